# Optimizing an MI355X kernel written in HIP

```python
import jax, jax.numpy as jnp
from jax import lax
import numpy as np

D_MODEL = 1024
BATCH = 8
SEQ = 2048
DEPTH = 4
DEC_BATCH = 128
DEC_SEQ = 4
PAST_LEN = 2048
PAGE_SIZE = 128

N_MIXERS = 2
N_ATTN_LAYERS = (DEPTH + 1) // 2
N_REC_LAYERS = DEPTH // 2
N_HEADS = 16
HEAD_DIM = D_MODEL // N_HEADS
KV_GROUPS = 2
HEADS_PER_GROUP = N_HEADS // KV_GROUPS
CMP_BLOCK = 32
CMP_STRIDE = 16
CMP_HIDDEN = 256
SEL_BLOCK = 64
SEL_TOPK = 16
WINDOW = 512
Q_BLOCK = 64
NSA_Q_COLS = N_HEADS * HEAD_DIM
NSA_KV_COLS = 6 * KV_GROUPS * HEAD_DIM
NSA_IN_COLS = NSA_Q_COLS + NSA_KV_COLS + 3 * N_HEADS
ATTN_SCALE = HEAD_DIM ** -0.5
FORCE_SCORE = 1e6
NEG_INF = -1e30
D_RNN = D_MODEL
RG_BLOCKS = 4
RG_BLOCK_DIM = D_RNN // RG_BLOCKS
RG_CONV = 4
RG_C = 8.0
D_FF = 3 * D_MODEL
FFN_CONV = 3
D_PLE = 256
ALPHA = (2 * DEPTH) ** 0.25
BETA = (8 * DEPTH) ** -0.25
LN_EPS = 1e-5

kernel_name = 'nsa_rglru_convffn_hybrid_step'


def layer_norm(x, g, b):
    xf = x.astype(jnp.float32)
    mu = jnp.mean(xf, axis=-1, keepdims=True)
    var = jnp.mean(jnp.square(xf - mu), axis=-1, keepdims=True)
    y = (xf - mu) * lax.rsqrt(var + LN_EPS) * g.astype(jnp.float32) + b.astype(jnp.float32)
    return y.astype(x.dtype)


def masked_softmax(s, mask):
    s = jnp.where(mask, s, NEG_INF)
    m = jnp.max(s, axis=-1, keepdims=True)
    e = jnp.where(mask, jnp.exp(s - m), 0.0)
    return e / jnp.maximum(jnp.sum(e, axis=-1, keepdims=True), 1e-30)


def causal_dwconv(u, w, b, prev):
    K = w.shape[0]
    T = u.shape[1]
    ext = jnp.concatenate([prev.astype(u.dtype), u], axis=1)
    out = b + ext[:, 0:T] * w[0]
    for k in range(1, K):
        out = out + ext[:, k:k + T] * w[k]
    return out, ext[:, T:]


def nsa_project(x, w_in):
    B, T, _ = x.shape
    proj = x @ w_in
    q = proj[..., :NSA_Q_COLS].reshape(B, T, KV_GROUPS, HEADS_PER_GROUP, HEAD_DIM)
    kv = proj[..., NSA_Q_COLS:NSA_Q_COLS + NSA_KV_COLS].reshape(B, T, 6, KV_GROUPS, HEAD_DIM)
    gates = jax.nn.sigmoid(proj[..., NSA_Q_COLS + NSA_KV_COLS:]).reshape(B, T, KV_GROUPS, HEADS_PER_GROUP, 3)
    return q, kv, gates


def compress(rows, pe, w1, b1, w2):
    nc = (rows.shape[1] - CMP_BLOCK) // CMP_STRIDE + 1
    idx = jnp.arange(nc)[:, None] * CMP_STRIDE + jnp.arange(CMP_BLOCK)[None, :]
    blk = rows[:, idx] + pe[:, None, :]
    hid = jax.nn.gelu(jnp.einsum('bclgd,ldh->bcgh', blk, w1) + b1)
    return jnp.einsum('bcgh,hd->bcgd', hid, w2)


def nsa_keys(rows, cmp):
    pe, w1, b1, w2 = cmp
    B, Tk = rows.shape[:2]
    kc = compress(rows[:, :, 0], pe[0], w1[0], b1[0], w2[0])
    vc = compress(rows[:, :, 1], pe[1], w1[1], b1[1], w2[1])
    nc = kc.shape[1]
    c_start = jnp.arange(nc) * CMP_STRIDE
    c_end = c_start + (CMP_BLOCK - 1)
    ns = -(-Tk // SEL_BLOCK)
    b_start = jnp.arange(ns) * SEL_BLOCK
    overlap = ((c_start[:, None] < b_start[None, :] + SEL_BLOCK)
               & (c_end[:, None] >= b_start[None, :])).astype(jnp.float32)
    sel = jnp.pad(rows[:, :, 2:4], ((0, 0), (0, ns * SEL_BLOCK - Tk), (0, 0), (0, 0), (0, 0)))
    sel = sel.reshape(B, ns, SEL_BLOCK, 2, KV_GROUPS, HEAD_DIM).transpose(3, 0, 4, 1, 2, 5)
    return (kc, vc, c_end, sel[0], sel[1], overlap)


def nsa_attend(q, gates, q_pos, ctx, kw, vw, w_pos):
    kc, vc, c_end, ks, vs, overlap = ctx
    B, Q = q.shape[:2]
    ns = ks.shape[2]
    f32 = jnp.float32
    s_c = jnp.einsum('bqghd,bcgd->bghqc', q, kc).astype(f32) * ATTN_SCALE
    p_c = masked_softmax(s_c, c_end[None, :] <= q_pos[:, None])
    o_c = jnp.einsum('bghqc,bcgd->bqghd', p_c.astype(vc.dtype), vc)
    imp = jnp.einsum('bghqc,cn->bgqn', p_c, overlap)
    blk = jnp.arange(ns)[None, :]
    cur = (q_pos // SEL_BLOCK)[:, None]
    imp = jnp.where((blk == 0) | (blk == cur) | (blk == cur - 1), FORCE_SCORE, imp)
    imp = jnp.where(blk > cur, -1.0, imp)
    n_top = min(SEL_TOPK, ns)
    _, idx = lax.top_k(imp, n_top)
    bi = jnp.arange(B)[:, None, None, None]
    gi = jnp.arange(KV_GROUPS)[None, :, None, None]
    k_sel = ks[bi, gi, idx].reshape(B, KV_GROUPS, Q, n_top * SEL_BLOCK, HEAD_DIM)
    v_sel = vs[bi, gi, idx].reshape(B, KV_GROUPS, Q, n_top * SEL_BLOCK, HEAD_DIM)
    s_pos = (idx[..., None] * SEL_BLOCK + jnp.arange(SEL_BLOCK)).reshape(B, KV_GROUPS, Q, n_top * SEL_BLOCK)
    s_s = jnp.einsum('bqghd,bgqkd->bghqk', q, k_sel).astype(f32) * ATTN_SCALE
    p_s = masked_softmax(s_s, (s_pos <= q_pos[None, None, :, None])[:, :, None])
    o_s = jnp.einsum('bghqk,bgqkd->bqghd', p_s.astype(v_sel.dtype), v_sel)
    s_w = jnp.einsum('bqghd,bwgd->bghqw', q, kw).astype(f32) * ATTN_SCALE
    dist = q_pos[:, None] - w_pos[None, :]
    p_w = masked_softmax(s_w, (dist >= 0) & (dist <= WINDOW) & (w_pos[None, :] >= 0))
    o_w = jnp.einsum('bghqw,bwgd->bqghd', p_w.astype(vw.dtype), vw)
    g = gates.astype(o_c.dtype)
    return g[..., 0:1] * o_c + g[..., 1:2] * o_s + g[..., 2:3] * o_w


def nsa_prompt(x, w_in, w_out, cmp):
    B, T, _ = x.shape
    q, kv, gates = nsa_project(x, w_in)
    ctx = nsa_keys(kv[:, :, :4], cmp)
    kw_pad = jnp.pad(kv[:, :, 4:6], ((0, 0), (WINDOW, 0), (0, 0), (0, 0), (0, 0)))
    nb = T // Q_BLOCK
    qb = q.reshape(B, nb, Q_BLOCK, KV_GROUPS, HEADS_PER_GROUP, HEAD_DIM).swapaxes(0, 1)
    gb = gates.reshape(B, nb, Q_BLOCK, KV_GROUPS, HEADS_PER_GROUP, 3).swapaxes(0, 1)

    def block(args):
        qc, gc, c = args
        start = c * Q_BLOCK
        kwc = lax.dynamic_slice_in_dim(kw_pad, start, WINDOW + Q_BLOCK, axis=1)
        q_pos = start + jnp.arange(Q_BLOCK)
        w_pos = start - WINDOW + jnp.arange(WINDOW + Q_BLOCK)
        return nsa_attend(qc, gc, q_pos, ctx, kwc[:, :, 0], kwc[:, :, 1], w_pos)

    o = lax.map(block, (qb, gb, jnp.arange(nb)))
    o = o.swapaxes(0, 1).reshape(B, T, N_HEADS * HEAD_DIM)
    return o @ w_out, kv[:, :, :4], kv[:, T - min(WINDOW, T):, 4:6]


def nsa_sample(x, kv_pool, page_table, win_buf, w_in, w_out, cmp):
    B, S, _ = x.shape
    q, kv, gates = nsa_project(x, w_in)
    past = kv_pool[page_table]
    past = past.reshape(B, -1, 4, KV_GROUPS, HEAD_DIM)
    P = past.shape[1]
    rows = jnp.concatenate([past.astype(kv.dtype), kv[:, :, :4]], axis=1)
    ctx = nsa_keys(rows, cmp)
    Wb = win_buf.shape[1]
    kw = jnp.concatenate([win_buf.astype(kv.dtype), kv[:, :, 4:6]], axis=1)
    q_pos = P + jnp.arange(S)
    w_pos = P - Wb + jnp.arange(Wb + S)
    o = nsa_attend(q, gates, q_pos, ctx, kw[:, :, 0], kw[:, :, 1], w_pos)
    return o.reshape(B, S, N_HEADS * HEAD_DIM) @ w_out, kv[:, :, :4], kw[:, S:]


def rglru_scan(x, h0, ga_w, ga_b, gx_w, gx_b, lam):
    B, T, _ = x.shape
    f32 = jnp.float32
    xb = x.reshape(B, T, RG_BLOCKS, RG_BLOCK_DIM)
    r = jax.nn.sigmoid((jnp.einsum('btnc,ncd->btnd', xb, ga_w).reshape(B, T, D_RNN) + ga_b).astype(f32))
    i = jax.nn.sigmoid((jnp.einsum('btnc,ncd->btnd', xb, gx_w).reshape(B, T, D_RNN) + gx_b).astype(f32))
    log_a = -RG_C * r * jax.nn.softplus(-lam.astype(f32))
    a = jnp.exp(log_a)
    u = jnp.sqrt(-jnp.expm1(2.0 * log_a)) * i * x.astype(f32)

    def step(h, au):
        a_t, u_t = au
        h = a_t * h + u_t
        return h, h

    h_last, hs = lax.scan(step, h0.astype(f32), (a.swapaxes(0, 1), u.swapaxes(0, 1)))
    return hs.swapaxes(0, 1).astype(x.dtype), h_last.astype(h0.dtype)


def rglru_block(x, h0, conv_prev, w_in, conv_w, conv_b, ga_w, ga_b, gx_w, gx_b, lam, w_out):
    u = x @ w_in
    gate_br, rec_br = u[..., :D_RNN], u[..., D_RNN:]
    rec, conv_state = causal_dwconv(rec_br, conv_w, conv_b, conv_prev)
    h, h_last = rglru_scan(rec, h0, ga_w, ga_b, gx_w, gx_b, lam)
    return (h * jax.nn.gelu(gate_br)) @ w_out, h_last, conv_state


def conv_ffn(x, prev, w_up, conv_w, conv_b, w_down):
    u, state = causal_dwconv(x @ w_up, conv_w, conv_b, prev)
    return (jax.nn.gelu(u[..., :D_FF]) * u[..., D_FF:]) @ w_down, state


def layer_tail(x, mix, ffn_prev, p, ln_mg, ln_mb, ln_fg, ln_fb, w_up, conv_w, conv_b, w_down, w_proj, w_gate):
    h = layer_norm(ALPHA * x + mix, ln_mg, ln_mb)
    f, ffn_state = conv_ffn(h, ffn_prev, w_up, conv_w, conv_b, w_down)
    h = layer_norm(ALPHA * h + f, ln_fg, ln_fb)
    return h + jax.nn.sigmoid(h @ w_gate) * (p @ w_proj), ffn_state


def setup_inputs(seed: int = 0) -> dict:
    key = jax.random.key(seed)
    keys = iter(jax.random.split(key, 64))

    def nrm(shape, scale):
        return jax.random.normal(next(keys), shape, jnp.float32) * scale

    n_pages = PAST_LEN // PAGE_SIZE
    n_pool = (DEC_BATCH * n_pages * 5) // 4
    win_buf = min(WINDOW, PAST_LEN)
    A, R = N_ATTN_LAYERS, N_REC_LAYERS
    x_prompt = nrm((BATCH, SEQ, D_MODEL), 1.0)
    x_sample = nrm((DEC_BATCH, DEC_SEQ, D_MODEL), 1.0)
    cache_nsa_kv = nrm((A, n_pool, PAGE_SIZE, 4, KV_GROUPS, HEAD_DIM), 1.0)
    cache_nsa_win = nrm((A, DEC_BATCH, win_buf, 2, KV_GROUPS, HEAD_DIM), 1.0)
    state_rglru_h = nrm((R, DEC_BATCH, D_RNN), 0.5)
    state_rglru_conv = nrm((R, DEC_BATCH, RG_CONV - 1, D_RNN), 1.0)
    state_ffn_conv = nrm((DEPTH, DEC_BATCH, FFN_CONV - 1, 2 * D_FF), 1.0)
    page_table = jax.random.permutation(next(keys), n_pool)[:DEC_BATCH * n_pages]
    page_table = page_table.reshape(DEC_BATCH, n_pages).astype(jnp.int32)
    p_prompt = nrm((DEPTH, BATCH, SEQ, D_PLE), 1.0)
    p_sample = nrm((DEPTH, DEC_BATCH, DEC_SEQ, D_PLE), 1.0)
    u = jax.random.uniform(next(keys), (R, D_RNN), jnp.float32, 0.9, 0.999)
    s = u ** (1.0 / RG_C)
    rg_lambda = jnp.log(s) - jnp.log1p(-s)
    return {
        'x_prompt': x_prompt,
        'x_sample': x_sample,
        'cache_nsa_kv': cache_nsa_kv,
        'cache_nsa_win': cache_nsa_win,
        'state_rglru_h': state_rglru_h,
        'state_rglru_conv': state_rglru_conv,
        'state_ffn_conv': state_ffn_conv,
        'page_table': page_table,
        'p_prompt': p_prompt,
        'p_sample': p_sample,
        'nsa_w_in': nrm((A, D_MODEL, NSA_IN_COLS), D_MODEL ** -0.5),
        'nsa_w_out': nrm((A, N_HEADS * HEAD_DIM, D_MODEL), BETA * (N_HEADS * HEAD_DIM) ** -0.5),
        'nsa_cmp_pe': nrm((A, 2, CMP_BLOCK, HEAD_DIM), 0.1),
        'nsa_cmp_w1': nrm((A, 2, CMP_BLOCK, HEAD_DIM, CMP_HIDDEN), (CMP_BLOCK * HEAD_DIM) ** -0.5),
        'nsa_cmp_b1': nrm((A, 2, CMP_HIDDEN), 0.01),
        'nsa_cmp_w2': nrm((A, 2, CMP_HIDDEN, HEAD_DIM), CMP_HIDDEN ** -0.5),
        'rg_w_in': nrm((R, D_MODEL, 2 * D_RNN), D_MODEL ** -0.5),
        'rg_conv_w': nrm((R, RG_CONV, D_RNN), RG_CONV ** -0.5),
        'rg_conv_b': nrm((R, D_RNN), 0.01),
        'rg_gate_a_w': nrm((R, RG_BLOCKS, RG_BLOCK_DIM, RG_BLOCK_DIM), RG_BLOCK_DIM ** -0.5),
        'rg_gate_a_b': nrm((R, D_RNN), 0.01),
        'rg_gate_x_w': nrm((R, RG_BLOCKS, RG_BLOCK_DIM, RG_BLOCK_DIM), RG_BLOCK_DIM ** -0.5),
        'rg_gate_x_b': nrm((R, D_RNN), 0.01),
        'rg_lambda': rg_lambda,
        'rg_w_out': nrm((R, D_RNN, D_MODEL), BETA * D_RNN ** -0.5),
        'ffn_w_up': nrm((DEPTH, D_MODEL, 2 * D_FF), D_MODEL ** -0.5),
        'ffn_conv_w': nrm((DEPTH, FFN_CONV, 2 * D_FF), FFN_CONV ** -0.5),
        'ffn_conv_b': nrm((DEPTH, 2 * D_FF), 0.01),
        'ffn_w_down': nrm((DEPTH, D_FF, D_MODEL), BETA * D_FF ** -0.5),
        'ln_mix_g': 1.0 + nrm((DEPTH, D_MODEL), 0.05),
        'ln_mix_b': nrm((DEPTH, D_MODEL), 0.02),
        'ln_ffn_g': 1.0 + nrm((DEPTH, D_MODEL), 0.05),
        'ln_ffn_b': nrm((DEPTH, D_MODEL), 0.02),
        'ple_w_proj': nrm((DEPTH, D_PLE, D_MODEL), 0.5 * D_PLE ** -0.5),
        'ple_w_gate': nrm((DEPTH, D_MODEL, D_MODEL), D_MODEL ** -0.5),
    }


def reference(x_prompt, x_sample, cache_nsa_kv, cache_nsa_win, state_rglru_h, state_rglru_conv,
              state_ffn_conv, page_table, p_prompt, p_sample,
              nsa_w_in, nsa_w_out, nsa_cmp_pe, nsa_cmp_w1, nsa_cmp_b1, nsa_cmp_w2,
              rg_w_in, rg_conv_w, rg_conv_b, rg_gate_a_w, rg_gate_a_b, rg_gate_x_w, rg_gate_x_b,
              rg_lambda, rg_w_out,
              ffn_w_up, ffn_conv_w, ffn_conv_b, ffn_w_down,
              ln_mix_g, ln_mix_b, ln_ffn_g, ln_ffn_b, ple_w_proj, ple_w_gate):
    xp, xs = x_prompt, x_sample
    bp = xp.shape[0]
    kv_p, kv_s, win_p, win_s = [], [], [], []
    h_p, h_s, rc_p, rc_s = [], [], [], []
    fc_p, fc_s = [], []
    for i in range(DEPTH):
        j = i // N_MIXERS
        if i % N_MIXERS == 0:
            cmp = (nsa_cmp_pe[j], nsa_cmp_w1[j], nsa_cmp_b1[j], nsa_cmp_w2[j])
            mix_p, rows_p, wnd_p = nsa_prompt(xp, nsa_w_in[j], nsa_w_out[j], cmp)
            mix_s, rows_s, wnd_s = nsa_sample(xs, cache_nsa_kv[j], page_table, cache_nsa_win[j],
                                              nsa_w_in[j], nsa_w_out[j], cmp)
            kv_p.append(rows_p)
            kv_s.append(rows_s)
            win_p.append(wnd_p)
            win_s.append(wnd_s)
        else:
            rg = (rg_w_in[j], rg_conv_w[j], rg_conv_b[j], rg_gate_a_w[j], rg_gate_a_b[j],
                  rg_gate_x_w[j], rg_gate_x_b[j], rg_lambda[j], rg_w_out[j])
            h0 = jnp.zeros((bp, D_RNN), jnp.float32)
            c0 = jnp.zeros((bp, RG_CONV - 1, D_RNN), xp.dtype)
            mix_p, hl_p, cs_p = rglru_block(xp, h0, c0, *rg)
            mix_s, hl_s, cs_s = rglru_block(xs, state_rglru_h[j], state_rglru_conv[j], *rg)
            h_p.append(hl_p)
            h_s.append(hl_s)
            rc_p.append(cs_p)
            rc_s.append(cs_s)
        tail = (ln_mix_g[i], ln_mix_b[i], ln_ffn_g[i], ln_ffn_b[i], ffn_w_up[i], ffn_conv_w[i],
                ffn_conv_b[i], ffn_w_down[i], ple_w_proj[i], ple_w_gate[i])
        f0 = jnp.zeros((bp, FFN_CONV - 1, 2 * D_FF), xp.dtype)
        xp, fs_p = layer_tail(xp, mix_p, f0, p_prompt[i], *tail)
        xs, fs_s = layer_tail(xs, mix_s, state_ffn_conv[i], p_sample[i], *tail)
        fc_p.append(fs_p)
        fc_s.append(fs_s)
    return (xp, xs,
            jnp.stack(kv_p), jnp.stack(kv_s),
            jnp.stack(win_p), jnp.stack(win_s),
            jnp.stack(h_p), jnp.stack(h_s),
            jnp.stack(rc_p), jnp.stack(rc_s),
            jnp.stack(fc_p), jnp.stack(fc_s))
```

```cpp
#include <hip/hip_runtime.h>
#include <cstdio>
#include <cstdint>

#ifndef MK_ONE_LAUNCH
#define MK_ONE_LAUNCH 0
#endif

#define LAS __attribute__((address_space(3)))
#define GAS __attribute__((address_space(1)))
typedef unsigned short bf16_t;
typedef short bf16x8 __attribute__((ext_vector_type(8)));
typedef short s16x4 __attribute__((ext_vector_type(4)));
typedef float f32x4 __attribute__((ext_vector_type(4)));
typedef float f32x2 __attribute__((ext_vector_type(2)));
typedef float f32x16 __attribute__((ext_vector_type(16)));
typedef unsigned u32x4 __attribute__((ext_vector_type(4)));
typedef unsigned u32x2 __attribute__((ext_vector_type(2)));

constexpr int D = 1024, BATCH = 8, SEQ = 2048, DEPTH = 4, DECB = 128, DECS = 4, PAST = 2048, PAGE = 128;
constexpr int MP = BATCH * SEQ, MS = DECB * DECS, MT = MP + MS;
constexpr int NPOOL = 2560, NPAGES = 16;
constexpr int DFF = 3072, DPLE = 256;
constexpr int NSA_N = 1840, NSA_NP = 2048;
constexpr float ALPHA = 1.6817928305074290f;
constexpr float LN_EPS = 1e-5f;
constexpr float QSCALE = 0.125f * 1.4426950408889634f;

constexpr size_t O_YP = 0;
constexpr size_t O_YS = O_YP + (size_t)MP * D;
constexpr size_t O_KVP = O_YS + (size_t)MS * D;
constexpr size_t O_KVS = O_KVP + (size_t)2 * MP * 512;
constexpr size_t O_WINP = O_KVS + (size_t)2 * MS * 512;
constexpr size_t O_WINS = O_WINP + (size_t)2 * BATCH * 512 * 256;
constexpr size_t O_HP = O_WINS + (size_t)2 * DECB * 512 * 256;
constexpr size_t O_HS = O_HP + (size_t)2 * BATCH * D;
constexpr size_t O_RCP = O_HS + (size_t)2 * DECB * D;
constexpr size_t O_RCS = O_RCP + (size_t)2 * BATCH * 3 * D;
constexpr size_t O_FCP = O_RCS + (size_t)2 * DECB * 3 * D;
constexpr size_t O_FCS = O_FCP + (size_t)4 * BATCH * 2 * 6144;
constexpr size_t O_END = O_FCS + (size_t)4 * DECB * 2 * 6144;
static_assert(O_END == 78053376, "output size");

constexpr size_t MiB = 1u << 20;
constexpr size_t WS_CTL = 0, CTL_ZERO_BYTES = 1 * MiB;
constexpr size_t WS_W_NSA_IN = 2 * MiB;
constexpr size_t WS_W_NSA_OUT = WS_W_NSA_IN + 8 * MiB;
constexpr size_t WS_W_CMP1 = WS_W_NSA_OUT + 4 * MiB;
constexpr size_t WS_W_CMP2 = WS_W_CMP1 + 4 * MiB;
constexpr size_t WS_W_RG_IN = WS_W_CMP2 + 1 * MiB;
constexpr size_t WS_W_RG_G = WS_W_RG_IN + 8 * MiB;
constexpr size_t WS_W_RG_OUT = WS_W_RG_G + 2 * MiB;
constexpr size_t WS_W_UP = WS_W_RG_OUT + 4 * MiB;
constexpr size_t WS_W_DOWN = WS_W_UP + 48 * MiB;
constexpr size_t WS_W_PROJ = WS_W_DOWN + 24 * MiB;
constexpr size_t WS_W_GATE = WS_W_PROJ + 2 * MiB;
constexpr size_t WS_B1PART = WS_W_GATE + 8 * MiB;
constexpr size_t WS_X32 = WS_B1PART + 1 * MiB;
constexpr size_t WS_XB = WS_X32 + 66 * MiB;
constexpr size_t WS_PB = WS_XB + 33 * MiB;
constexpr size_t WS_PP = WS_PB + 33 * MiB;
constexpr size_t WS_CS = WS_PP + 132 * MiB;
constexpr size_t WS_HIDS = WS_CS + 257 * MiB;
constexpr size_t WS_KCS = WS_HIDS + 64 * MiB;
constexpr size_t WS_QB = WS_KCS + 16 * MiB;
constexpr size_t WS_KV6 = WS_QB + 33 * MiB;
constexpr size_t WS_KVS = WS_KV6 + 25 * MiB;
constexpr size_t WS_G32 = WS_KVS + 1 * MiB;
constexpr size_t WS_HIDP = WS_G32 + 4 * MiB;
constexpr size_t WS_KCP = WS_HIDP + 2 * MiB;
constexpr size_t WS_OB = WS_KCP + 1 * MiB;
constexpr size_t WS_PRE = WS_OB + 33 * MiB;
constexpr size_t WS_H32 = WS_PRE + 66 * MiB;
constexpr size_t WS_HB = WS_H32 + 66 * MiB;
constexpr size_t WS_U = WS_HB + 33 * MiB;
constexpr size_t WS_ACT = WS_U + 198 * MiB;
constexpr size_t WS_GG = WS_ACT + 99 * MiB;
constexpr size_t WS_RECB = WS_GG + 33 * MiB;
constexpr size_t WS_REC = WS_RECB + 33 * MiB;
constexpr size_t WS_AA = WS_REC + 33 * MiB;
constexpr size_t WS_UU = WS_AA + 66 * MiB;
constexpr size_t WS_CA = WS_UU + 66 * MiB;
constexpr size_t WS_CH = WS_CA + 1 * MiB;
constexpr size_t WS_HG = WS_CH + 1 * MiB;
constexpr size_t WS_END = WS_HG + 33 * MiB;

constexpr int CW_BAR = 4096;

constexpr int RING_BYTES = 131072;
constexpr int LDSCTL_OFF = RING_BYTES, MISC_OFF = LDSCTL_OFF + 320;
constexpr int LDS_B1P_OFF = RING_BYTES + 1024;
constexpr int LDS_BYTES = 147456;
constexpr int NWAVES = 8;

__device__ __forceinline__ unsigned f2bf(float f) { unsigned u = __builtin_bit_cast(unsigned, f); return (u + 0x7fffu + ((u >> 16) & 1u)) >> 16; }
__device__ __forceinline__ unsigned pk2(float lo, float hi) { return f2bf(lo) | (f2bf(hi) << 16); }
__device__ __forceinline__ float bf2f(unsigned short h) { return __builtin_bit_cast(float, (unsigned)h << 16); }
__device__ __forceinline__ float bflo(unsigned w) { return __builtin_bit_cast(float, w << 16); }
__device__ __forceinline__ float bfhi(unsigned w) { return __builtin_bit_cast(float, w & 0xffff0000u); }
__device__ __forceinline__ float sigm(float x) { return 1.f / (1.f + __expf(-x)); }
__device__ __forceinline__ float gelu_t(float x) { const float u = 0.7978845608028654f * (x + 0.044715f * x * x * x); return x / (1.f + __expf(-2.f * u)); }
__device__ __forceinline__ float ex2(float x) { return __builtin_amdgcn_exp2f(x); }
#define LDS_WAIT() asm volatile("s_waitcnt lgkmcnt(0)" ::: "memory")
#define VM_WAIT() asm volatile("s_waitcnt vmcnt(0)" ::: "memory")

namespace pg8 {
constexpr int BM = 256, BK = 64, HALF = 128, HTB = HALF * BK * 2, STAGE_BYTES = 8 * HTB, NXCD = 8, WGM = 8;
__host__ __device__ __forceinline__ int lds_byte(int r, int c) { const int st = (r >> 4) * 2 + (c >> 5), rr = r & 15, cc = c & 31, ob = rr * 64 + cc * 2; return st * 1024 + (ob ^ (((ob >> 9) & 1) << 5)); }
__host__ __device__ __forceinline__ void stage_rc(int b, int& R, int& C) { const int st = b / 1024, sb = b % 1024, swz = sb ^ (((sb >> 9) & 1) << 5); R = (st >> 1) * 16 + swz / 64; C = (st & 1) * 32 + (swz % 64) / 2; }
__host__ __device__ __forceinline__ int perm32(int rho) { const int n = rho >> 4, i = rho & 15; return 8 * (i >> 2) + 4 * n + (i & 3); }

struct Unit { int pm, pn; long aoff, boff; };
struct Gemm { const bf16_t* A; const bf16_t* Bt; int lda, ldb, K; };

struct Sched {
    int nM, nN, nwg, G, c;
    long a_tile, b_tile;
    int a_pn_mul; long a_pn_bytes;
    int b_pm_mul; long b_pm_bytes;
    __device__ void init(int nM_, int nN_, int G_, int c_, int lda, int ldb) {
        nM = nM_; nN = nN_; nwg = nM * nN; G = G_; c = c_; a_tile = (long)BM * lda * 2; b_tile = (long)BM * ldb * 2;
        a_pn_mul = 0; a_pn_bytes = 0; b_pm_mul = 0; b_pm_bytes = 0; }
    __device__ static constexpr int rmul(int div) { return (65536 + div - 1) / div; }
    __device__ bool next(int i, Unit& u) const {
        const long L = (long)i * G + c; if (L >= nwg) return false;
        int wgid = (int)L; { const int q = nwg / NXCD, r = nwg % NXCD, xcd = wgid % NXCD, off = wgid / NXCD; wgid = (xcd < r ? xcd * (q + 1) : r * (q + 1) + (xcd - r) * q) + off; }
        const int nig = WGM * nN, gid = wgid / nig, fm = gid * WGM, gsz = (nM - fm) < WGM ? (nM - fm) : WGM;
        u.pm = fm + ((wgid % nig) % gsz); u.pn = (wgid % nig) / gsz;
        u.aoff = (long)u.pm * a_tile + (long)((u.pn * a_pn_mul) >> 16) * a_pn_bytes; u.boff = (long)u.pn * b_tile + (long)((u.pm * b_pm_mul) >> 16) * b_pm_bytes;
        return true; }
};

template <class Epi>
__device__ __forceinline__ void gemm_phase(LAS unsigned char* lds, const Gemm g, const Sched& S, const Epi& E) {
    int tid_ = threadIdx.x; asm volatile("" : "+v"(tid_));
    const int tid = tid_, wid = __builtin_amdgcn_readfirstlane(tid >> 6), lane = tid & 63, wr = wid >> 2, wc = wid & 3, fr = lane & 15, fq = lane >> 4;
    int K_ = g.K; asm volatile("" : "+s"(K_));
    const int K = K_, nt = K / BK;
    unsigned voffA, voffB;
    { int R, C; stage_rc(tid * 16, R, C); const int Rb = (R & ~31) + perm32(R & 31); voffA = (unsigned)(R * g.lda + C) * 2u; voffB = (unsigned)(Rb * g.ldb + C) * 2u; }
    const size_t piecevoffA = (size_t)64 * g.lda * 2, piecevoffB = (size_t)64 * g.ldb * 2;
    const size_t kstep = (size_t)(BK * 2);
    const size_t hstepA = (size_t)HALF * g.lda * 2, hstepB = (size_t)HALF * g.ldb * 2;
    const unsigned ldsw = (unsigned)wid * 1024u;
    const int aoff = lds_byte(wr * 64 + fr, fq * 8), boff = lds_byte(wc * 32 + fr, fq * 8);
#define PG8_SA(b, h) (((b) * 2 + (h)) * HTB)
#define PG8_SB(b, h) ((4 + (b) * 2 + (h)) * HTB)
#define PG8_STAGE_(bufoff, gbase, voff, piece) do { \
        __builtin_amdgcn_global_load_lds((const unsigned*)((const char*)(gbase) + (voff)), (LAS unsigned*)(lds + (bufoff) + ldsw), 16, 0, 0); \
        __builtin_amdgcn_global_load_lds((const unsigned*)((const char*)(gbase) + (piece) + (voff)), (LAS unsigned*)(lds + (bufoff) + ldsw + 8192), 16, 0, 0); } while (0)
#define PG8_STAGE(bufoff, gbase, voff) PG8_STAGE_(bufoff, gbase, voff, piece##voff)
#define PG8_LDA(dst, b, h) do { _Pragma("unroll") for (int m = 0; m < 4; ++m) _Pragma("unroll") for (int k = 0; k < 2; ++k) dst[m][k] = *(const LAS bf16x8*)(lds + PG8_SA(b, h) + aoff + m * 2048 + k * 1024); } while (0)
#define PG8_LDB(dst, b, h) do { _Pragma("unroll") for (int n = 0; n < 2; ++n) _Pragma("unroll") for (int k = 0; k < 2; ++k) dst[n][k] = *(const LAS bf16x8*)(lds + PG8_SB(b, h) + boff + n * 2048 + k * 1024); } while (0)
#define PG8_MMA(ai, bj, At, Bt) do { __builtin_amdgcn_s_setprio(1); _Pragma("unroll") for (int m = 0; m < 4; ++m) _Pragma("unroll") for (int n = 0; n < 2; ++n) _Pragma("unroll") for (int k = 0; k < 2; ++k) \
        acc[ai][bj][m][n] = __builtin_amdgcn_mfma_f32_16x16x32_bf16(Bt[n][k], At[m][k], acc[ai][bj][m][n], 0, 0, 0); __builtin_amdgcn_s_setprio(0); } while (0)
#define PG8_WAIT_V(n) asm volatile("s_waitcnt vmcnt(" #n ")" ::: "memory")
#define PG8_WAIT_L(n) asm volatile("s_waitcnt lgkmcnt(" #n ")" ::: "memory")
#define PG8_BAR __builtin_amdgcn_s_barrier()
#define PG8_SCHED __builtin_amdgcn_sched_barrier(0)
    Unit cur, nxt; int ui = 0;
    if (!S.next(0, cur)) return;
    f32x4 acc[2][2][4][2];
#pragma unroll
    for (int a = 0; a < 2; ++a)
#pragma unroll
        for (int b = 0; b < 2; ++b)
#pragma unroll
            for (int m = 0; m < 4; ++m)
#pragma unroll
                for (int n = 0; n < 2; ++n) acc[a][b][m][n] = (f32x4){0.f, 0.f, 0.f, 0.f};
    bf16x8 At[4][2], B0[2][2], B1[2][2];
    const char* cA = (const char*)g.A + cur.aoff; const char* cB = (const char*)g.Bt + cur.boff;
    PG8_STAGE(PG8_SB(0, 0), cB, voffB); PG8_STAGE(PG8_SB(0, 1), cB + hstepB, voffB); PG8_STAGE(PG8_SA(0, 0), cA, voffA); PG8_STAGE(PG8_SA(0, 1), cA + hstepA, voffA);
    if (wr == 1) PG8_BAR;
    PG8_WAIT_V(2); PG8_BAR;
    PG8_STAGE(PG8_SB(1, 0), cB + kstep, voffB); PG8_STAGE(PG8_SA(1, 0), cA + kstep, voffA); PG8_STAGE(PG8_SB(1, 1), cB + hstepB + kstep, voffB);
    PG8_WAIT_V(6); PG8_BAR;
    for (;;) {
        const bool has_next = S.next(ui + 1, nxt);
        const char* nA = has_next ? (const char*)g.A + nxt.aoff : cA; const char* nB = has_next ? (const char*)g.Bt + nxt.boff : cB;
        for (int t = 0; t < nt; t += 2) {
            const bool last = (t == nt - 2);
            const char* a1 = cA + (size_t)(t + 1) * kstep;
            const char* a2 = last ? nA : cA + (size_t)(t + 2) * kstep; const char* b2 = last ? nB : cB + (size_t)(t + 2) * kstep;
            const char* a3 = a2 + kstep; const char* b3 = b2 + kstep;
            PG8_LDB(B0, 0, 0); PG8_LDB(B1, 0, 1); PG8_SCHED; PG8_LDA(At, 0, 0); PG8_STAGE(PG8_SA(1, 1), a1 + hstepA, voffA);
            PG8_WAIT_V(8); PG8_WAIT_L(0); PG8_BAR; PG8_MMA(0, 0, At, B0); PG8_MMA(0, 1, At, B1); PG8_BAR; PG8_SCHED;
            PG8_LDA(At, 0, 1); PG8_STAGE(PG8_SB(0, 0), b2, voffB); PG8_STAGE(PG8_SB(0, 1), b2 + hstepB, voffB); PG8_STAGE(PG8_SA(0, 0), a2, voffA);
            PG8_WAIT_V(8); PG8_WAIT_L(0); PG8_BAR; PG8_MMA(1, 0, At, B0); PG8_MMA(1, 1, At, B1); PG8_BAR; PG8_SCHED;
            PG8_LDB(B0, 1, 0); PG8_LDB(B1, 1, 1); PG8_SCHED; PG8_LDA(At, 1, 0); PG8_STAGE(PG8_SA(0, 1), a2 + hstepA, voffA);
            PG8_WAIT_V(8); PG8_WAIT_L(0); PG8_BAR; PG8_MMA(0, 0, At, B0); PG8_MMA(0, 1, At, B1); PG8_BAR; PG8_SCHED;
            PG8_LDA(At, 1, 1); PG8_STAGE(PG8_SB(1, 0), b3, voffB); PG8_STAGE(PG8_SB(1, 1), b3 + hstepB, voffB); PG8_STAGE(PG8_SA(1, 0), a3, voffA);
            PG8_WAIT_V(8); PG8_WAIT_L(0); PG8_BAR; PG8_MMA(1, 0, At, B0); PG8_MMA(1, 1, At, B1); PG8_BAR; PG8_SCHED;
        }
        if (wr == 0) PG8_BAR;
        E(acc, cur, wr, wc, fr, fq);
        if (!has_next) break;
#pragma unroll
        for (int a = 0; a < 2; ++a)
#pragma unroll
            for (int b = 0; b < 2; ++b)
#pragma unroll
                for (int m = 0; m < 4; ++m)
#pragma unroll
                    for (int n = 0; n < 2; ++n) acc[a][b][m][n] = (f32x4){0.f, 0.f, 0.f, 0.f};
        cur = nxt; cA = nA; cB = nB; ++ui;
        if (wr == 1) PG8_BAR;
    }
    PG8_WAIT_V(0);
    PG8_BAR;
#undef PG8_SA
#undef PG8_SB
#undef PG8_STAGE
#undef PG8_STAGE_
#undef PG8_LDA
#undef PG8_LDB
#undef PG8_MMA
#undef PG8_WAIT_V
#undef PG8_WAIT_L
#undef PG8_BAR
#undef PG8_SCHED
}

__device__ __forceinline__ u32x4 pack8(const f32x4& v0, const f32x4& v1) { u32x4 w; w.x = pk2(v0[0], v0[1]); w.y = pk2(v0[2], v0[3]); w.z = pk2(v1[0], v1[1]); w.w = pk2(v1[2], v1[3]); return w; }
#define EPI_PIECES(...) \
    _Pragma("unroll") for (int ai = 0; ai < 2; ++ai) _Pragma("unroll") for (int m = 0; m < 4; ++m) { const int rowU = u.pm * BM + ai * HALF + m * 16; (void)rowU; \
        _Pragma("unroll") for (int bj = 0; bj < 2; ++bj) { const f32x4 v0 = acc[ai][bj][m][0], v1 = acc[ai][bj][m][1]; (void)v0; (void)v1; __VA_ARGS__ } \
        asm volatile("" ::: "memory"); }
#define ST_F32X8(ptr, a, b) do { *(f32x4*)(ptr) = (a); *(f32x4*)((ptr) + 16) = (b); } while (0)

template <bool BA> struct EpiBf16G {
    bf16_t* O; int ldc; const LAS float* bias; int bias_pm_shift;
    __device__ __forceinline__ void operator()(const f32x4 (&acc)[2][2][4][2], const Unit& u, int wr, int wc, int fr, int fq) const {
        const LAS float* bp0 = BA ? bias + (u.pm >> bias_pm_shift) * 256 + wc * 32 + 8 * fq : nullptr;
        const unsigned lo = (unsigned)(((wr * 64 + fr) * ldc + wc * 32 + 8 * fq) * 2);
        EPI_PIECES(
            char* op = (char*)O + ((size_t)rowU * ldc + u.pn * BM + bj * HALF) * 2;
            f32x4 a = v0; f32x4 b = v1;
            if (BA) { const LAS float* bp = bp0 + bj * HALF;
                _Pragma("unroll") for (int e = 0; e < 4; ++e) { a[e] = gelu_t(a[e] + bp[e]); b[e] = gelu_t(b[e] + bp[4 + e]); } }
            *(u32x4*)(op + lo) = pack8(a, b); )
    }
};

struct EpiNsaIn {
    bf16_t* QB; bf16_t* KV6; bf16_t* KVS; float* G32; float* out; int j;
    __device__ __forceinline__ void operator()(const f32x4 (&acc)[2][2][4][2], const Unit& u, int wr, int wc, int fr, int fq) const {
        const bool samp = u.pm >= MP / BM; const int rowL = wr * 64 + fr, colL = wc * 32 + 8 * fq;
        if (u.pn < 4) {
            const unsigned lo = (unsigned)((rowL * 1024 + colL) * 2);
            EPI_PIECES( char* op = (char*)QB + ((size_t)rowU * 1024 + u.pn * BM + bj * HALF) * 2; *(u32x4*)(op + lo) = pack8(v0 * QSCALE, v1 * QSCALE); )
        } else if (u.pn < 7) {
            const int gg = wc >> 1, d = (wc & 1) * 32 + 8 * fq;
            if (!samp) {
                const int b = u.pm >> 3; const bool wintail = (u.pm & 7) >= 6;
                const unsigned lo_kv = (unsigned)(((gg * 2048 + rowL) * 64 + d) * 2), lo_o = (unsigned)((rowL * 512 + colL) * 4), lo_w = (unsigned)((rowL * 256 + colL) * 4);
                EPI_PIECES(
                    const int kc0 = u.pn * BM + bj * HALF - 1024, comp = kc0 >> 7, tU = rowU & 2047;
                    char* kp = (char*)KV6 + ((size_t)((comp * 8 + b) * 2 * 2048 + tU) * 64) * 2; *(u32x4*)(kp + lo_kv) = pack8(v0, v1);
                    if (comp < 4) { char* op = (char*)(out + O_KVP) + ((size_t)((j * BATCH + b) * SEQ + tU) * 512 + kc0) * 4; ST_F32X8(op + lo_o, v0, v1); }
                    else if (wintail) { char* op = (char*)(out + O_WINP) + ((size_t)((j * BATCH + b) * 512 + (tU - (SEQ - 512))) * 256 + (kc0 - 512)) * 4; ST_F32X8(op + lo_w, v0, v1); } )
            } else {
                const unsigned lo_s = (unsigned)((rowL * 768 + colL) * 2), lo_o = (unsigned)((rowL * 512 + colL) * 4), lo_w = (unsigned)((((rowL >> 2) * 512 + (rowL & 3)) * 256 + colL) * 4);
                EPI_PIECES(
                    const int kc0 = u.pn * BM + bj * HALF - 1024, comp = kc0 >> 7, srU = rowU - MP;
                    char* sp = (char*)KVS + ((size_t)srU * 768 + kc0) * 2; *(u32x4*)(sp + lo_s) = pack8(v0, v1);
                    if (comp < 4) { char* op = (char*)(out + O_KVS) + ((size_t)(j * MS + srU) * 512 + kc0) * 4; ST_F32X8(op + lo_o, v0, v1); }
                    else { char* op = (char*)(out + O_WINS) + ((size_t)((j * DECB + (srU >> 2)) * 512 + 508) * 256 + (kc0 - 512)) * 4; ST_F32X8(op + lo_w, v0, v1); } )
            }
        } else {
            const unsigned lo = (unsigned)((rowL * 48 + colL) * 4);
            if (colL < 48) {
#pragma unroll
                for (int ai = 0; ai < 2; ++ai)
#pragma unroll
                    for (int m = 0; m < 4; ++m) { const int rowU = u.pm * BM + ai * HALF + m * 16; char* op = (char*)G32 + (size_t)rowU * 48 * 4;
                        f32x4 a = acc[ai][0][m][0], b = acc[ai][0][m][1];
#pragma unroll
                        for (int e = 0; e < 4; ++e) { a[e] = sigm(a[e]); b[e] = sigm(b[e]); }
                        ST_F32X8(op + lo, a, b); }
            }
        }
    }
};

struct EpiResid {
    const float* base; float* pre;
    __device__ __forceinline__ void operator()(const f32x4 (&acc)[2][2][4][2], const Unit& u, int wr, int wc, int fr, int fq) const {
        const unsigned lo = (unsigned)(((wr * 64 + fr) * D + wc * 32 + 8 * fq) * 4);
        EPI_PIECES(
            const size_t uo = ((size_t)rowU * D + u.pn * BM + bj * HALF) * 4; const char* bp = (const char*)base + uo; char* op = (char*)pre + uo;
            const f32x4 b0 = *(const f32x4*)(bp + lo), b1 = *(const f32x4*)(bp + lo + 16);
            ST_F32X8(op + lo, b0 * ALPHA + v0, b1 * ALPHA + v1); )
    }
};

struct EpiUp {
    bf16_t* U; float* out; int layer;
    __device__ __forceinline__ void operator()(const f32x4 (&acc)[2][2][4][2], const Unit& u, int wr, int wc, int fr, int fq) const {
        const bool samp = u.pm >= MP / BM; const int rowL = wr * 64 + fr, colL = wc * 32 + 8 * fq;
        const unsigned lo = (unsigned)((rowL * 6144 + colL) * 2);
        EPI_PIECES(
            const int ncU = bj * DFF + u.pn * 128;
            char* op = (char*)U + ((size_t)rowU * 6144 + ncU) * 2; *(u32x4*)(op + lo) = pack8(v0, v1);
            if (!samp) { if ((u.pm & 7) == 7 && ai == 1 && m == 3 && rowL >= 64 + 14) { const int b = u.pm >> 3, tt = rowL - (64 + 14);
                    float* o = out + O_FCP + ((size_t)(layer * BATCH + b) * 2 + tt) * 6144 + ncU + colL; ST_F32X8((char*)o, v0, v1); } }
            else { const int sr = rowU - MP + rowL, b = sr >> 2, s = sr & 3;
                if (s >= 2) { float* o = out + O_FCS + ((size_t)(layer * DECB + b) * 2 + (s - 2)) * 6144 + ncU + colL; ST_F32X8((char*)o, v0, v1); } } )
    }
};

struct EpiPle {
    const float* h2; const bf16_t* pp; float* x32; bf16_t* xb; float* out; int last;
    __device__ __forceinline__ void operator()(const f32x4 (&acc)[2][2][4][2], const Unit& u, int wr, int wc, int fr, int fq) const {
        const unsigned le = (unsigned)((wr * 64 + fr) * D + wc * 32 + 8 * fq);
        EPI_PIECES(
            const size_t ue = (size_t)rowU * D + u.pn * BM + bj * HALF;
            const char* hp = (const char*)h2 + ue * 4; const char* ppp = (const char*)pp + ue * 2;
            const f32x4 h0 = *(const f32x4*)(hp + le * 4), h1 = *(const f32x4*)(hp + le * 4 + 16); const u32x4 pw = *(const u32x4*)(ppp + le * 2);
            f32x4 r0; f32x4 r1;
            r0[0] = h0[0] + sigm(v0[0]) * bflo(pw.x); r0[1] = h0[1] + sigm(v0[1]) * bfhi(pw.x); r0[2] = h0[2] + sigm(v0[2]) * bflo(pw.y); r0[3] = h0[3] + sigm(v0[3]) * bfhi(pw.y);
            r1[0] = h1[0] + sigm(v1[0]) * bflo(pw.z); r1[1] = h1[1] + sigm(v1[1]) * bfhi(pw.z); r1[2] = h1[2] + sigm(v1[2]) * bflo(pw.w); r1[3] = h1[3] + sigm(v1[3]) * bfhi(pw.w);
            if (last) { char* op = (char*)(out + O_YP) + ue * 4; ST_F32X8(op + le * 4, r0, r1); }
            else { char* xp = (char*)x32 + ue * 4; ST_F32X8(xp + le * 4, r0, r1); char* bp = (char*)xb + ue * 2; *(u32x4*)(bp + le * 2) = pack8(r0, r1); } )
    }
};

struct EpiRgIn {
    bf16_t* GG; bf16_t* RECB; float* out; int j;
    __device__ __forceinline__ void operator()(const f32x4 (&acc)[2][2][4][2], const Unit& u, int wr, int wc, int fr, int fq) const {
        const bool samp = u.pm >= MP / BM; const int rowL = wr * 64 + fr, colL = wc * 32 + 8 * fq;
        const unsigned lo = (unsigned)((rowL * D + colL) * 2);
        if (u.pn < 4) {
            EPI_PIECES( char* op = (char*)GG + ((size_t)rowU * D + u.pn * BM + bj * HALF) * 2; f32x4 a = v0; f32x4 b = v1;
                _Pragma("unroll") for (int e = 0; e < 4; ++e) { a[e] = gelu_t(a[e]); b[e] = gelu_t(b[e]); }
                *(u32x4*)(op + lo) = pack8(a, b); )
        } else {
            EPI_PIECES(
                const int cU = (u.pn - 4) * BM + bj * HALF;
                char* op = (char*)RECB + ((size_t)rowU * D + cU) * 2; *(u32x4*)(op + lo) = pack8(v0, v1);
                if (!samp) { if ((u.pm & 7) == 7 && ai == 1 && m == 3 && rowL >= 64 + 13) { const int b = u.pm >> 3, tt = rowL - (64 + 13);
                        float* o = out + O_RCP + ((size_t)(j * BATCH + b) * 3 + tt) * D + cU + colL; ST_F32X8((char*)o, v0, v1); } }
                else { const int sr = rowU - MP + rowL, b = sr >> 2, s = sr & 3;
                    if (s >= 1) { float* o = out + O_RCS + ((size_t)(j * DECB + b) * 3 + (s - 1)) * D + cU + colL; ST_F32X8((char*)o, v0, v1); } } )
        }
    }
};

struct EpiRgGate {
    float* AA; float* UU;
    __device__ __forceinline__ void operator()(const f32x4 (&acc)[2][2][4][2], const Unit& u, int wr, int wc, int fr, int fq) const {
        const unsigned lo = (unsigned)(((wr * 64 + fr) * D + wc * 32 + 8 * fq) * 4); const int cU = (u.pn >> 1) * 256 + (u.pn & 1) * 128;
        EPI_PIECES( char* op = (char*)(bj ? UU : AA) + ((size_t)rowU * D + cU) * 4; ST_F32X8(op + lo, v0, v1); )
    }
};
}

#define XB_TMO      128
#define XB_XCNT(j)  (256  + 64 * (j))
#define XB_XSUB(j)  (1280 + 64 * (j))
#define XB_XGEN(j)  (2304 + 64 * (j))
#define XB_TOP      3328
#define XB_TOPGEN   3392
#define XCD_BAR_WORDS 3456
#define XB_SPIN_CAP (1u << 18)
__device__ __forceinline__ unsigned xb_ld(unsigned* p)              { return __hip_atomic_load(p, __ATOMIC_RELAXED, __HIP_MEMORY_SCOPE_AGENT); }
__device__ __forceinline__ unsigned xb_add(unsigned* p, unsigned v) { return __hip_atomic_fetch_add(p, v, __ATOMIC_RELAXED, __HIP_MEMORY_SCOPE_AGENT); }
__device__ __forceinline__ unsigned xb_xcc_id() { return (unsigned)__builtin_amdgcn_s_getreg((3 << 11) | 20) & 0xFu; }
#define XB_SPIN(cond, bar) do { unsigned _sp = 0; while (cond) { __builtin_amdgcn_s_sleep(1); \
    if ((++_sp & 255u) == 0u) { if (xb_ld(&(bar)[XB_TMO])) break; if (_sp > XB_SPIN_CAP) { atomicAdd(&(bar)[XB_TMO], 1u); break; } } } } while (0)
struct XcdBarrier { unsigned* bar; unsigned x; volatile LAS unsigned* st; };
__device__ __forceinline__ XcdBarrier xcd_barrier_post(unsigned* bar, volatile LAS unsigned* st) {
    XcdBarrier b; b.bar = bar; b.x = xb_xcc_id(); b.st = st;
    if (threadIdx.x == 0) (void)xb_add(&bar[XB_XCNT(b.x)], 1u);
    return b;
}
__device__ __forceinline__ void xcd_barrier_complete(unsigned* bar, unsigned x, unsigned& nloc, unsigned& nx) {
    const unsigned G = gridDim.x * gridDim.y * gridDim.z;
    unsigned sum, cnt, mine, sp = 0u;
    for (;;) {
        sum = 0u; cnt = 0u; mine = 0u;
#pragma unroll
        for (unsigned j = 0; j < 16; ++j) { const unsigned c = xb_ld(&bar[XB_XCNT(j)]); sum += c; cnt += (c > 0u) ? 1u : 0u; mine = (j == x) ? c : mine; }
        if (sum == G) break;
        __builtin_amdgcn_s_sleep(1);
        if ((++sp & 255u) == 0u) { if (xb_ld(&bar[XB_TMO])) break; if (sp > XB_SPIN_CAP) { atomicAdd(&bar[XB_TMO], 1u); break; } }
    }
    nloc = mine > 0u ? mine : 1u; nx = cnt > 0u ? cnt : 1u;
}
__device__ __forceinline__ void xcd_barrier(const XcdBarrier& b) {
    asm volatile("s_waitcnt vmcnt(0)" ::: "memory");
    __syncthreads();
    if (threadIdx.x == 0) {
        unsigned* bar = b.bar;
        __builtin_amdgcn_s_waitcnt(0);
        unsigned nloc = b.st[0], nx = b.st[1];
        if (nloc == 0u) { xcd_barrier_complete(bar, b.x, nloc, nx); b.st[0] = nloc; b.st[1] = nx; }
        const unsigned old = xb_add(&bar[XB_XSUB(b.x)], 1u);
        const unsigned gen = old / nloc;
        if (old + 1u == (gen + 1u) * nloc) {
            __builtin_amdgcn_fence(__ATOMIC_RELEASE, "agent");
            asm volatile("s_waitcnt vmcnt(0)" ::: "memory");
            const unsigned og = xb_add(&bar[XB_TOP], 1u);
            const unsigned tg = og / nx;
            if (og + 1u == (tg + 1u) * nx) xb_add(&bar[XB_TOPGEN], 1u);
            else XB_SPIN(xb_ld(&bar[XB_TOPGEN]) == tg, bar);
            __builtin_amdgcn_fence(__ATOMIC_ACQUIRE, "agent");
            xb_add(&bar[XB_XGEN(b.x)], 1u);
            asm volatile("s_waitcnt vmcnt(0)" ::: "memory");
        } else {
            XB_SPIN(xb_ld(&bar[XB_XGEN(b.x)]) == gen, bar);
            __builtin_amdgcn_fence(__ATOMIC_ACQUIRE, "agent");
            asm volatile("s_waitcnt vmcnt(0)" ::: "memory");
        }
    }
    __syncthreads();
}

struct Args { const void* in[35]; float* out; unsigned char* ws; int ph_lo, ph_hi; };
struct Frame {
    LAS unsigned char* lds; int tid, lane, wave, vcu, G;
    unsigned char* ws; float* out;
};
__device__ __forceinline__ float wave_sum(float v) {
#pragma unroll
    for (int o = 1; o < 64; o <<= 1) v += __shfl_xor(v, o);
    return v;
}

__device__ __forceinline__ const void* in_ptr(int k) {
    const void* const __attribute__((address_space(4)))* p = (const void* const __attribute__((address_space(4)))*)__builtin_amdgcn_kernarg_segment_ptr();
    asm volatile("" : "+s"(k));
    return p[k];
}
__device__ __forceinline__ void tr_item(const float* W, int ldw, int k0, int n_src0, int n_valid, bf16_t* WT, int ldt, int dst_row0, LAS float* scr, int lane) {
#pragma unroll 8
    for (int i = 0; i < 32; ++i) { const int kk = 2 * i + (lane >> 5), nn = lane & 31; scr[kk * 33 + nn] = (nn < n_valid) ? W[(size_t)(k0 + kk) * ldw + n_src0 + nn] : 0.f; }
    LDS_WAIT(); asm volatile("" ::: "memory");
    const int c = lane & 7;
#pragma unroll
    for (int jj = 0; jj < 4; ++jj) { const int n = (lane >> 3) + 8 * jj; const LAS float* s = scr + (8 * c) * 33 + n;
        u32x4 o; o.x = pk2(s[0 * 33], s[1 * 33]); o.y = pk2(s[2 * 33], s[3 * 33]); o.z = pk2(s[4 * 33], s[5 * 33]); o.w = pk2(s[6 * 33], s[7 * 33]);
        *(u32x4*)(WT + (size_t)(dst_row0 + n) * ldt + k0 + 8 * c) = o; }
    LDS_WAIT(); asm volatile("" ::: "memory");
}

__device__ __forceinline__ void p0_prologue(Frame& F) {
    unsigned char* ws = F.ws;
    LAS float* scr = (LAS float*)(F.lds + F.wave * 16384);
    const int gw = F.vcu * NWAVES + F.wave, NGW = F.G * NWAVES, lane = F.lane;
    constexpr int I_NSA_IN = 16 * 64, I_SQ = 16 * 32, I_CMP1 = 32 * 8, I_CMP2 = 4 * 2, I_RG_IN = 16 * 64, I_RG_G = 4 * 8, I_UP = 16 * 192, I_DOWN = 48 * 32, I_PROJ = 4 * 32;
    constexpr int NITEMS = 2 * I_NSA_IN + 2 * I_SQ + 4 * I_CMP1 + 4 * I_CMP2 + 2 * I_RG_IN + 16 * I_RG_G + 2 * I_SQ + 4 * I_UP + 4 * I_DOWN + 4 * I_PROJ + 4 * I_SQ;
    for (int it = gw; it < NITEMS; it += NGW) {
        int r = it;
        if (r < 2 * I_NSA_IN) { const int j = r / I_NSA_IN, q = r % I_NSA_IN, kb = q / 64, nb = q % 64; const int nv = NSA_N - 32 * nb;
            tr_item((const float*)in_ptr(10) + (size_t)j * 1024 * NSA_N, NSA_N, 64 * kb, 32 * nb, nv < 0 ? 0 : (nv > 32 ? 32 : nv), (bf16_t*)(ws + WS_W_NSA_IN) + (size_t)j * NSA_NP * 1024, 1024, 32 * nb, scr, lane); continue; } r -= 2 * I_NSA_IN;
        if (r < 2 * I_SQ) { const int j = r / I_SQ, q = r % I_SQ, kb = q / 32, nb = q % 32;
            tr_item((const float*)in_ptr(11) + (size_t)j * 1024 * 1024, 1024, 64 * kb, 32 * nb, 32, (bf16_t*)(ws + WS_W_NSA_OUT) + (size_t)j * 1024 * 1024, 1024, 32 * nb, scr, lane); continue; } r -= 2 * I_SQ;
        if (r < 4 * I_CMP1) { const int mt = r / I_CMP1, q = r % I_CMP1, kb = q / 8, nb = q % 8;
            tr_item((const float*)in_ptr(13) + (size_t)mt * 2048 * 256, 256, 64 * kb, 32 * nb, 32, (bf16_t*)(ws + WS_W_CMP1) + (size_t)mt * 256 * 2048, 2048, 32 * nb, scr, lane); continue; } r -= 4 * I_CMP1;
        if (r < 4 * I_CMP2) { const int mt = r / I_CMP2, q = r % I_CMP2, kb = q / 2, nb = q % 2;
            tr_item((const float*)in_ptr(15) + (size_t)mt * 256 * 64, 64, 64 * kb, 32 * nb, 32, (bf16_t*)(ws + WS_W_CMP2) + (size_t)mt * 64 * 256, 256, 32 * nb, scr, lane); continue; } r -= 4 * I_CMP2;
        if (r < 2 * I_RG_IN) { const int j = r / I_RG_IN, q = r % I_RG_IN, kb = q / 64, nb = q % 64;
            tr_item((const float*)in_ptr(16) + (size_t)j * 1024 * 2048, 2048, 64 * kb, 32 * nb, 32, (bf16_t*)(ws + WS_W_RG_IN) + (size_t)j * 2048 * 1024, 1024, 32 * nb, scr, lane); continue; } r -= 2 * I_RG_IN;
        if (r < 16 * I_RG_G) { const int mt = r / I_RG_G, q = r % I_RG_G, kb = q / 8, nt = q % 8; const int j = mt >> 3, src = (mt >> 2) & 1, nb = mt & 3;
            const float* W = (const float*)in_ptr(src ? 21 : 19) + (size_t)(j * 4 + nb) * 256 * 256;
            tr_item(W, 256, 64 * kb, 32 * nt, 32, (bf16_t*)(ws + WS_W_RG_G) + (size_t)j * 8 * 256 * 256, 256, (nb * 2 + nt / 4) * 256 + src * 128 + (nt % 4) * 32, scr, lane); continue; } r -= 16 * I_RG_G;
        if (r < 2 * I_SQ) { const int j = r / I_SQ, q = r % I_SQ, kb = q / 32, nb = q % 32;
            tr_item((const float*)in_ptr(24) + (size_t)j * 1024 * 1024, 1024, 64 * kb, 32 * nb, 32, (bf16_t*)(ws + WS_W_RG_OUT) + (size_t)j * 1024 * 1024, 1024, 32 * nb, scr, lane); continue; } r -= 2 * I_SQ;
        if (r < 4 * I_UP) { const int i = r / I_UP, q = r % I_UP, kb = q / 192, nt = q % 192; const int n0 = 32 * nt, half = n0 / DFF, within = n0 % DFF;
            tr_item((const float*)in_ptr(25) + (size_t)i * 1024 * 6144, 6144, 64 * kb, n0, 32, (bf16_t*)(ws + WS_W_UP) + (size_t)i * 6144 * 1024, 1024, (within / 128) * 256 + half * 128 + (within % 128), scr, lane); continue; } r -= 4 * I_UP;
        if (r < 4 * I_DOWN) { const int i = r / I_DOWN, q = r % I_DOWN, kb = q / 32, nb = q % 32;
            tr_item((const float*)in_ptr(28) + (size_t)i * 3072 * 1024, 1024, 64 * kb, 32 * nb, 32, (bf16_t*)(ws + WS_W_DOWN) + (size_t)i * 1024 * 3072, 3072, 32 * nb, scr, lane); continue; } r -= 4 * I_DOWN;
        if (r < 4 * I_PROJ) { const int i = r / I_PROJ, q = r % I_PROJ, kb = q / 32, nb = q % 32;
            tr_item((const float*)in_ptr(33) + (size_t)i * 256 * 1024, 1024, 64 * kb, 32 * nb, 32, (bf16_t*)(ws + WS_W_PROJ) + (size_t)i * 1024 * 256, 256, 32 * nb, scr, lane); continue; } r -= 4 * I_PROJ;
        { const int i = r / I_SQ, q = r % I_SQ, kb = q / 32, nb = q % 32;
            tr_item((const float*)in_ptr(34) + (size_t)i * 1024 * 1024, 1024, 64 * kb, 32 * nb, 32, (bf16_t*)(ws + WS_W_GATE) + (size_t)i * 1024 * 1024, 1024, 32 * nb, scr, lane); }
    }
    for (int m = gw; m < MT; m += NGW) {
        const float* src = (m < MP) ? (const float*)in_ptr(0) + (size_t)m * D : (const float*)in_ptr(1) + (size_t)(m - MP) * D;
        float* x32 = (float*)(ws + WS_X32) + (size_t)m * D; bf16_t* xb = (bf16_t*)(ws + WS_XB) + (size_t)m * D;
#pragma unroll
        for (int jj = 0; jj < 4; ++jj) { const f32x4 v = *((const f32x4*)src + lane + 64 * jj); *((f32x4*)x32 + lane + 64 * jj) = v;
            u32x2 w; w.x = pk2(v[0], v[1]); w.y = pk2(v[2], v[3]); *((u32x2*)xb + lane + 64 * jj) = w; }
    }
    for (int rr = gw; rr < 4 * MT; rr += NGW) { const int i = rr / MT, m = rr % MT;
        const float* src = (m < MP) ? (const float*)in_ptr(8) + ((size_t)i * MP + m) * DPLE : (const float*)in_ptr(9) + ((size_t)i * MS + (m - MP)) * DPLE;
        const f32x4 v = *((const f32x4*)src + lane); u32x2 w; w.x = pk2(v[0], v[1]); w.y = pk2(v[2], v[3]);
        *((u32x2*)((bf16_t*)(ws + WS_PB) + (size_t)rr * DPLE) + lane) = w; }
    { const int* pt = (const int*)in_ptr(7); const float* ckv = (const float*)in_ptr(2); bf16_t* cs = (bf16_t*)(ws + WS_CS);
      const int kv = lane >> 5, gg = (lane >> 4) & 1, c4 = lane & 15;
      for (int rr = gw; rr < 2 * DECB * PAST; rr += NGW) { const int layer = rr / (DECB * PAST), q = rr % (DECB * PAST), b = q / PAST, t = q % PAST;
          const int page = pt[b * NPAGES + (t >> 7)];
          const f32x4 v = *((const f32x4*)(ckv + ((size_t)(layer * NPOOL + page) * PAGE + (t & 127)) * 512) + lane);
          u32x2 w; w.x = pk2(v[0], v[1]); w.y = pk2(v[2], v[3]);
          *(u32x2*)(cs + ((size_t)(((layer * 2 + kv) * DECB + b) * 2 + gg) * PAST + t) * 64 + c4 * 4) = w; } }
    for (int it = gw; it < 4 * 4 * 32; it += NGW) { const int mt = it >> 7, hc = (it >> 5) & 3, sl = it & 31; const int h = hc * 64 + lane;
        const float* pe = (const float*)in_ptr(12) + (size_t)mt * 2048; const float* w1 = (const float*)in_ptr(13) + (size_t)mt * 2048 * 256;
        float s = 0.f;
#pragma unroll 8
        for (int k = 0; k < 64; ++k) { const int kk = sl * 64 + k; s += pe[kk] * w1[(size_t)kk * 256 + h]; }
        ((float*)(ws + WS_B1PART))[(mt * 32 + sl) * 256 + h] = s; }
    { const f32x4* src = (const f32x4*)in_ptr(3); f32x4* dst = (f32x4*)(F.out + O_WINS);
      const size_t per = (size_t)508 * 64, tot = (size_t)2 * DECB * per;
      for (size_t e = (size_t)gw * 64 + lane; e < tot; e += (size_t)NGW * 64) { const size_t jb = e / per, q = e % per; dst[jb * (512 * 64) + q] = src[jb * (512 * 64) + 4 * 64 + q]; } }
}

__device__ __forceinline__ void load_b1p(Frame& F) {
    LAS float* tb = (LAS float*)(F.lds + LDS_B1P_OFF); const float* part = (const float*)(F.ws + WS_B1PART);
    for (int o = F.tid; o < 1024; o += 512) { const int mt = o >> 8, h = o & 255; float s = ((const float*)in_ptr(14))[o];
        for (int sl = 0; sl < 32; ++sl) s += part[(mt * 32 + sl) * 256 + h];
        tb[o] = s; }
    __syncthreads();
}

__device__ __forceinline__ void cmp_stage2(Frame& F, const bf16_t* hid, const bf16_t* w2t_base, int rows_per_mat, int nrows, bf16_t* outp) {
    const int gw = F.vcu * NWAVES + F.wave, NGW = F.G * NWAVES, lane = F.lane, r32 = lane & 31, hi = lane >> 5;
    for (int task = gw; task < nrows / 32; task += NGW) { const int R0 = task * 32; const bf16_t* w2t = w2t_base + (size_t)(R0 / rows_per_mat) * 64 * 256;
        f32x16 o0 = {0}, o1 = {0};
#pragma unroll 4
        for (int ks = 0; ks < 16; ++ks) {
            const bf16x8 hf = *(const bf16x8*)(hid + (size_t)(R0 + r32) * 256 + 16 * ks + 8 * hi);
            const bf16x8 w0 = *(const bf16x8*)(w2t + (size_t)r32 * 256 + 16 * ks + 8 * hi), w1 = *(const bf16x8*)(w2t + (size_t)(32 + r32) * 256 + 16 * ks + 8 * hi);
            o0 = __builtin_amdgcn_mfma_f32_32x32x16_bf16(w0, hf, o0, 0, 0, 0); o1 = __builtin_amdgcn_mfma_f32_32x32x16_bf16(w1, hf, o1, 0, 0, 0); }
        bf16_t* op = outp + (size_t)(R0 + r32) * 64;
#pragma unroll
        for (int k4 = 0; k4 < 4; ++k4) { u32x2 w; w.x = pk2(o0[4 * k4], o0[4 * k4 + 1]); w.y = pk2(o0[4 * k4 + 2], o0[4 * k4 + 3]); *(u32x2*)(op + 8 * k4 + 4 * hi) = w;
            u32x2 w2; w2.x = pk2(o1[4 * k4], o1[4 * k4 + 1]); w2.y = pk2(o1[4 * k4 + 2], o1[4 * k4 + 3]); *(u32x2*)(op + 32 + 8 * k4 + 4 * hi) = w2; } }
}

__device__ __forceinline__ void ln_phase(Frame& F, const float* pre, const float* g, const float* bta, float* h32, bf16_t* hb) {
    const int gw = F.vcu * NWAVES + F.wave, NGW = F.G * NWAVES, lane = F.lane;
    f32x4 gv[4], bv[4];
#pragma unroll
    for (int jj = 0; jj < 4; ++jj) { gv[jj] = *((const f32x4*)g + lane + 64 * jj); bv[jj] = *((const f32x4*)bta + lane + 64 * jj); }
    for (int m = gw; m < MT; m += NGW) {
        const f32x4* xr = (const f32x4*)(pre + (size_t)m * D) + lane; f32x4 v[4]; float s = 0.f;
#pragma unroll
        for (int jj = 0; jj < 4; ++jj) { v[jj] = xr[64 * jj]; s += (v[jj][0] + v[jj][1]) + (v[jj][2] + v[jj][3]); }
        const float mean = wave_sum(s) * (1.f / D); float s2 = 0.f;
#pragma unroll
        for (int jj = 0; jj < 4; ++jj) { v[jj] = v[jj] - mean; s2 += (v[jj][0] * v[jj][0] + v[jj][1] * v[jj][1]) + (v[jj][2] * v[jj][2] + v[jj][3] * v[jj][3]); }
        const float rstd = 1.f / sqrtf(wave_sum(s2) * (1.f / D) + LN_EPS);
#pragma unroll
        for (int jj = 0; jj < 4; ++jj) { const f32x4 y = v[jj] * rstd * gv[jj] + bv[jj]; *((f32x4*)(h32 + (size_t)m * D) + lane + 64 * jj) = y;
            u32x2 w; w.x = pk2(y[0], y[1]); w.y = pk2(y[2], y[3]); *((u32x2*)(hb + (size_t)m * D) + lane + 64 * jj) = w; }
    }
}

__device__ __forceinline__ void unpack8(const u32x4& w, float (&f)[8]) { f[0] = bflo(w.x); f[1] = bfhi(w.x); f[2] = bflo(w.y); f[3] = bfhi(w.y); f[4] = bflo(w.z); f[5] = bfhi(w.z); f[6] = bflo(w.w); f[7] = bfhi(w.w); }

__device__ __forceinline__ void ffn_conv_phase(Frame& F, const bf16_t* U, const float* cw, const float* cb, const float* state  , bf16_t* ACT) {
    const int gt = F.vcu * 512 + F.tid, NT = F.G * 512;
    constexpr int CG = DFF / 8;
    constexpr int NPI = (MP / 16) * CG;
    constexpr int NSI = DECB * CG;
    for (int it = gt; it < NPI + NSI; it += NT) {
        const bool samp = it >= NPI; const int q = samp ? it - NPI : it; const int cg = q % CG, rc = q / CG, c = cg * 8;
        float w[2][3][8], bb[2][8];
#pragma unroll
        for (int h = 0; h < 2; ++h) {
#pragma unroll
            for (int k = 0; k < 3; ++k) { const f32x4 a = *(const f32x4*)(cw + (size_t)k * 6144 + h * DFF + c), b = *(const f32x4*)(cw + (size_t)k * 6144 + h * DFF + c + 4);
#pragma unroll
                for (int e = 0; e < 4; ++e) { w[h][k][e] = a[e]; w[h][k][4 + e] = b[e]; } }
            const f32x4 a = *(const f32x4*)(cb + h * DFF + c), b = *(const f32x4*)(cb + h * DFF + c + 4);
#pragma unroll
            for (int e = 0; e < 4; ++e) { bb[h][e] = a[e]; bb[h][4 + e] = b[e]; } }
        float p2[2][8], p1[2][8];
        int row0, nrows;
        if (!samp) { row0 = rc * 16; nrows = 16; const int t0 = row0 & 2047;
#pragma unroll
            for (int h = 0; h < 2; ++h) {
                if (t0 == 0) {
#pragma unroll
                    for (int e = 0; e < 8; ++e) { p2[h][e] = 0.f; p1[h][e] = 0.f; } }
                else { unpack8(*(const u32x4*)(U + (size_t)(row0 - 2) * 6144 + h * DFF + c), p2[h]); unpack8(*(const u32x4*)(U + (size_t)(row0 - 1) * 6144 + h * DFF + c), p1[h]); } } }
        else { row0 = MP + rc * 4; nrows = 4;
#pragma unroll
            for (int h = 0; h < 2; ++h) { const float* s0 = state + ((size_t)rc * 2 + 0) * 6144 + h * DFF + c; const float* s1 = state + ((size_t)rc * 2 + 1) * 6144 + h * DFF + c;
#pragma unroll
                for (int e = 0; e < 8; ++e) { p2[h][e] = s0[e]; p1[h][e] = s1[e]; } } }
        for (int r = 0; r < nrows; ++r) {
            float cur[2][8], res[8];
            unpack8(*(const u32x4*)(U + (size_t)(row0 + r) * 6144 + c), cur[0]); unpack8(*(const u32x4*)(U + (size_t)(row0 + r) * 6144 + DFF + c), cur[1]);
#pragma unroll
            for (int e = 0; e < 8; ++e) {
                const float ua = bb[0][e] + p2[0][e] * w[0][0][e] + p1[0][e] * w[0][1][e] + cur[0][e] * w[0][2][e];
                const float ub = bb[1][e] + p2[1][e] * w[1][0][e] + p1[1][e] * w[1][1][e] + cur[1][e] * w[1][2][e];
                res[e] = gelu_t(ua) * ub; p2[0][e] = p1[0][e]; p1[0][e] = cur[0][e]; p2[1][e] = p1[1][e]; p1[1][e] = cur[1][e]; }
            u32x4 o; o.x = pk2(res[0], res[1]); o.y = pk2(res[2], res[3]); o.z = pk2(res[4], res[5]); o.w = pk2(res[6], res[7]);
            *(u32x4*)(ACT + (size_t)(row0 + r) * DFF + c) = o; }
    }
}

__device__ __forceinline__ void rg_conv_phase(Frame& F, const bf16_t* RECB, const float* cw  , const float* cb, const float* state  , bf16_t* REC) {
    const int gt = F.vcu * 512 + F.tid, NT = F.G * 512;
    constexpr int CG = D / 8; constexpr int NPI = (MP / 16) * CG, NSI = DECB * CG;
    for (int it = gt; it < NPI + NSI; it += NT) {
        const bool samp = it >= NPI; const int q = samp ? it - NPI : it; const int cg = q % CG, rc = q / CG, c = cg * 8;
        float w[4][8], bb[8];
#pragma unroll
        for (int k = 0; k < 4; ++k) {
#pragma unroll
            for (int e = 0; e < 8; ++e) w[k][e] = cw[k * D + c + e]; }
#pragma unroll
        for (int e = 0; e < 8; ++e) bb[e] = cb[c + e];
        float p3[8], p2[8], p1[8]; int row0, nrows;
        if (!samp) { row0 = rc * 16; nrows = 16; const int t0 = row0 & 2047;
            if (t0 == 0) {
#pragma unroll
                for (int e = 0; e < 8; ++e) { p3[e] = 0.f; p2[e] = 0.f; p1[e] = 0.f; } }
            else { unpack8(*(const u32x4*)(RECB + (size_t)(row0 - 3) * D + c), p3); unpack8(*(const u32x4*)(RECB + (size_t)(row0 - 2) * D + c), p2); unpack8(*(const u32x4*)(RECB + (size_t)(row0 - 1) * D + c), p1); } }
        else { row0 = MP + rc * 4; nrows = 4;
#pragma unroll
            for (int e = 0; e < 8; ++e) { p3[e] = state[((size_t)rc * 3 + 0) * D + c + e]; p2[e] = state[((size_t)rc * 3 + 1) * D + c + e]; p1[e] = state[((size_t)rc * 3 + 2) * D + c + e]; } }
        for (int r = 0; r < nrows; ++r) {
            float cur[8], res[8]; unpack8(*(const u32x4*)(RECB + (size_t)(row0 + r) * D + c), cur);
#pragma unroll
            for (int e = 0; e < 8; ++e) { res[e] = bb[e] + p3[e] * w[0][e] + p2[e] * w[1][e] + p1[e] * w[2][e] + cur[e] * w[3][e]; p3[e] = p2[e]; p2[e] = p1[e]; p1[e] = cur[e]; }
            u32x4 o; o.x = pk2(res[0], res[1]); o.y = pk2(res[2], res[3]); o.z = pk2(res[4], res[5]); o.w = pk2(res[6], res[7]);
            *(u32x4*)(REC + (size_t)(row0 + r) * D + c) = o; }
    }
}

struct RgCoef { float gab, gxb, sp; };
__device__ __forceinline__ RgCoef rg_coef(const float* ga_b, const float* gx_b, const float* lam, int c) { RgCoef k; k.gab = ga_b[c]; k.gxb = gx_b[c]; k.sp = -8.f * log1pf(__expf(-lam[c])); return k; }
__device__ __forceinline__ void rg_au(const RgCoef& k, float pa, float px, float rec, float& a, float& u) {
    const float r = sigm(pa + k.gab), ig = sigm(px + k.gxb), la = k.sp * r; a = __expf(la); u = sqrtf(-expm1f(2.f * la)) * ig * rec; }
__device__ __forceinline__ void scan1_phase(Frame& F, const float* AA, const float* UU, const bf16_t* REC, const float* ga_b, const float* gx_b, const float* lam, float* CA, float* CH) {
    for (int it = F.vcu; it < BATCH * 32 * 2; it += F.G) { const int bc = it >> 1, c = (it & 1) * 512 + F.tid; const int b = bc >> 5, ch = bc & 31;
        const RgCoef k = rg_coef(ga_b, gx_b, lam, c);
        const size_t r0 = (size_t)b * SEQ + ch * 64; float a = 1.f, h = 0.f;
#pragma unroll 4
        for (int t = 0; t < 64; ++t) { float at, ut; rg_au(k, AA[(r0 + t) * D + c], UU[(r0 + t) * D + c], bf2f(REC[(r0 + t) * D + c]), at, ut); h = at * h + ut; a *= at; }
        CA[(size_t)bc * D + c] = a; CH[(size_t)bc * D + c] = h; }
}
__device__ __forceinline__ void scan2_phase(Frame& F, const float* AA, const float* UU, const bf16_t* REC, const float* ga_b, const float* gx_b, const float* lam, const float* CA, const float* CH, const bf16_t* GG, bf16_t* HG, const float* h0s  , float* out, int j) {
    constexpr int NPI = BATCH * 32 * 2, NSI = DECB * 2;
    for (int it = F.vcu; it < NPI + NSI; it += F.G) {
        if (it < NPI) { const int bc = it >> 1, c = (it & 1) * 512 + F.tid; const int b = bc >> 5, ch = bc & 31;
            const RgCoef k = rg_coef(ga_b, gx_b, lam, c);
            float h = 0.f;
            for (int kk = 0; kk < ch; ++kk) h = CA[(size_t)(b * 32 + kk) * D + c] * h + CH[(size_t)(b * 32 + kk) * D + c];
            const size_t r0 = (size_t)b * SEQ + ch * 64;
#pragma unroll 4
            for (int t = 0; t < 64; ++t) { float at, ut; rg_au(k, AA[(r0 + t) * D + c], UU[(r0 + t) * D + c], bf2f(REC[(r0 + t) * D + c]), at, ut); h = at * h + ut;
                HG[(r0 + t) * D + c] = (bf16_t)f2bf(h * bf2f(GG[(r0 + t) * D + c])); }
            if (ch == 31) out[O_HP + (size_t)(j * BATCH + b) * D + c] = h; }
        else { const int q = it - NPI, b = q >> 1, c = (q & 1) * 512 + F.tid; float h = h0s[(size_t)b * D + c];
            const RgCoef k = rg_coef(ga_b, gx_b, lam, c);
#pragma unroll
            for (int s = 0; s < 4; ++s) { const size_t r = (size_t)MP + b * 4 + s; float at, ut; rg_au(k, AA[r * D + c], UU[r * D + c], bf2f(REC[r * D + c]), at, ut); h = at * h + ut; HG[r * D + c] = (bf16_t)f2bf(h * bf2f(GG[r * D + c])); }
            out[O_HS + (size_t)(j * DECB + b) * D + c] = h; }
    }
}

namespace att {
__device__ __forceinline__ int crow(int r, int hi) { return (r & 3) + 8 * (r >> 2) + 4 * hi; }
__device__ __forceinline__ int koff(int key, int c16) { return key * 128 + ((c16 ^ ((key >> 1) & 7)) << 4); }
__device__ __forceinline__ int voff8(int key, int c8) { return key * 128 + ((c8 ^ (((key >> 1) & 1) << 3)) << 3); }
__device__ __forceinline__ float pmax(float v) { auto rr = __builtin_amdgcn_permlane32_swap(__float_as_uint(v), __float_as_uint(v), false, false); return fmaxf(__uint_as_float(rr[0]), __uint_as_float(rr[1])); }
__device__ __forceinline__ float psum(float v) { auto rr = __builtin_amdgcn_permlane32_swap(__float_as_uint(v), __float_as_uint(v), false, false); return __uint_as_float(rr[0]) + __uint_as_float(rr[1]); }
__device__ __forceinline__ float pother(float v, int hi) { auto rr = __builtin_amdgcn_permlane32_swap(__float_as_uint(v), __float_as_uint(v), false, false); return hi ? __uint_as_float(rr[0]) : __uint_as_float(rr[1]); }
typedef short v4i16_t __attribute__((ext_vector_type(4)));
__device__ __forceinline__ s16x4 vtr(const LAS unsigned char* p) { return __builtin_bit_cast(s16x4, __builtin_amdgcn_ds_read_tr16_b64_v4i16((LAS v4i16_t*)p)); }

__device__ __forceinline__ f32x16 s_tile(const LAS unsigned char* Kt, int key0, const bf16x8 (&qf)[4], int lane) {
    const int kq = lane & 31, hi = lane >> 5; f32x16 s = {0};
#pragma unroll
    for (int ks = 0; ks < 4; ++ks) { const bf16x8 kf = *(const LAS bf16x8*)(Kt + koff(key0 + kq, 2 * ks + hi)); s = __builtin_amdgcn_mfma_f32_32x32x16_bf16(kf, qf[ks], s, 0, 0, 0); }
    return s;
}
__device__ __forceinline__ void pv_tile(const LAS unsigned char* Vt, int key0, const f32x16& p, f32x16 (&o)[2], int lane) {
    const int hi = lane >> 5, gI = (lane >> 4) & 1, l15 = lane & 15, qp = l15 >> 2, pp = l15 & 3;
    unsigned pk[8];
#pragma unroll
    for (int i = 0; i < 8; ++i) pk[i] = pk2(p[2 * i], p[2 * i + 1]);
#pragma unroll
    for (int st = 0; st < 2; ++st) { const u32x4 pw = {pk[4 * st], pk[4 * st + 1], pk[4 * st + 2], pk[4 * st + 3]}; const bf16x8 pb = __builtin_bit_cast(bf16x8, pw);
#pragma unroll
        for (int dt = 0; dt < 2; ++dt) { const int c8 = 8 * dt + 4 * gI + pp, k1 = key0 + 16 * st + 4 * hi + qp;
            const s16x4 lo = vtr(Vt + voff8(k1, c8)), h4 = vtr(Vt + voff8(k1 + 8, c8));
            const bf16x8 vf = {lo[0], lo[1], lo[2], lo[3], h4[0], h4[1], h4[2], h4[3]};
            o[dt] = __builtin_amdgcn_mfma_f32_32x32x16_bf16(vf, pb, o[dt], 0, 0, 0); } }
}
template <class VF>
__device__ __forceinline__ void flash32(const LAS unsigned char* Kt, const LAS unsigned char* Vt, int key0, const bf16x8 (&qf)[4], float& m, float& l, f32x16 (&o)[2], int lane, VF valid) {
    f32x16 s = s_tile(Kt, key0, qf, lane); const int hi = lane >> 5;
    float tm = -1e30f;
#pragma unroll
    for (int r = 0; r < 16; ++r) { const bool v = valid(crow(r, hi)); s[r] = v ? s[r] : -1e30f; tm = fmaxf(tm, s[r]); }
    tm = pmax(tm);
    const float mn = fmaxf(m, tm), f = ex2(m - mn); m = mn;
    float ps = 0.f;
#pragma unroll
    for (int r = 0; r < 16; ++r) { const float p = s[r] > -1e29f ? ex2(s[r] - mn) : 0.f; s[r] = p; ps += p; }
    l = l * f + ps;
#pragma unroll
    for (int r = 0; r < 16; ++r) { o[0][r] *= f; o[1][r] *= f; }
    pv_tile(Vt, key0, s, o, lane);
}

constexpr int P_KT0 = 0, P_VT0 = 8192, P_KT1 = 16384, P_VT1 = 24576, P_KC = 32768, P_VC = 49152, P_IMP = 65536, P_IMPS = 98304, P_SELM = 102400;

__device__ __forceinline__ void stage_kv64(LAS unsigned char* Kt, LAS unsigned char* Vt, const u32x4& rk, const u32x4& rv, int tid) {
    const int key = tid >> 3, c16 = tid & 7;
    *(LAS u32x4*)(Kt + koff(key, c16)) = rk; *(LAS u32x4*)(Vt + key * 128 + ((c16 ^ (((key >> 1) & 1) << 2)) << 4)) = rv;
}

__device__ __forceinline__ void nsa_prompt_item(LAS unsigned char* lds, int b, int qblk, int g, const bf16_t* QB, const bf16_t* KV6, const bf16_t* KCP, const float* G32, bf16_t* OB) {
    int tid_ = threadIdx.x; asm volatile("" : "+v"(tid_));
    const int tid = tid_, lane = tid & 63, w = __builtin_amdgcn_readfirstlane(tid >> 6), q = lane & 31, hi = lane >> 5;
    const int t0 = 32 * qblk, t = t0 + q, cur = qblk >> 1, head = 8 * g + w; const size_t m = (size_t)b * SEQ + t;
#pragma unroll
    for (int i = 0; i < 2; ++i) { const int idx = tid + 512 * i, key = idx >> 3, c16 = idx & 7;
        const u32x4 kk = *(const u32x4*)(KCP + ((size_t)((0 * 16 + b * 2 + g) * 128 + key)) * 64 + c16 * 8), vv = *(const u32x4*)(KCP + ((size_t)((1 * 16 + b * 2 + g) * 128 + key)) * 64 + c16 * 8);
        *(LAS u32x4*)(lds + P_KC + koff(key, c16)) = kk; *(LAS u32x4*)(lds + P_VC + key * 128 + ((c16 ^ (((key >> 1) & 1) << 2)) << 4)) = vv; }
    bf16x8 qf[4];
#pragma unroll
    for (int ks = 0; ks < 4; ++ks) qf[ks] = *(const bf16x8*)(QB + m * 1024 + head * 64 + 16 * ks + 8 * hi);
    const float g0 = G32[m * 48 + g * 24 + w * 3 + 0], g1 = G32[m * 48 + g * 24 + w * 3 + 1], g2 = G32[m * 48 + g * 24 + w * 3 + 2];
    __syncthreads();
    f32x16 otot[2];
    {
        f32x16 s[4]; float mx = -1e30f;
#pragma unroll
        for (int tl = 0; tl < 4; ++tl) { s[tl] = s_tile(lds + P_KC, 32 * tl, qf, lane);
#pragma unroll
            for (int r = 0; r < 16; ++r) { const int c = 32 * tl + crow(r, hi); const bool v = (16 * c + 31 <= t); s[tl][r] = v ? s[tl][r] : -1e30f; mx = fmaxf(mx, s[tl][r]); } }
        mx = pmax(mx); float sum = 0.f;
#pragma unroll
        for (int tl = 0; tl < 4; ++tl)
#pragma unroll
            for (int r = 0; r < 16; ++r) { const float e = s[tl][r] > -1e29f ? ex2(s[tl][r] - mx) : 0.f; s[tl][r] = e; sum += e; }
        sum = psum(sum); const float inv = 1.f / fmaxf(sum, 1e-30f);
        float G[16], lastv[16];
#pragma unroll
        for (int tl = 0; tl < 4; ++tl)
#pragma unroll
            for (int k = 0; k < 4; ++k) { float a = 0.f;
#pragma unroll
                for (int i = 0; i < 4; ++i) { s[tl][4 * k + i] *= inv; a += s[tl][4 * k + i]; }
                G[4 * tl + k] = a; lastv[4 * tl + k] = s[tl][4 * k + 3]; }
        float oth[16];
#pragma unroll
        for (int i = 0; i < 16; ++i) oth[i] = pother(lastv[i], hi);
        LAS float* imp = (LAS float*)(lds + P_IMP) + (w * 32 + q) * 32;
#pragma unroll
        for (int i = 0; i < 16; ++i) { const int tl = i >> 2, k = i & 3; const int n = 2 * k + hi + 8 * tl;
            const float prev = hi ? oth[i] : (i ? oth[i - 1] : 0.f); imp[n] = G[i] + prev; }
        f32x16 oc[2] = {{0}, {0}};
#pragma unroll
        for (int tl = 0; tl < 4; ++tl) pv_tile(lds + P_VC, 32 * tl, s[tl], oc, lane);
        otot[0] = oc[0] * g0; otot[1] = oc[1] * g0;
    }
    __syncthreads();
    {
        const int qq = lane >> 4, n2 = lane & 15, qs = 4 * w + qq;
        LAS float* imps = (LAS float*)(lds + P_IMPS) + qs * 32; float val[2];
#pragma unroll
        for (int e = 0; e < 2; ++e) { const int n = n2 + 16 * e; float v = 0.f;
#pragma unroll
            for (int ww = 0; ww < 8; ++ww) v += ((LAS float*)(lds + P_IMP))[(ww * 32 + qs) * 32 + n];
            if (n == 0 || n == cur || n == cur - 1) v = 1e6f;
            if (n > cur) v = -1.f;
            val[e] = v; imps[n] = v; }
        LDS_WAIT(); asm volatile("" ::: "memory");
        int rank0 = 0, rank1 = 0;
        for (int np = 0; np < 32; ++np) { const float vp = imps[np];
            rank0 += (vp > val[0] || (vp == val[0] && np < n2)) ? 1 : 0; rank1 += (vp > val[1] || (vp == val[1] && np < n2 + 16)) ? 1 : 0; }
        const unsigned long long b0 = __ballot(rank0 < 16), b1 = __ballot(rank1 < 16);
        const unsigned mask = (unsigned)((b0 >> (16 * qq)) & 0xffffull) | ((unsigned)((b1 >> (16 * qq)) & 0xffffull) << 16);
        if (n2 == 0) ((LAS unsigned*)(lds + P_SELM))[qs] = mask;
    }
    __syncthreads();
    const unsigned mymask = ((LAS unsigned*)(lds + P_SELM))[q];
    unsigned um = mymask;
#pragma unroll
    for (int o = 1; o < 32; o <<= 1) um |= (unsigned)__shfl_xor((int)um, o);
    um = (unsigned)__builtin_amdgcn_readfirstlane((int)um);
    const bf16_t* Ksel = KV6 + ((size_t)((2 * 8 + b) * 2 + g) * 2048) * 64; const bf16_t* Vsel = KV6 + ((size_t)((3 * 8 + b) * 2 + g) * 2048) * 64;
    const bf16_t* Kwin = KV6 + ((size_t)((4 * 8 + b) * 2 + g) * 2048) * 64; const bf16_t* Vwin = KV6 + ((size_t)((5 * 8 + b) * 2 + g) * 2048) * 64;
    const int ldoff = (tid >> 3) * 64 + (tid & 7) * 8;
    {
        unsigned rem = um & (cur == 31 ? 0xffffffffu : ((1u << (cur + 1)) - 1u));
        float mm = -1e30f, ll = 0.f; f32x16 o[2] = {{0}, {0}};
        int n = __builtin_ctz(rem); rem &= rem - 1;
        u32x4 rk = *(const u32x4*)(Ksel + (size_t)n * 4096 + ldoff), rv = *(const u32x4*)(Vsel + (size_t)n * 4096 + ldoff);
        int buf = 0;
        for (;;) {
            LAS unsigned char* Kt = lds + (buf ? P_KT1 : P_KT0); LAS unsigned char* Vt = lds + (buf ? P_VT1 : P_VT0);
            stage_kv64(Kt, Vt, rk, rv, tid);
            __syncthreads();
            const int nn = rem ? __builtin_ctz(rem) : -1;
            if (nn >= 0) { rem &= rem - 1; rk = *(const u32x4*)(Ksel + (size_t)nn * 4096 + ldoff); rv = *(const u32x4*)(Vsel + (size_t)nn * 4096 + ldoff); }
            const bool selq = (mymask >> n) & 1u;
#pragma unroll
            for (int hf = 0; hf < 2; ++hf) { const int kb = 64 * n + 32 * hf;
                flash32(Kt, Vt, 32 * hf, qf, mm, ll, o, lane, [&](int kk) { return selq && (kb + kk <= t); }); }
            if (nn < 0) break;
            n = nn; buf ^= 1;
        }
        ll = psum(ll); const float sc = g1 / fmaxf(ll, 1e-30f);
        otot[0] += o[0] * sc; otot[1] += o[1] * sc;
    }
    __syncthreads();
    {
        const int nlo = cur - 8 < 0 ? 0 : cur - 8;
        float mm = -1e30f, ll = 0.f; f32x16 o[2] = {{0}, {0}};
        u32x4 rk = *(const u32x4*)(Kwin + (size_t)nlo * 4096 + ldoff), rv = *(const u32x4*)(Vwin + (size_t)nlo * 4096 + ldoff);
        int buf = 0;
        for (int n = nlo; n <= cur; ++n) {
            LAS unsigned char* Kt = lds + (buf ? P_KT1 : P_KT0); LAS unsigned char* Vt = lds + (buf ? P_VT1 : P_VT0);
            stage_kv64(Kt, Vt, rk, rv, tid);
            __syncthreads();
            if (n < cur) { rk = *(const u32x4*)(Kwin + (size_t)(n + 1) * 4096 + ldoff); rv = *(const u32x4*)(Vwin + (size_t)(n + 1) * 4096 + ldoff); }
#pragma unroll
            for (int hf = 0; hf < 2; ++hf) { const int kb = 64 * n + 32 * hf;
                flash32(Kt, Vt, 32 * hf, qf, mm, ll, o, lane, [&](int kk) { const int key = kb + kk; return key <= t && key >= t - 512; }); }
            buf ^= 1;
        }
        ll = psum(ll); const float sc = g2 / fmaxf(ll, 1e-30f);
        otot[0] += o[0] * sc; otot[1] += o[1] * sc;
    }
    bf16_t* op = OB + m * 1024 + head * 64;
#pragma unroll
    for (int dt = 0; dt < 2; ++dt)
#pragma unroll
        for (int k4 = 0; k4 < 4; ++k4) { u32x2 wv; wv.x = pk2(otot[dt][4 * k4], otot[dt][4 * k4 + 1]); wv.y = pk2(otot[dt][4 * k4 + 2], otot[dt][4 * k4 + 3]);
            *(u32x2*)(op + 32 * dt + 8 * k4 + 4 * hi) = wv; }
    __syncthreads();
}

constexpr int S_TILE = 0  , S_OBUF = 0  , S_KC = 65536, S_VC = 81920, S_PBUF = 98304  ,
              S_MST = 114688  , S_LST = 115712, S_IMPS = 116736  , S_SELF = 117376  ;

__device__ __forceinline__ void s_write_partial(LAS unsigned char* lds, int w, int lane, float mm, float ll, const f32x16 (&o)[2]) {
    const int j = lane & 31, hi = lane >> 5;
    if (hi == 0) { ((LAS float*)(lds + S_MST))[w * 32 + j] = mm; ((LAS float*)(lds + S_LST))[w * 32 + j] = ll; }
    LAS float* ob = (LAS float*)(lds + S_OBUF) + w * 2048;
#pragma unroll
    for (int dt = 0; dt < 2; ++dt)
#pragma unroll
        for (int r = 0; r < 16; ++r) ob[(32 * dt + crow(r, hi)) * 32 + j] = o[dt][r];
}
__device__ __forceinline__ void s_merge(LAS unsigned char* lds, int nw, int tid, float gate, float (&acc)[4]) {
    const int j = tid & 31; const LAS float* ms = (const LAS float*)(lds + S_MST); const LAS float* ls = (const LAS float*)(lds + S_LST);
    float M = -1e30f;
    for (int w = 0; w < nw; ++w) M = fmaxf(M, ms[w * 32 + j]);
    float L = 0.f, wt[8];
    for (int w = 0; w < 8; ++w) { wt[w] = (w < nw) ? ex2(ms[w * 32 + j] - M) : 0.f; if (w < nw) L += ls[w * 32 + j] * wt[w]; }
    const float sc = gate / fmaxf(L, 1e-30f);
#pragma unroll
    for (int i = 0; i < 4; ++i) { const int d = (tid >> 5) + 16 * i; float v = 0.f;
        for (int w = 0; w < nw; ++w) v += ((const LAS float*)(lds + S_OBUF))[w * 2048 + d * 32 + j] * wt[w];
        acc[i] += v * sc; }
}
__device__ __forceinline__ void s_load_half_f32(LAS unsigned char* Kt, LAS unsigned char* Vt, const float* ksrc, const float* vsrc, size_t rstride, int nvalid, int lane) {
    const int kr = lane >> 4, c = lane & 15;
#pragma unroll
    for (int i = 0; i < 8; ++i) { const int key = 4 * i + kr; f32x4 kv = {0.f, 0.f, 0.f, 0.f}, vv = {0.f, 0.f, 0.f, 0.f};
        if (key < nvalid) { kv = *(const f32x4*)(ksrc + (size_t)key * rstride + 4 * c); vv = *(const f32x4*)(vsrc + (size_t)key * rstride + 4 * c); }
        u32x2 kw; kw.x = pk2(kv[0], kv[1]); kw.y = pk2(kv[2], kv[3]); u32x2 vw; vw.x = pk2(vv[0], vv[1]); vw.y = pk2(vv[2], vv[3]);
        *(LAS u32x2*)(Kt + koff(key, c >> 1) + 8 * (c & 1)) = kw; *(LAS u32x2*)(Vt + voff8(key, c)) = vw; }
}
__device__ __forceinline__ void s_load_rows_bf16(LAS unsigned char* Kt, LAS unsigned char* Vt, int key0, const bf16_t* ksrc, const bf16_t* vsrc, size_t rstride, int nvalid, int lane) {
    const int kr = lane >> 4, c = lane & 15;
    for (int i = 0; i < 8; ++i) { const int kk = 4 * i + kr; if (kk >= nvalid) break;
        const u32x2 kw = *(const u32x2*)(ksrc + (size_t)kk * rstride + 4 * c), vw = *(const u32x2*)(vsrc + (size_t)kk * rstride + 4 * c);
        *(LAS u32x2*)(Kt + koff(key0 + kk, c >> 1) + 8 * (c & 1)) = kw; *(LAS u32x2*)(Vt + voff8(key0 + kk, c)) = vw; }
}

__device__ __forceinline__ void nsa_sample_item(LAS unsigned char* lds, int b, int g, int layer, const bf16_t* QB, const bf16_t* KVS, const bf16_t* KCS, const float* G32,
                                                const float* ckv, const float* cwin, const int* pt, bf16_t* OB) {
    int tid_ = threadIdx.x; asm volatile("" : "+v"(tid_));
    const int tid = tid_, lane = tid & 63, w = __builtin_amdgcn_readfirstlane(tid >> 6), j = lane & 31, hi = lane >> 5, qy = j >> 3, hh = j & 7;
    const size_t ms = (size_t)MP + 4 * b + qy; const int head = 8 * g + hh;
#pragma unroll
    for (int i = 0; i < 2; ++i) { const int idx = tid + 512 * i, key = idx >> 3, c16 = idx & 7;
        const u32x4 kk = *(const u32x4*)(KCS + ((size_t)((((layer * 2 + 0) * DECB + b) * 2 + g) * 128 + key)) * 64 + c16 * 8), vv = *(const u32x4*)(KCS + ((size_t)((((layer * 2 + 1) * DECB + b) * 2 + g) * 128 + key)) * 64 + c16 * 8);
        *(LAS u32x4*)(lds + S_KC + koff(key, c16)) = kk; *(LAS u32x4*)(lds + S_VC + key * 128 + ((c16 ^ (((key >> 1) & 1) << 2)) << 4)) = vv; }
    bf16x8 qf[4];
#pragma unroll
    for (int ks = 0; ks < 4; ++ks) qf[ks] = *(const bf16x8*)(QB + ms * 1024 + head * 64 + 16 * ks + 8 * hi);
    const float g0 = G32[ms * 48 + g * 24 + hh * 3 + 0], g1 = G32[ms * 48 + g * 24 + hh * 3 + 1], g2 = G32[ms * 48 + g * 24 + hh * 3 + 2];
    float acc[4] = {0.f, 0.f, 0.f, 0.f};
    __syncthreads();
    if (w < 4) {
        f32x16 s = s_tile(lds + S_KC, 32 * w, qf, lane); float mx = -1e30f;
#pragma unroll
        for (int r = 0; r < 16; ++r) { const int c = 32 * w + crow(r, hi); s[r] = (c < 127) ? s[r] : -1e30f; mx = fmaxf(mx, s[r]); }
        mx = pmax(mx); float sum = 0.f;
#pragma unroll
        for (int r = 0; r < 16; ++r) { const float e = s[r] > -1e29f ? ex2(s[r] - mx) : 0.f; s[r] = e; sum += e; ((LAS float*)(lds + S_PBUF))[(32 * w + crow(r, hi)) * 32 + j] = e; }
        sum = psum(sum);
        f32x16 o[2] = {{0}, {0}}; pv_tile(lds + S_VC, 32 * w, s, o, lane);
        s_write_partial(lds, w, lane, mx, sum, o);
    }
    __syncthreads();
    s_merge(lds, 4, tid, g0, acc);
    if (tid < 132) { const int q4 = tid / 33, n = tid % 33; float v = 0.f;
        const LAS float* msb = (const LAS float*)(lds + S_MST); const LAS float* lsb = (const LAS float*)(lds + S_LST);
        for (int h8 = 0; h8 < 8; ++h8) { const int jj = 8 * q4 + h8; float M = -1e30f;
            for (int ww = 0; ww < 4; ++ww) M = fmaxf(M, msb[ww * 32 + jj]);
            float L = 0.f; for (int ww = 0; ww < 4; ++ww) L += lsb[ww * 32 + jj] * ex2(msb[ww * 32 + jj] - M);
            float a = 0.f;
            for (int c = 4 * n - 1; c <= 4 * n + 3; ++c) if (c >= 0 && c < 127) a += ((const LAS float*)(lds + S_PBUF))[c * 32 + jj] * ex2(msb[(c >> 5) * 32 + jj] - M);
            v += a / fmaxf(L, 1e-30f); }
        if (n == 0 || n == 32 || n == 31) v = 1e6f;
        ((LAS float*)(lds + S_IMPS))[q4 * 33 + n] = v; }
    __syncthreads();
    if (tid < 132) { const int q4 = tid / 33, n = tid % 33; const float v = ((const LAS float*)(lds + S_IMPS))[q4 * 33 + n]; int rank = 0;
        for (int np = 0; np < 33; ++np) { const float vp = ((const LAS float*)(lds + S_IMPS))[q4 * 33 + np]; rank += (vp > v || (vp == v && np < n)) ? 1 : 0; }
        ((LAS unsigned*)(lds + S_SELF))[q4 * 33 + n] = rank < 16 ? 1u : 0u; }
    __syncthreads();
    unsigned long long mymask = 0ull, um = 0ull;
    for (int n = 0; n < 33; ++n) { const LAS unsigned* sf = (const LAS unsigned*)(lds + S_SELF);
        if (sf[qy * 33 + n]) mymask |= 1ull << n;
        if (sf[n] | sf[33 + n] | sf[66 + n] | sf[99 + n]) um |= 1ull << n; }
    LAS unsigned char* Kt = lds + S_TILE + w * 8192; LAS unsigned char* Vt = Kt + 4096;
    {
        float mm = -1e30f, ll = 0.f; f32x16 o[2] = {{0}, {0}}; int idx = 0;
        for (int n = 0; n < 33; ++n) { if (!((um >> n) & 1ull)) continue;
            for (int hf = 0; hf < 2; ++hf) { if (n == 32 && hf == 1) break;
                if ((idx++ & 7) != w) continue;
                if (n < 32) { const int page = pt[b * NPAGES + (n >> 1)]; const float* base = ckv + ((size_t)(layer * NPOOL + page) * PAGE + (n & 1) * 64 + 32 * hf) * 512 + g * 64;
                    s_load_half_f32(Kt, Vt, base + 2 * 128, base + 3 * 128, 512, 32, lane); }
                else { s_load_half_f32(Kt, Vt, nullptr, nullptr, 0, 0, lane); LDS_WAIT();
                    s_load_rows_bf16(Kt, Vt, 0, KVS + (size_t)(4 * b) * 768 + 2 * 128 + g * 64, KVS + (size_t)(4 * b) * 768 + 3 * 128 + g * 64, 768, 4, lane); }
                LDS_WAIT(); asm volatile("" ::: "memory");
                const bool selq = (mymask >> n) & 1ull; const int pos0 = 64 * n + 32 * hf;
                flash32(Kt, Vt, 0, qf, mm, ll, o, lane, [&](int kk) { return selq && (pos0 + kk <= PAST + qy); });
                LDS_WAIT(); asm volatile("" ::: "memory"); } }
        ll = psum(ll);
        __syncthreads();
        s_write_partial(lds, w, lane, mm, ll, o);
        __syncthreads();
        s_merge(lds, 8, tid, g1, acc);
        __syncthreads();
    }
    {
        float mm = -1e30f, ll = 0.f; f32x16 o[2] = {{0}, {0}};
        for (int ht = w; ht < 17; ht += 8) {
            if (ht < 16) { const float* base = cwin + ((size_t)(layer * DECB + b) * 512 + 32 * ht) * 256 + g * 64; s_load_half_f32(Kt, Vt, base, base + 128, 256, 32, lane); }
            else { s_load_half_f32(Kt, Vt, nullptr, nullptr, 0, 0, lane); LDS_WAIT();
                s_load_rows_bf16(Kt, Vt, 0, KVS + (size_t)(4 * b) * 768 + 4 * 128 + g * 64, KVS + (size_t)(4 * b) * 768 + 5 * 128 + g * 64, 768, 4, lane); }
            LDS_WAIT(); asm volatile("" ::: "memory");
            const int i0 = 32 * ht;
            flash32(Kt, Vt, 0, qf, mm, ll, o, lane, [&](int kk) { const int ix = i0 + kk; return ix >= qy && ix <= 512 + qy; });
            LDS_WAIT(); asm volatile("" ::: "memory"); }
        ll = psum(ll);
        __syncthreads();
        s_write_partial(lds, w, lane, mm, ll, o);
        __syncthreads();
        s_merge(lds, 8, tid, g2, acc);
    }
    { const int jj = tid & 31; const size_t mr = (size_t)MP + 4 * b + (jj >> 3); const int hd = 8 * g + (jj & 7);
#pragma unroll
      for (int i = 0; i < 4; ++i) { const int d = (tid >> 5) + 16 * i; OB[mr * 1024 + hd * 64 + d] = (bf16_t)f2bf(acc[i]); } }
    __syncthreads();
}
}

constexpr int N_PHASES = 4 + 4 * 12;
__global__ void __launch_bounds__(NWAVES * 64, 2) mega_fwd(Args args) {
    extern __shared__ __attribute__((aligned(16))) unsigned char lds_raw[];
    Frame F;
    F.lds = (LAS unsigned char*)lds_raw; F.tid = threadIdx.x; F.lane = F.tid & 63; F.wave = __builtin_amdgcn_readfirstlane(F.tid >> 6);
    F.G = gridDim.x; { const int bx = blockIdx.x; F.vcu = (F.G % 8 == 0) ? (bx % 8) * (F.G / 8) + bx / 8 : bx; }
    F.ws = args.ws; F.out = args.out;
    unsigned char* ws0 = args.ws; float* out0 = args.out; int layer0 = 0;
#define PH_LOCALS unsigned char* ws = ws0; asm volatile("" : "+s"(ws)); float* outl = out0; asm volatile("" : "+s"(outl)); int layer = layer0; asm volatile("" : "+s"(layer)); const int j = layer >> 1; (void)j; int bx = (int)blockIdx.x; asm volatile("" : "+s"(bx)); (void)bx; F.ws = ws; F.out = outl; { const int G_ = F.G; F.vcu = (G_ % 8 == 0) ? (bx % 8) * (G_ / 8) + bx / 8 : bx; } { int t_ = threadIdx.x; asm volatile("" : "+v"(t_)); F.tid = t_; F.lane = t_ & 63; F.wave = __builtin_amdgcn_readfirstlane(t_ >> 6); }
    for (int u = F.tid; u < (LDS_BYTES - LDSCTL_OFF) / 4; u += NWAVES * 64) ((LAS unsigned*)(F.lds + LDSCTL_OFF))[u] = 0u;
    __syncthreads();
    const int lo = args.ph_lo, hi = args.ph_hi;
    XcdBarrier bar = xcd_barrier_post((unsigned*)(ws0 + WS_CTL) + CW_BAR, (volatile LAS unsigned*)(F.lds + MISC_OFF) + 8);
    int ph = 0;
#define IN_PH() (lo <= ph && ph < hi)
#ifndef ONLY_SITE
#define SITE(k) true
#else
#define SITE(k) ((k) == ONLY_SITE)
#endif
#define END_PH() do { if (lo <= ph && ph + 1 < hi) xcd_barrier(bar); ++ph; } while (0)

#ifndef SKIP_P0
    if (IN_PH() && SITE(1)) { PH_LOCALS; p0_prologue(F); }
#endif
    END_PH();
    if (IN_PH() && SITE(2)) { PH_LOCALS;
        { pg8::Gemm g{(const bf16_t*)(ws + WS_PB), (const bf16_t*)(ws + WS_W_PROJ), DPLE, DPLE, DPLE}; pg8::Sched S; S.init(4 * MT / 256, 4, F.G, bx, DPLE, DPLE);
          S.b_pm_mul = pg8::Sched::rmul(MT / 256); S.b_pm_bytes = (long)1024 * DPLE * 2;
          pg8::EpiBf16G<false> E{(bf16_t*)(ws + WS_PP), D, nullptr, 0};
          pg8::gemm_phase(F.lds, g, S, E); }
    }
    END_PH();
    if (IN_PH() && SITE(21)) { PH_LOCALS;
        load_b1p(F);
        { pg8::Gemm g{(const bf16_t*)(ws + WS_CS), (const bf16_t*)(ws + WS_W_CMP1), 1024, 2048, 2048}; pg8::Sched S; S.init(512, 1, F.G, bx, 1024, 2048);
          S.b_pm_mul = pg8::Sched::rmul(128); S.b_pm_bytes = (long)256 * 2048 * 2;
          pg8::EpiBf16G<true> E{(bf16_t*)(ws + WS_HIDS), 256, (const LAS float*)(F.lds + LDS_B1P_OFF), 7};
          pg8::gemm_phase(F.lds, g, S, E); }
    }
    END_PH();
    if (IN_PH() && SITE(3)) { PH_LOCALS; cmp_stage2(F, (const bf16_t*)(ws + WS_HIDS), (const bf16_t*)(ws + WS_W_CMP2), 32768, 131072, (bf16_t*)(ws + WS_KCS)); }
    END_PH();

    for (layer0 = 0; layer0 < DEPTH; ++layer0) {
        if ((layer0 & 1) == 0) {
            if (IN_PH() && SITE(4)) { PH_LOCALS;
                pg8::Gemm g{(const bf16_t*)(ws + WS_XB), (const bf16_t*)(ws + WS_W_NSA_IN) + (size_t)j * NSA_NP * 1024, D, D, D}; pg8::Sched S; S.init(MT / 256, NSA_NP / 256, F.G, bx, D, D);
                pg8::EpiNsaIn E{(bf16_t*)(ws + WS_QB), (bf16_t*)(ws + WS_KV6), (bf16_t*)(ws + WS_KVS), (float*)(ws + WS_G32), F.out, j};
                pg8::gemm_phase(F.lds, g, S, E);
            }
            END_PH();
            if (IN_PH() && SITE(5)) { PH_LOCALS;
                load_b1p(F);
                pg8::Gemm g{(const bf16_t*)(ws + WS_KV6), (const bf16_t*)(ws + WS_W_CMP1) + (size_t)j * 2 * 256 * 2048, 1024, 2048, 2048}; pg8::Sched S; S.init(16, 1, F.G, bx, 1024, 2048);
                S.b_pm_mul = pg8::Sched::rmul(8); S.b_pm_bytes = (long)256 * 2048 * 2;
                pg8::EpiBf16G<true> E{(bf16_t*)(ws + WS_HIDP), 256, (const LAS float*)(F.lds + LDS_B1P_OFF) + j * 512, 3};
                pg8::gemm_phase(F.lds, g, S, E);
            }
            END_PH();
            if (IN_PH() && SITE(6)) { PH_LOCALS; cmp_stage2(F, (const bf16_t*)(ws + WS_HIDP), (const bf16_t*)(ws + WS_W_CMP2) + (size_t)j * 2 * 64 * 256, 2048, 4096, (bf16_t*)(ws + WS_KCP)); }
            END_PH();
            if (IN_PH() && SITE(7)) { PH_LOCALS;
                for (int it = F.vcu; it < 1024; it += F.G) { const int k = it >> 8, a16 = (it >> 4) & 15, bg = it & 15;
                    const int qblk = k == 0 ? 63 - a16 : k == 1 ? 32 + a16 : k == 2 ? 31 - a16 : a16;
                    att::nsa_prompt_item(F.lds, bg >> 1, qblk, bg & 1, (const bf16_t*)(ws + WS_QB), (const bf16_t*)(ws + WS_KV6), (const bf16_t*)(ws + WS_KCP), (const float*)(ws + WS_G32), (bf16_t*)(ws + WS_OB)); }
            }
            END_PH();
            if (IN_PH() && SITE(22)) { PH_LOCALS;
                for (int q = F.vcu; q < 256; q += F.G)
                    att::nsa_sample_item(F.lds, q >> 1, q & 1, j, (const bf16_t*)(ws + WS_QB), (const bf16_t*)(ws + WS_KVS), (const bf16_t*)(ws + WS_KCS), (const float*)(ws + WS_G32),
                                         (const float*)in_ptr(2), (const float*)in_ptr(3), (const int*)in_ptr(7), (bf16_t*)(ws + WS_OB));
            }
            END_PH();
            if (IN_PH() && SITE(8)) { PH_LOCALS;
                pg8::Gemm g{(const bf16_t*)(ws + WS_OB), (const bf16_t*)(ws + WS_W_NSA_OUT) + (size_t)j * D * D, D, D, D}; pg8::Sched S; S.init(MT / 256, 4, F.G, bx, D, D);
                pg8::EpiResid E{(const float*)(ws + WS_X32), (float*)(ws + WS_PRE)};
                pg8::gemm_phase(F.lds, g, S, E);
            }
            END_PH();
        } else {
            if (IN_PH() && SITE(9)) { PH_LOCALS;
                pg8::Gemm g{(const bf16_t*)(ws + WS_XB), (const bf16_t*)(ws + WS_W_RG_IN) + (size_t)j * 2048 * D, D, D, D}; pg8::Sched S; S.init(MT / 256, 8, F.G, bx, D, D);
                pg8::EpiRgIn E{(bf16_t*)(ws + WS_GG), (bf16_t*)(ws + WS_RECB), F.out, j};
                pg8::gemm_phase(F.lds, g, S, E);
            }
            END_PH();
            if (IN_PH() && SITE(10)) { PH_LOCALS; rg_conv_phase(F, (const bf16_t*)(ws + WS_RECB), (const float*)in_ptr(17) + (size_t)j * 4 * D, (const float*)in_ptr(18) + (size_t)j * D,
                                         (const float*)in_ptr(5) + (size_t)j * DECB * 3 * D, (bf16_t*)(ws + WS_REC)); }
            END_PH();
            if (IN_PH() && SITE(11)) { PH_LOCALS;
                pg8::Gemm g{(const bf16_t*)(ws + WS_REC), (const bf16_t*)(ws + WS_W_RG_G) + (size_t)j * 8 * 256 * 256, D, 256, 256}; pg8::Sched S; S.init(MT / 256, 8, F.G, bx, D, 256);
                S.a_pn_mul = pg8::Sched::rmul(2); S.a_pn_bytes = 256 * 2;
                pg8::EpiRgGate E{(float*)(ws + WS_AA), (float*)(ws + WS_UU)};
                pg8::gemm_phase(F.lds, g, S, E);
            }
            END_PH();
            if (IN_PH() && SITE(12)) { PH_LOCALS; scan1_phase(F, (const float*)(ws + WS_AA), (const float*)(ws + WS_UU), (const bf16_t*)(ws + WS_REC), (const float*)in_ptr(20) + (size_t)j * D, (const float*)in_ptr(22) + (size_t)j * D, (const float*)in_ptr(23) + (size_t)j * D, (float*)(ws + WS_CA), (float*)(ws + WS_CH)); }
            END_PH();
            if (IN_PH() && SITE(13)) { PH_LOCALS; scan2_phase(F, (const float*)(ws + WS_AA), (const float*)(ws + WS_UU), (const bf16_t*)(ws + WS_REC), (const float*)in_ptr(20) + (size_t)j * D, (const float*)in_ptr(22) + (size_t)j * D, (const float*)in_ptr(23) + (size_t)j * D, (const float*)(ws + WS_CA), (const float*)(ws + WS_CH), (const bf16_t*)(ws + WS_GG), (bf16_t*)(ws + WS_HG),
                                       (const float*)in_ptr(4) + (size_t)j * DECB * D, F.out, j); }
            END_PH();
            if (IN_PH() && SITE(14)) { PH_LOCALS;
                pg8::Gemm g{(const bf16_t*)(ws + WS_HG), (const bf16_t*)(ws + WS_W_RG_OUT) + (size_t)j * D * D, D, D, D}; pg8::Sched S; S.init(MT / 256, 4, F.G, bx, D, D);
                pg8::EpiResid E{(const float*)(ws + WS_X32), (float*)(ws + WS_PRE)};
                pg8::gemm_phase(F.lds, g, S, E);
            }
            END_PH();
        }
        if (IN_PH() && SITE(15)) { PH_LOCALS; ln_phase(F, (const float*)(ws + WS_PRE), (const float*)in_ptr(29) + (size_t)layer * D, (const float*)in_ptr(30) + (size_t)layer * D, (float*)(ws + WS_H32), (bf16_t*)(ws + WS_HB)); }
        END_PH();
        if (IN_PH() && SITE(16)) { PH_LOCALS;
            pg8::Gemm g{(const bf16_t*)(ws + WS_HB), (const bf16_t*)(ws + WS_W_UP) + (size_t)layer * 6144 * D, D, D, D}; pg8::Sched S; S.init(MT / 256, 24, F.G, bx, D, D);
            pg8::EpiUp E{(bf16_t*)(ws + WS_U), F.out, layer};
            pg8::gemm_phase(F.lds, g, S, E);
        }
        END_PH();
        if (IN_PH() && SITE(17)) { PH_LOCALS; ffn_conv_phase(F, (const bf16_t*)(ws + WS_U), (const float*)in_ptr(26) + (size_t)layer * 3 * 6144, (const float*)in_ptr(27) + (size_t)layer * 6144,
                                      (const float*)in_ptr(6) + (size_t)layer * DECB * 2 * 6144, (bf16_t*)(ws + WS_ACT)); }
        END_PH();
        if (IN_PH() && SITE(18)) { PH_LOCALS;
            pg8::Gemm g{(const bf16_t*)(ws + WS_ACT), (const bf16_t*)(ws + WS_W_DOWN) + (size_t)layer * D * DFF, DFF, DFF, DFF}; pg8::Sched S; S.init(MT / 256, 4, F.G, bx, DFF, DFF);
            pg8::EpiResid E{(const float*)(ws + WS_H32), (float*)(ws + WS_PRE)};
            pg8::gemm_phase(F.lds, g, S, E);
        }
        END_PH();
        if (IN_PH() && SITE(19)) { PH_LOCALS; ln_phase(F, (const float*)(ws + WS_PRE), (const float*)in_ptr(31) + (size_t)layer * D, (const float*)in_ptr(32) + (size_t)layer * D, (float*)(ws + WS_H32), (bf16_t*)(ws + WS_HB)); }
        END_PH();
        if (IN_PH() && SITE(20)) { PH_LOCALS;
            pg8::Gemm g{(const bf16_t*)(ws + WS_HB), (const bf16_t*)(ws + WS_W_GATE) + (size_t)layer * D * D, D, D, D}; pg8::Sched S; S.init(MT / 256, 4, F.G, bx, D, D);
            pg8::EpiPle E{(const float*)(ws + WS_H32), (const bf16_t*)(ws + WS_PP) + (size_t)layer * MT * D, (float*)(ws + WS_X32), (bf16_t*)(ws + WS_XB), F.out, layer == DEPTH - 1 ? 1 : 0};
            pg8::gemm_phase(F.lds, g, S, E);
        }
        END_PH();
    }
}

extern "C" void kernel_launch(void* const* d_in, const int* in_sizes, int n_in, void* d_out, int out_size, void* d_ws, size_t ws_size, hipStream_t stream) {
    static int grid = 0;
    if (grid == 0) {
        if (n_in != 35 || (size_t)out_size != O_END || ws_size < WS_END) { fprintf(stderr, "kernel_launch: unexpected problem (n_in %d, out %d, ws %zu need %zu)\n", n_in, out_size, ws_size, (size_t)WS_END); grid = -1; return; }
        int dev = 0, cus = 0, per_cu = 0;
        if (hipGetDevice(&dev) != hipSuccess || hipDeviceGetAttribute(&cus, hipDeviceAttributeMultiprocessorCount, dev) != hipSuccess) { grid = -1; return; }
        if (hipFuncSetAttribute((const void*)mega_fwd, hipFuncAttributeMaxDynamicSharedMemorySize, LDS_BYTES) != hipSuccess) { fprintf(stderr, "kernel_launch: hipFuncSetAttribute failed\n"); grid = -1; return; }
        if (hipOccupancyMaxActiveBlocksPerMultiprocessor(&per_cu, (const void*)mega_fwd, NWAVES * 64, LDS_BYTES) != hipSuccess || per_cu < 1)
            fprintf(stderr, "kernel_launch: occupancy query reports %d blocks per CU\n", per_cu);
        (void)hipGetLastError();
        grid = cus;
    }
    if (grid < 0) return;
    hipMemsetAsync((char*)d_ws + WS_CTL, 0, CTL_ZERO_BYTES, stream);
    Args a{};
    for (int i = 0; i < 35; ++i) a.in[i] = d_in[i];
    a.out = (float*)d_out; a.ws = (unsigned char*)d_ws;
#if MK_ONE_LAUNCH
    a.ph_lo = 0; a.ph_hi = N_PHASES;
    hipLaunchKernelGGL(mega_fwd, dim3(grid), dim3(NWAVES * 64), LDS_BYTES, stream, a);
#else
    for (int p = 0; p < N_PHASES; ++p) { a.ph_lo = p; a.ph_hi = p + 1; hipLaunchKernelGGL(mega_fwd, dim3(grid), dim3(NWAVES * 64), LDS_BYTES, stream, a); }
#endif
}
```

```cpp
#include <hip/hip_runtime.h>
#include <cstdio>
#include <cstdint>

#ifndef MK_ONE_LAUNCH
#define MK_ONE_LAUNCH 1
#endif

#define LAS __attribute__((address_space(3)))
#define GAS __attribute__((address_space(1)))
typedef unsigned short bf16_t;
typedef short bf16x8 __attribute__((ext_vector_type(8)));
typedef short s16x4 __attribute__((ext_vector_type(4)));
typedef float f32x4 __attribute__((ext_vector_type(4)));
typedef float f32x2 __attribute__((ext_vector_type(2)));
typedef float f32x16 __attribute__((ext_vector_type(16)));
typedef unsigned u32x4 __attribute__((ext_vector_type(4)));
typedef unsigned u32x2 __attribute__((ext_vector_type(2)));

constexpr int D = 1024, BATCH = 8, SEQ = 2048, DEPTH = 4, DECB = 128, DECS = 4, PAST = 2048, PAGE = 128;
constexpr int MP = BATCH * SEQ, MS = DECB * DECS, MT = MP + MS;
constexpr int NPOOL = 2560, NPAGES = 16;
constexpr int DFF = 3072, DPLE = 256;
constexpr int NSA_N = 1840, NSA_NP = 2048;
constexpr float ALPHA = 1.6817928305074290f;
constexpr float LN_EPS = 1e-5f;
constexpr float QSCALE = 0.125f * 1.4426950408889634f;

constexpr size_t O_YP = 0;
constexpr size_t O_YS = O_YP + (size_t)MP * D;
constexpr size_t O_KVP = O_YS + (size_t)MS * D;
constexpr size_t O_KVS = O_KVP + (size_t)2 * MP * 512;
constexpr size_t O_WINP = O_KVS + (size_t)2 * MS * 512;
constexpr size_t O_WINS = O_WINP + (size_t)2 * BATCH * 512 * 256;
constexpr size_t O_HP = O_WINS + (size_t)2 * DECB * 512 * 256;
constexpr size_t O_HS = O_HP + (size_t)2 * BATCH * D;
constexpr size_t O_RCP = O_HS + (size_t)2 * DECB * D;
constexpr size_t O_RCS = O_RCP + (size_t)2 * BATCH * 3 * D;
constexpr size_t O_FCP = O_RCS + (size_t)2 * DECB * 3 * D;
constexpr size_t O_FCS = O_FCP + (size_t)4 * BATCH * 2 * 6144;
constexpr size_t O_END = O_FCS + (size_t)4 * DECB * 2 * 6144;
static_assert(O_END == 78053376, "output size");

constexpr size_t MiB = 1u << 20;
constexpr size_t WS_CTL = 0, CTL_ZERO_BYTES = 1 * MiB;
constexpr size_t WS_W_NSA_IN = 2 * MiB;
constexpr size_t WS_W_NSA_OUT = WS_W_NSA_IN + 8 * MiB;
constexpr size_t WS_W_CMP1 = WS_W_NSA_OUT + 4 * MiB;
constexpr size_t WS_W_CMP2 = WS_W_CMP1 + 4 * MiB;
constexpr size_t WS_W_RG_IN = WS_W_CMP2 + 1 * MiB;
constexpr size_t WS_W_RG_G = WS_W_RG_IN + 8 * MiB;
constexpr size_t WS_W_RG_OUT = WS_W_RG_G + 2 * MiB;
constexpr size_t WS_W_UP = WS_W_RG_OUT + 4 * MiB;
constexpr size_t WS_W_DOWN = WS_W_UP + 48 * MiB;
constexpr size_t WS_W_PROJ = WS_W_DOWN + 24 * MiB;
constexpr size_t WS_W_GATE = WS_W_PROJ + 2 * MiB;
constexpr size_t WS_B1PART = WS_W_GATE + 8 * MiB;
constexpr size_t WS_X32 = WS_B1PART + 1 * MiB;
constexpr size_t WS_XB = WS_X32 + 66 * MiB;
constexpr size_t WS_PB = WS_XB + 33 * MiB;
constexpr size_t WS_PP = WS_PB + 33 * MiB;
constexpr size_t WS_CS = WS_PP + 132 * MiB;
constexpr size_t WS_HIDS = WS_CS + 257 * MiB;
constexpr size_t WS_KCS = WS_HIDS + 64 * MiB;
constexpr size_t WS_QB = WS_KCS + 16 * MiB;
constexpr size_t WS_KV6 = WS_QB + 33 * MiB;
constexpr size_t WS_KVS = WS_KV6 + 25 * MiB;
constexpr size_t WS_G32 = WS_KVS + 1 * MiB;
constexpr size_t WS_HIDP = WS_G32 + 4 * MiB;
constexpr size_t WS_KCP = WS_HIDP + 2 * MiB;
constexpr size_t WS_OB = WS_KCP + 1 * MiB;
constexpr size_t WS_PRE = WS_OB + 33 * MiB;
constexpr size_t WS_H32 = WS_PRE + 66 * MiB;
constexpr size_t WS_HB = WS_H32 + 66 * MiB;
constexpr size_t WS_U = WS_HB + 33 * MiB;
constexpr size_t WS_ACT = WS_U + 198 * MiB;
constexpr size_t WS_GG = WS_ACT + 99 * MiB;
constexpr size_t WS_RECB = WS_GG + 33 * MiB;
constexpr size_t WS_REC = WS_RECB + 33 * MiB;
constexpr size_t WS_AA = WS_REC + 33 * MiB;
constexpr size_t WS_UU = WS_AA + 66 * MiB;
constexpr size_t WS_CA = WS_UU + 66 * MiB;
constexpr size_t WS_CH = WS_CA + 1 * MiB;
constexpr size_t WS_HG = WS_CH + 1 * MiB;
constexpr size_t WS_END = WS_HG + 33 * MiB;

constexpr int CW_BAR = 4096;

constexpr int RING_BYTES = 131072;
constexpr int LDSCTL_OFF = RING_BYTES, MISC_OFF = LDSCTL_OFF + 320;
constexpr int LDS_B1P_OFF = RING_BYTES + 1024;
constexpr int LDS_BYTES = 147456;
constexpr int NWAVES = 8;

__device__ __forceinline__ unsigned f2bf(float f) { unsigned u = __builtin_bit_cast(unsigned, f); return (u + 0x7fffu + ((u >> 16) & 1u)) >> 16; }
__device__ __forceinline__ unsigned pk2(float lo, float hi) { return f2bf(lo) | (f2bf(hi) << 16); }
__device__ __forceinline__ float bf2f(unsigned short h) { return __builtin_bit_cast(float, (unsigned)h << 16); }
__device__ __forceinline__ float bflo(unsigned w) { return __builtin_bit_cast(float, w << 16); }
__device__ __forceinline__ float bfhi(unsigned w) { return __builtin_bit_cast(float, w & 0xffff0000u); }
__device__ __forceinline__ float sigm(float x) { return 1.f / (1.f + __expf(-x)); }
__device__ __forceinline__ float gelu_t(float x) { const float u = 0.7978845608028654f * (x + 0.044715f * x * x * x); return x / (1.f + __expf(-2.f * u)); }
__device__ __forceinline__ float ex2(float x) { return __builtin_amdgcn_exp2f(x); }
#define LDS_WAIT() asm volatile("s_waitcnt lgkmcnt(0)" ::: "memory")
#define VM_WAIT() asm volatile("s_waitcnt vmcnt(0)" ::: "memory")

namespace pg8 {
constexpr int BM = 256, BK = 64, HALF = 128, HTB = HALF * BK * 2, STAGE_BYTES = 8 * HTB, NXCD = 8, WGM = 8;
__host__ __device__ __forceinline__ int lds_byte(int r, int c) { const int st = (r >> 4) * 2 + (c >> 5), rr = r & 15, cc = c & 31, ob = rr * 64 + cc * 2; return st * 1024 + (ob ^ (((ob >> 9) & 1) << 5)); }
__host__ __device__ __forceinline__ void stage_rc(int b, int& R, int& C) { const int st = b / 1024, sb = b % 1024, swz = sb ^ (((sb >> 9) & 1) << 5); R = (st >> 1) * 16 + swz / 64; C = (st & 1) * 32 + (swz % 64) / 2; }
__host__ __device__ __forceinline__ int perm32(int rho) { const int n = rho >> 4, i = rho & 15; return 8 * (i >> 2) + 4 * n + (i & 3); }

struct Unit { int pm, pn; long aoff, boff; };
struct Gemm { const bf16_t* A; const bf16_t* Bt; int lda, ldb, K; };

struct Sched {
    int nM, nN, nwg, G, c;
    long a_tile, b_tile;
    int a_pn_mul; long a_pn_bytes;
    int b_pm_mul; long b_pm_bytes;
    __device__ void init(int nM_, int nN_, int G_, int c_, int lda, int ldb) {
        nM = nM_; nN = nN_; nwg = nM * nN; G = G_; c = c_; a_tile = (long)BM * lda * 2; b_tile = (long)BM * ldb * 2;
        a_pn_mul = 0; a_pn_bytes = 0; b_pm_mul = 0; b_pm_bytes = 0; }
    __device__ static constexpr int rmul(int div) { return (65536 + div - 1) / div; }
    __device__ bool next(int i, Unit& u) const {
        const long L = (long)i * G + c; if (L >= nwg) return false;
        int wgid = (int)L; { const int q = nwg / NXCD, r = nwg % NXCD, xcd = wgid % NXCD, off = wgid / NXCD; wgid = (xcd < r ? xcd * (q + 1) : r * (q + 1) + (xcd - r) * q) + off; }
        const int nig = WGM * nN, gid = wgid / nig, fm = gid * WGM, gsz = (nM - fm) < WGM ? (nM - fm) : WGM;
        u.pm = fm + ((wgid % nig) % gsz); u.pn = (wgid % nig) / gsz;
        u.aoff = (long)u.pm * a_tile + (long)((u.pn * a_pn_mul) >> 16) * a_pn_bytes; u.boff = (long)u.pn * b_tile + (long)((u.pm * b_pm_mul) >> 16) * b_pm_bytes;
        return true; }
};

template <class Epi>
__device__ __forceinline__ void gemm_phase(LAS unsigned char* lds, const Gemm g, const Sched& S, const Epi& E) {
    int tid_ = threadIdx.x; asm volatile("" : "+v"(tid_));
    const int tid = tid_, wid = __builtin_amdgcn_readfirstlane(tid >> 6), lane = tid & 63, wr = wid >> 2, wc = wid & 3, fr = lane & 15, fq = lane >> 4;
    int K_ = g.K; asm volatile("" : "+s"(K_));
    const int K = K_, nt = K / BK;
    unsigned voffA, voffB;
    { int R, C; stage_rc(tid * 16, R, C); const int Rb = (R & ~31) + perm32(R & 31); voffA = (unsigned)(R * g.lda + C) * 2u; voffB = (unsigned)(Rb * g.ldb + C) * 2u; }
    const size_t piecevoffA = (size_t)64 * g.lda * 2, piecevoffB = (size_t)64 * g.ldb * 2;
    const size_t kstep = (size_t)(BK * 2);
    const size_t hstepA = (size_t)HALF * g.lda * 2, hstepB = (size_t)HALF * g.ldb * 2;
    const unsigned ldsw = (unsigned)wid * 1024u;
    const int aoff = lds_byte(wr * 64 + fr, fq * 8), boff = lds_byte(wc * 32 + fr, fq * 8);
#define PG8_SA(b, h) (((b) * 2 + (h)) * HTB)
#define PG8_SB(b, h) ((4 + (b) * 2 + (h)) * HTB)
#define PG8_STAGE_(bufoff, gbase, voff, piece) do { \
        __builtin_amdgcn_global_load_lds((const unsigned*)((const char*)(gbase) + (voff)), (LAS unsigned*)(lds + (bufoff) + ldsw), 16, 0, 0); \
        __builtin_amdgcn_global_load_lds((const unsigned*)((const char*)(gbase) + (piece) + (voff)), (LAS unsigned*)(lds + (bufoff) + ldsw + 8192), 16, 0, 0); } while (0)
#define PG8_STAGE(bufoff, gbase, voff) PG8_STAGE_(bufoff, gbase, voff, piece##voff)
#define PG8_LDA(dst, b, h) do { _Pragma("unroll") for (int m = 0; m < 4; ++m) _Pragma("unroll") for (int k = 0; k < 2; ++k) dst[m][k] = *(const LAS bf16x8*)(lds + PG8_SA(b, h) + aoff + m * 2048 + k * 1024); } while (0)
#define PG8_LDB(dst, b, h) do { _Pragma("unroll") for (int n = 0; n < 2; ++n) _Pragma("unroll") for (int k = 0; k < 2; ++k) dst[n][k] = *(const LAS bf16x8*)(lds + PG8_SB(b, h) + boff + n * 2048 + k * 1024); } while (0)
#define PG8_MMA(ai, bj, At, Bt) do { __builtin_amdgcn_s_setprio(1); _Pragma("unroll") for (int m = 0; m < 4; ++m) _Pragma("unroll") for (int n = 0; n < 2; ++n) _Pragma("unroll") for (int k = 0; k < 2; ++k) \
        acc[ai][bj][m][n] = __builtin_amdgcn_mfma_f32_16x16x32_bf16(Bt[n][k], At[m][k], acc[ai][bj][m][n], 0, 0, 0); __builtin_amdgcn_s_setprio(0); } while (0)
#define PG8_WAIT_V(n) asm volatile("s_waitcnt vmcnt(" #n ")" ::: "memory")
#define PG8_WAIT_L(n) asm volatile("s_waitcnt lgkmcnt(" #n ")" ::: "memory")
#define PG8_BAR __builtin_amdgcn_s_barrier()
#define PG8_SCHED __builtin_amdgcn_sched_barrier(0)
    Unit cur, nxt; int ui = 0;
    if (!S.next(0, cur)) return;
    f32x4 acc[2][2][4][2];
#pragma unroll
    for (int a = 0; a < 2; ++a)
#pragma unroll
        for (int b = 0; b < 2; ++b)
#pragma unroll
            for (int m = 0; m < 4; ++m)
#pragma unroll
                for (int n = 0; n < 2; ++n) acc[a][b][m][n] = (f32x4){0.f, 0.f, 0.f, 0.f};
    bf16x8 At[4][2], B0[2][2], B1[2][2];
    const char* cA = (const char*)g.A + cur.aoff; const char* cB = (const char*)g.Bt + cur.boff;
    PG8_STAGE(PG8_SB(0, 0), cB, voffB); PG8_STAGE(PG8_SB(0, 1), cB + hstepB, voffB); PG8_STAGE(PG8_SA(0, 0), cA, voffA); PG8_STAGE(PG8_SA(0, 1), cA + hstepA, voffA);
    if (wr == 1) PG8_BAR;
    PG8_WAIT_V(2); PG8_BAR;
    PG8_STAGE(PG8_SB(1, 0), cB + kstep, voffB); PG8_STAGE(PG8_SA(1, 0), cA + kstep, voffA); PG8_STAGE(PG8_SB(1, 1), cB + hstepB + kstep, voffB);
    PG8_WAIT_V(6); PG8_BAR;
    for (;;) {
        const bool has_next = S.next(ui + 1, nxt);
        const char* nA = has_next ? (const char*)g.A + nxt.aoff : cA; const char* nB = has_next ? (const char*)g.Bt + nxt.boff : cB;
        for (int t = 0; t < nt; t += 2) {
            const bool last = (t == nt - 2);
            const char* a1 = cA + (size_t)(t + 1) * kstep;
            const char* a2 = last ? nA : cA + (size_t)(t + 2) * kstep; const char* b2 = last ? nB : cB + (size_t)(t + 2) * kstep;
            const char* a3 = a2 + kstep; const char* b3 = b2 + kstep;
            PG8_LDB(B0, 0, 0); PG8_LDB(B1, 0, 1); PG8_SCHED; PG8_LDA(At, 0, 0); PG8_STAGE(PG8_SA(1, 1), a1 + hstepA, voffA);
            PG8_WAIT_V(8); PG8_WAIT_L(0); PG8_BAR; PG8_MMA(0, 0, At, B0); PG8_MMA(0, 1, At, B1); PG8_BAR; PG8_SCHED;
            PG8_LDA(At, 0, 1); PG8_STAGE(PG8_SB(0, 0), b2, voffB); PG8_STAGE(PG8_SB(0, 1), b2 + hstepB, voffB); PG8_STAGE(PG8_SA(0, 0), a2, voffA);
            PG8_WAIT_V(8); PG8_WAIT_L(0); PG8_BAR; PG8_MMA(1, 0, At, B0); PG8_MMA(1, 1, At, B1); PG8_BAR; PG8_SCHED;
            PG8_LDB(B0, 1, 0); PG8_LDB(B1, 1, 1); PG8_SCHED; PG8_LDA(At, 1, 0); PG8_STAGE(PG8_SA(0, 1), a2 + hstepA, voffA);
            PG8_WAIT_V(8); PG8_WAIT_L(0); PG8_BAR; PG8_MMA(0, 0, At, B0); PG8_MMA(0, 1, At, B1); PG8_BAR; PG8_SCHED;
            PG8_LDA(At, 1, 1); PG8_STAGE(PG8_SB(1, 0), b3, voffB); PG8_STAGE(PG8_SB(1, 1), b3 + hstepB, voffB); PG8_STAGE(PG8_SA(1, 0), a3, voffA);
            PG8_WAIT_V(8); PG8_WAIT_L(0); PG8_BAR; PG8_MMA(1, 0, At, B0); PG8_MMA(1, 1, At, B1); PG8_BAR; PG8_SCHED;
        }
        if (wr == 0) PG8_BAR;
        E(acc, cur, wr, wc, fr, fq);
        if (!has_next) break;
#pragma unroll
        for (int a = 0; a < 2; ++a)
#pragma unroll
            for (int b = 0; b < 2; ++b)
#pragma unroll
                for (int m = 0; m < 4; ++m)
#pragma unroll
                    for (int n = 0; n < 2; ++n) acc[a][b][m][n] = (f32x4){0.f, 0.f, 0.f, 0.f};
        cur = nxt; cA = nA; cB = nB; ++ui;
        if (wr == 1) PG8_BAR;
    }
    PG8_WAIT_V(0);
    PG8_BAR;
#undef PG8_SA
#undef PG8_SB
#undef PG8_STAGE
#undef PG8_STAGE_
#undef PG8_LDA
#undef PG8_LDB
#undef PG8_MMA
#undef PG8_WAIT_V
#undef PG8_WAIT_L
#undef PG8_BAR
#undef PG8_SCHED
}

__device__ __forceinline__ u32x4 pack8(const f32x4& v0, const f32x4& v1) { u32x4 w; w.x = pk2(v0[0], v0[1]); w.y = pk2(v0[2], v0[3]); w.z = pk2(v1[0], v1[1]); w.w = pk2(v1[2], v1[3]); return w; }
#define EPI_PIECES(...) \
    _Pragma("unroll") for (int ai = 0; ai < 2; ++ai) _Pragma("unroll") for (int m = 0; m < 4; ++m) { const int rowU = u.pm * BM + ai * HALF + m * 16; (void)rowU; \
        _Pragma("unroll") for (int bj = 0; bj < 2; ++bj) { const f32x4 v0 = acc[ai][bj][m][0], v1 = acc[ai][bj][m][1]; (void)v0; (void)v1; __VA_ARGS__ } \
        asm volatile("" ::: "memory"); }
#define ST_F32X8(ptr, a, b) do { *(f32x4*)(ptr) = (a); *(f32x4*)((ptr) + 16) = (b); } while (0)

template <bool BA> struct EpiBf16G {
    bf16_t* O; int ldc; const LAS float* bias; int bias_pm_shift;
    __device__ __forceinline__ void operator()(const f32x4 (&acc)[2][2][4][2], const Unit& u, int wr, int wc, int fr, int fq) const {
        const LAS float* bp0 = BA ? bias + (u.pm >> bias_pm_shift) * 256 + wc * 32 + 8 * fq : nullptr;
        const unsigned lo = (unsigned)(((wr * 64 + fr) * ldc + wc * 32 + 8 * fq) * 2);
        EPI_PIECES(
            char* op = (char*)O + ((size_t)rowU * ldc + u.pn * BM + bj * HALF) * 2;
            f32x4 a = v0; f32x4 b = v1;
            if (BA) { const LAS float* bp = bp0 + bj * HALF;
                _Pragma("unroll") for (int e = 0; e < 4; ++e) { a[e] = gelu_t(a[e] + bp[e]); b[e] = gelu_t(b[e] + bp[4 + e]); } }
            *(u32x4*)(op + lo) = pack8(a, b); )
    }
};

struct EpiNsaIn {
    bf16_t* QB; bf16_t* KV6; bf16_t* KVS; float* G32; float* out; int j;
    __device__ __forceinline__ void operator()(const f32x4 (&acc)[2][2][4][2], const Unit& u, int wr, int wc, int fr, int fq) const {
        const bool samp = u.pm >= MP / BM; const int rowL = wr * 64 + fr, colL = wc * 32 + 8 * fq;
        if (u.pn < 4) {
            const unsigned lo = (unsigned)((rowL * 1024 + colL) * 2);
            EPI_PIECES( char* op = (char*)QB + ((size_t)rowU * 1024 + u.pn * BM + bj * HALF) * 2; *(u32x4*)(op + lo) = pack8(v0 * QSCALE, v1 * QSCALE); )
        } else if (u.pn < 7) {
            const int gg = wc >> 1, d = (wc & 1) * 32 + 8 * fq;
            if (!samp) {
                const int b = u.pm >> 3; const bool wintail = (u.pm & 7) >= 6;
                const unsigned lo_kv = (unsigned)(((gg * 2048 + rowL) * 64 + d) * 2), lo_o = (unsigned)((rowL * 512 + colL) * 4), lo_w = (unsigned)((rowL * 256 + colL) * 4);
                EPI_PIECES(
                    const int kc0 = u.pn * BM + bj * HALF - 1024, comp = kc0 >> 7, tU = rowU & 2047;
                    char* kp = (char*)KV6 + ((size_t)((comp * 8 + b) * 2 * 2048 + tU) * 64) * 2; *(u32x4*)(kp + lo_kv) = pack8(v0, v1);
                    if (comp < 4) { char* op = (char*)(out + O_KVP) + ((size_t)((j * BATCH + b) * SEQ + tU) * 512 + kc0) * 4; ST_F32X8(op + lo_o, v0, v1); }
                    else if (wintail) { char* op = (char*)(out + O_WINP) + ((size_t)((j * BATCH + b) * 512 + (tU - (SEQ - 512))) * 256 + (kc0 - 512)) * 4; ST_F32X8(op + lo_w, v0, v1); } )
            } else {
                const unsigned lo_s = (unsigned)((rowL * 768 + colL) * 2), lo_o = (unsigned)((rowL * 512 + colL) * 4), lo_w = (unsigned)((((rowL >> 2) * 512 + (rowL & 3)) * 256 + colL) * 4);
                EPI_PIECES(
                    const int kc0 = u.pn * BM + bj * HALF - 1024, comp = kc0 >> 7, srU = rowU - MP;
                    char* sp = (char*)KVS + ((size_t)srU * 768 + kc0) * 2; *(u32x4*)(sp + lo_s) = pack8(v0, v1);
                    if (comp < 4) { char* op = (char*)(out + O_KVS) + ((size_t)(j * MS + srU) * 512 + kc0) * 4; ST_F32X8(op + lo_o, v0, v1); }
                    else { char* op = (char*)(out + O_WINS) + ((size_t)((j * DECB + (srU >> 2)) * 512 + 508) * 256 + (kc0 - 512)) * 4; ST_F32X8(op + lo_w, v0, v1); } )
            }
        } else {
            const unsigned lo = (unsigned)((rowL * 48 + colL) * 4);
            if (colL < 48) {
#pragma unroll
                for (int ai = 0; ai < 2; ++ai)
#pragma unroll
                    for (int m = 0; m < 4; ++m) { const int rowU = u.pm * BM + ai * HALF + m * 16; char* op = (char*)G32 + (size_t)rowU * 48 * 4;
                        f32x4 a = acc[ai][0][m][0], b = acc[ai][0][m][1];
#pragma unroll
                        for (int e = 0; e < 4; ++e) { a[e] = sigm(a[e]); b[e] = sigm(b[e]); }
                        ST_F32X8(op + lo, a, b); }
            }
        }
    }
};

struct EpiResid {
    const float* base; float* pre;
    __device__ __forceinline__ void operator()(const f32x4 (&acc)[2][2][4][2], const Unit& u, int wr, int wc, int fr, int fq) const {
        const unsigned lo = (unsigned)(((wr * 64 + fr) * D + wc * 32 + 8 * fq) * 4);
        EPI_PIECES(
            const size_t uo = ((size_t)rowU * D + u.pn * BM + bj * HALF) * 4; const char* bp = (const char*)base + uo; char* op = (char*)pre + uo;
            const f32x4 b0 = *(const f32x4*)(bp + lo), b1 = *(const f32x4*)(bp + lo + 16);
            ST_F32X8(op + lo, b0 * ALPHA + v0, b1 * ALPHA + v1); )
    }
};

struct EpiUp {
    bf16_t* U; float* out; int layer;
    __device__ __forceinline__ void operator()(const f32x4 (&acc)[2][2][4][2], const Unit& u, int wr, int wc, int fr, int fq) const {
        const bool samp = u.pm >= MP / BM; const int rowL = wr * 64 + fr, colL = wc * 32 + 8 * fq;
        const unsigned lo = (unsigned)((rowL * 6144 + colL) * 2);
        EPI_PIECES(
            const int ncU = bj * DFF + u.pn * 128;
            char* op = (char*)U + ((size_t)rowU * 6144 + ncU) * 2; *(u32x4*)(op + lo) = pack8(v0, v1);
            if (!samp) { if ((u.pm & 7) == 7 && ai == 1 && m == 3 && rowL >= 64 + 14) { const int b = u.pm >> 3, tt = rowL - (64 + 14);
                    float* o = out + O_FCP + ((size_t)(layer * BATCH + b) * 2 + tt) * 6144 + ncU + colL; ST_F32X8((char*)o, v0, v1); } }
            else { const int sr = rowU - MP + rowL, b = sr >> 2, s = sr & 3;
                if (s >= 2) { float* o = out + O_FCS + ((size_t)(layer * DECB + b) * 2 + (s - 2)) * 6144 + ncU + colL; ST_F32X8((char*)o, v0, v1); } } )
    }
};

struct EpiPle {
    const float* h2; const bf16_t* pp; float* x32; bf16_t* xb; float* out; int last;
    __device__ __forceinline__ void operator()(const f32x4 (&acc)[2][2][4][2], const Unit& u, int wr, int wc, int fr, int fq) const {
        const unsigned le = (unsigned)((wr * 64 + fr) * D + wc * 32 + 8 * fq);
        EPI_PIECES(
            const size_t ue = (size_t)rowU * D + u.pn * BM + bj * HALF;
            const char* hp = (const char*)h2 + ue * 4; const char* ppp = (const char*)pp + ue * 2;
            const f32x4 h0 = *(const f32x4*)(hp + le * 4), h1 = *(const f32x4*)(hp + le * 4 + 16); const u32x4 pw = *(const u32x4*)(ppp + le * 2);
            f32x4 r0; f32x4 r1;
            r0[0] = h0[0] + sigm(v0[0]) * bflo(pw.x); r0[1] = h0[1] + sigm(v0[1]) * bfhi(pw.x); r0[2] = h0[2] + sigm(v0[2]) * bflo(pw.y); r0[3] = h0[3] + sigm(v0[3]) * bfhi(pw.y);
            r1[0] = h1[0] + sigm(v1[0]) * bflo(pw.z); r1[1] = h1[1] + sigm(v1[1]) * bfhi(pw.z); r1[2] = h1[2] + sigm(v1[2]) * bflo(pw.w); r1[3] = h1[3] + sigm(v1[3]) * bfhi(pw.w);
            if (last) { char* op = (char*)(out + O_YP) + ue * 4; ST_F32X8(op + le * 4, r0, r1); }
            else { char* xp = (char*)x32 + ue * 4; ST_F32X8(xp + le * 4, r0, r1); char* bp = (char*)xb + ue * 2; *(u32x4*)(bp + le * 2) = pack8(r0, r1); } )
    }
};

struct EpiRgIn {
    bf16_t* GG; bf16_t* RECB; float* out; int j;
    __device__ __forceinline__ void operator()(const f32x4 (&acc)[2][2][4][2], const Unit& u, int wr, int wc, int fr, int fq) const {
        const bool samp = u.pm >= MP / BM; const int rowL = wr * 64 + fr, colL = wc * 32 + 8 * fq;
        const unsigned lo = (unsigned)((rowL * D + colL) * 2);
        if (u.pn < 4) {
            EPI_PIECES( char* op = (char*)GG + ((size_t)rowU * D + u.pn * BM + bj * HALF) * 2; f32x4 a = v0; f32x4 b = v1;
                _Pragma("unroll") for (int e = 0; e < 4; ++e) { a[e] = gelu_t(a[e]); b[e] = gelu_t(b[e]); }
                *(u32x4*)(op + lo) = pack8(a, b); )
        } else {
            EPI_PIECES(
                const int cU = (u.pn - 4) * BM + bj * HALF;
                char* op = (char*)RECB + ((size_t)rowU * D + cU) * 2; *(u32x4*)(op + lo) = pack8(v0, v1);
                if (!samp) { if ((u.pm & 7) == 7 && ai == 1 && m == 3 && rowL >= 64 + 13) { const int b = u.pm >> 3, tt = rowL - (64 + 13);
                        float* o = out + O_RCP + ((size_t)(j * BATCH + b) * 3 + tt) * D + cU + colL; ST_F32X8((char*)o, v0, v1); } }
                else { const int sr = rowU - MP + rowL, b = sr >> 2, s = sr & 3;
                    if (s >= 1) { float* o = out + O_RCS + ((size_t)(j * DECB + b) * 3 + (s - 1)) * D + cU + colL; ST_F32X8((char*)o, v0, v1); } } )
        }
    }
};

struct EpiRgGate {
    float* AA; float* UU;
    __device__ __forceinline__ void operator()(const f32x4 (&acc)[2][2][4][2], const Unit& u, int wr, int wc, int fr, int fq) const {
        const unsigned lo = (unsigned)(((wr * 64 + fr) * D + wc * 32 + 8 * fq) * 4); const int cU = (u.pn >> 1) * 256 + (u.pn & 1) * 128;
        EPI_PIECES( char* op = (char*)(bj ? UU : AA) + ((size_t)rowU * D + cU) * 4; ST_F32X8(op + lo, v0, v1); )
    }
};
}

#define XB_TMO      128
#define XB_XCNT(j)  (256  + 64 * (j))
#define XB_XSUB(j)  (1280 + 64 * (j))
#define XB_XGEN(j)  (2304 + 64 * (j))
#define XB_TOP      3328
#define XB_TOPGEN   3392
#define XCD_BAR_WORDS 3456
#define XB_SPIN_CAP (1u << 18)
__device__ __forceinline__ unsigned xb_ld(unsigned* p)              { return __hip_atomic_load(p, __ATOMIC_RELAXED, __HIP_MEMORY_SCOPE_AGENT); }
__device__ __forceinline__ unsigned xb_add(unsigned* p, unsigned v) { return __hip_atomic_fetch_add(p, v, __ATOMIC_RELAXED, __HIP_MEMORY_SCOPE_AGENT); }
__device__ __forceinline__ unsigned xb_xcc_id() { return (unsigned)__builtin_amdgcn_s_getreg((3 << 11) | 20) & 0xFu; }
#define XB_SPIN(cond, bar) do { unsigned _sp = 0; while (cond) { __builtin_amdgcn_s_sleep(1); \
    if ((++_sp & 255u) == 0u) { if (xb_ld(&(bar)[XB_TMO])) break; if (_sp > XB_SPIN_CAP) { atomicAdd(&(bar)[XB_TMO], 1u); break; } } } } while (0)
struct XcdBarrier { unsigned* bar; unsigned x; volatile LAS unsigned* st; };
__device__ __forceinline__ XcdBarrier xcd_barrier_post(unsigned* bar, volatile LAS unsigned* st) {
    XcdBarrier b; b.bar = bar; b.x = xb_xcc_id(); b.st = st;
    if (threadIdx.x == 0) (void)xb_add(&bar[XB_XCNT(b.x)], 1u);
    return b;
}
__device__ __forceinline__ void xcd_barrier_complete(unsigned* bar, unsigned x, unsigned& nloc, unsigned& nx) {
    const unsigned G = gridDim.x * gridDim.y * gridDim.z;
    unsigned sum, cnt, mine, sp = 0u;
    for (;;) {
        sum = 0u; cnt = 0u; mine = 0u;
#pragma unroll
        for (unsigned j = 0; j < 16; ++j) { const unsigned c = xb_ld(&bar[XB_XCNT(j)]); sum += c; cnt += (c > 0u) ? 1u : 0u; mine = (j == x) ? c : mine; }
        if (sum == G) break;
        __builtin_amdgcn_s_sleep(1);
        if ((++sp & 255u) == 0u) { if (xb_ld(&bar[XB_TMO])) break; if (sp > XB_SPIN_CAP) { atomicAdd(&bar[XB_TMO], 1u); break; } }
    }
    nloc = mine > 0u ? mine : 1u; nx = cnt > 0u ? cnt : 1u;
}
__device__ __forceinline__ void xcd_barrier(const XcdBarrier& b) {
    asm volatile("s_waitcnt vmcnt(0)" ::: "memory");
    __syncthreads();
    if (threadIdx.x == 0) {
        unsigned* bar = b.bar;
        __builtin_amdgcn_s_waitcnt(0);
        unsigned nloc = b.st[0], nx = b.st[1];
        if (nloc == 0u) { xcd_barrier_complete(bar, b.x, nloc, nx); b.st[0] = nloc; b.st[1] = nx; }
        const unsigned old = xb_add(&bar[XB_XSUB(b.x)], 1u);
        const unsigned gen = old / nloc;
        if (old + 1u == (gen + 1u) * nloc) {
            __builtin_amdgcn_fence(__ATOMIC_RELEASE, "agent");
            asm volatile("s_waitcnt vmcnt(0)" ::: "memory");
            const unsigned og = xb_add(&bar[XB_TOP], 1u);
            const unsigned tg = og / nx;
            if (og + 1u == (tg + 1u) * nx) xb_add(&bar[XB_TOPGEN], 1u);
            else XB_SPIN(xb_ld(&bar[XB_TOPGEN]) == tg, bar);
            __builtin_amdgcn_fence(__ATOMIC_ACQUIRE, "agent");
            xb_add(&bar[XB_XGEN(b.x)], 1u);
            asm volatile("s_waitcnt vmcnt(0)" ::: "memory");
        } else {
            XB_SPIN(xb_ld(&bar[XB_XGEN(b.x)]) == gen, bar);
            __builtin_amdgcn_fence(__ATOMIC_ACQUIRE, "agent");
            asm volatile("s_waitcnt vmcnt(0)" ::: "memory");
        }
    }
    __syncthreads();
}

struct Args { const void* in[35]; float* out; unsigned char* ws; int ph_lo, ph_hi; };
struct Frame {
    LAS unsigned char* lds; int tid, lane, wave, vcu, G;
    unsigned char* ws; float* out;
};
__device__ __forceinline__ float wave_sum(float v) {
#pragma unroll
    for (int o = 1; o < 64; o <<= 1) v += __shfl_xor(v, o);
    return v;
}

__device__ __forceinline__ const void* in_ptr(int k) {
    const void* const __attribute__((address_space(4)))* p = (const void* const __attribute__((address_space(4)))*)__builtin_amdgcn_kernarg_segment_ptr();
    asm volatile("" : "+s"(k));
    return p[k];
}
__device__ __forceinline__ void tr_item(const float* W, int ldw, int k0, int n_src0, int n_valid, bf16_t* WT, int ldt, int dst_row0, LAS float* scr, int lane) {
#pragma unroll 8
    for (int i = 0; i < 32; ++i) { const int kk = 2 * i + (lane >> 5), nn = lane & 31; scr[kk * 33 + nn] = (nn < n_valid) ? W[(size_t)(k0 + kk) * ldw + n_src0 + nn] : 0.f; }
    LDS_WAIT(); asm volatile("" ::: "memory");
    const int c = lane & 7;
#pragma unroll
    for (int jj = 0; jj < 4; ++jj) { const int n = (lane >> 3) + 8 * jj; const LAS float* s = scr + (8 * c) * 33 + n;
        u32x4 o; o.x = pk2(s[0 * 33], s[1 * 33]); o.y = pk2(s[2 * 33], s[3 * 33]); o.z = pk2(s[4 * 33], s[5 * 33]); o.w = pk2(s[6 * 33], s[7 * 33]);
        *(u32x4*)(WT + (size_t)(dst_row0 + n) * ldt + k0 + 8 * c) = o; }
    LDS_WAIT(); asm volatile("" ::: "memory");
}

__device__ __forceinline__ void p0_prologue(Frame& F) {
    unsigned char* ws = F.ws;
    LAS float* scr = (LAS float*)(F.lds + F.wave * 16384);
    const int gw = F.vcu * NWAVES + F.wave, NGW = F.G * NWAVES, lane = F.lane;
    constexpr int I_NSA_IN = 16 * 64, I_SQ = 16 * 32, I_CMP1 = 32 * 8, I_CMP2 = 4 * 2, I_RG_IN = 16 * 64, I_RG_G = 4 * 8, I_UP = 16 * 192, I_DOWN = 48 * 32, I_PROJ = 4 * 32;
    constexpr int NITEMS = 2 * I_NSA_IN + 2 * I_SQ + 4 * I_CMP1 + 4 * I_CMP2 + 2 * I_RG_IN + 16 * I_RG_G + 2 * I_SQ + 4 * I_UP + 4 * I_DOWN + 4 * I_PROJ + 4 * I_SQ;
    for (int it = gw; it < NITEMS; it += NGW) {
        int r = it;
        if (r < 2 * I_NSA_IN) { const int j = r / I_NSA_IN, q = r % I_NSA_IN, kb = q / 64, nb = q % 64; const int nv = NSA_N - 32 * nb;
            tr_item((const float*)in_ptr(10) + (size_t)j * 1024 * NSA_N, NSA_N, 64 * kb, 32 * nb, nv < 0 ? 0 : (nv > 32 ? 32 : nv), (bf16_t*)(ws + WS_W_NSA_IN) + (size_t)j * NSA_NP * 1024, 1024, 32 * nb, scr, lane); continue; } r -= 2 * I_NSA_IN;
        if (r < 2 * I_SQ) { const int j = r / I_SQ, q = r % I_SQ, kb = q / 32, nb = q % 32;
            tr_item((const float*)in_ptr(11) + (size_t)j * 1024 * 1024, 1024, 64 * kb, 32 * nb, 32, (bf16_t*)(ws + WS_W_NSA_OUT) + (size_t)j * 1024 * 1024, 1024, 32 * nb, scr, lane); continue; } r -= 2 * I_SQ;
        if (r < 4 * I_CMP1) { const int mt = r / I_CMP1, q = r % I_CMP1, kb = q / 8, nb = q % 8;
            tr_item((const float*)in_ptr(13) + (size_t)mt * 2048 * 256, 256, 64 * kb, 32 * nb, 32, (bf16_t*)(ws + WS_W_CMP1) + (size_t)mt * 256 * 2048, 2048, 32 * nb, scr, lane); continue; } r -= 4 * I_CMP1;
        if (r < 4 * I_CMP2) { const int mt = r / I_CMP2, q = r % I_CMP2, kb = q / 2, nb = q % 2;
            tr_item((const float*)in_ptr(15) + (size_t)mt * 256 * 64, 64, 64 * kb, 32 * nb, 32, (bf16_t*)(ws + WS_W_CMP2) + (size_t)mt * 64 * 256, 256, 32 * nb, scr, lane); continue; } r -= 4 * I_CMP2;
        if (r < 2 * I_RG_IN) { const int j = r / I_RG_IN, q = r % I_RG_IN, kb = q / 64, nb = q % 64;
            tr_item((const float*)in_ptr(16) + (size_t)j * 1024 * 2048, 2048, 64 * kb, 32 * nb, 32, (bf16_t*)(ws + WS_W_RG_IN) + (size_t)j * 2048 * 1024, 1024, 32 * nb, scr, lane); continue; } r -= 2 * I_RG_IN;
        if (r < 16 * I_RG_G) { const int mt = r / I_RG_G, q = r % I_RG_G, kb = q / 8, nt = q % 8; const int j = mt >> 3, src = (mt >> 2) & 1, nb = mt & 3;
            const float* W = (const float*)in_ptr(src ? 21 : 19) + (size_t)(j * 4 + nb) * 256 * 256;
            tr_item(W, 256, 64 * kb, 32 * nt, 32, (bf16_t*)(ws + WS_W_RG_G) + (size_t)j * 8 * 256 * 256, 256, (nb * 2 + nt / 4) * 256 + src * 128 + (nt % 4) * 32, scr, lane); continue; } r -= 16 * I_RG_G;
        if (r < 2 * I_SQ) { const int j = r / I_SQ, q = r % I_SQ, kb = q / 32, nb = q % 32;
            tr_item((const float*)in_ptr(24) + (size_t)j * 1024 * 1024, 1024, 64 * kb, 32 * nb, 32, (bf16_t*)(ws + WS_W_RG_OUT) + (size_t)j * 1024 * 1024, 1024, 32 * nb, scr, lane); continue; } r -= 2 * I_SQ;
        if (r < 4 * I_UP) { const int i = r / I_UP, q = r % I_UP, kb = q / 192, nt = q % 192; const int n0 = 32 * nt, half = n0 / DFF, within = n0 % DFF;
            tr_item((const float*)in_ptr(25) + (size_t)i * 1024 * 6144, 6144, 64 * kb, n0, 32, (bf16_t*)(ws + WS_W_UP) + (size_t)i * 6144 * 1024, 1024, (within / 128) * 256 + half * 128 + (within % 128), scr, lane); continue; } r -= 4 * I_UP;
        if (r < 4 * I_DOWN) { const int i = r / I_DOWN, q = r % I_DOWN, kb = q / 32, nb = q % 32;
            tr_item((const float*)in_ptr(28) + (size_t)i * 3072 * 1024, 1024, 64 * kb, 32 * nb, 32, (bf16_t*)(ws + WS_W_DOWN) + (size_t)i * 1024 * 3072, 3072, 32 * nb, scr, lane); continue; } r -= 4 * I_DOWN;
        if (r < 4 * I_PROJ) { const int i = r / I_PROJ, q = r % I_PROJ, kb = q / 32, nb = q % 32;
            tr_item((const float*)in_ptr(33) + (size_t)i * 256 * 1024, 1024, 64 * kb, 32 * nb, 32, (bf16_t*)(ws + WS_W_PROJ) + (size_t)i * 1024 * 256, 256, 32 * nb, scr, lane); continue; } r -= 4 * I_PROJ;
        { const int i = r / I_SQ, q = r % I_SQ, kb = q / 32, nb = q % 32;
            tr_item((const float*)in_ptr(34) + (size_t)i * 1024 * 1024, 1024, 64 * kb, 32 * nb, 32, (bf16_t*)(ws + WS_W_GATE) + (size_t)i * 1024 * 1024, 1024, 32 * nb, scr, lane); }
    }
    for (int m = gw; m < MT; m += NGW) {
        const float* src = (m < MP) ? (const float*)in_ptr(0) + (size_t)m * D : (const float*)in_ptr(1) + (size_t)(m - MP) * D;
        float* x32 = (float*)(ws + WS_X32) + (size_t)m * D; bf16_t* xb = (bf16_t*)(ws + WS_XB) + (size_t)m * D;
#pragma unroll
        for (int jj = 0; jj < 4; ++jj) { const f32x4 v = *((const f32x4*)src + lane + 64 * jj); *((f32x4*)x32 + lane + 64 * jj) = v;
            u32x2 w; w.x = pk2(v[0], v[1]); w.y = pk2(v[2], v[3]); *((u32x2*)xb + lane + 64 * jj) = w; }
    }
    for (int rr = gw; rr < 4 * MT; rr += NGW) { const int i = rr / MT, m = rr % MT;
        const float* src = (m < MP) ? (const float*)in_ptr(8) + ((size_t)i * MP + m) * DPLE : (const float*)in_ptr(9) + ((size_t)i * MS + (m - MP)) * DPLE;
        const f32x4 v = *((const f32x4*)src + lane); u32x2 w; w.x = pk2(v[0], v[1]); w.y = pk2(v[2], v[3]);
        *((u32x2*)((bf16_t*)(ws + WS_PB) + (size_t)rr * DPLE) + lane) = w; }
    { const int* pt = (const int*)in_ptr(7); const float* ckv = (const float*)in_ptr(2); bf16_t* cs = (bf16_t*)(ws + WS_CS);
      const int kv = lane >> 5, gg = (lane >> 4) & 1, c4 = lane & 15;
      for (int rr = gw; rr < 2 * DECB * PAST; rr += NGW) { const int layer = rr / (DECB * PAST), q = rr % (DECB * PAST), b = q / PAST, t = q % PAST;
          const int page = pt[b * NPAGES + (t >> 7)];
          const f32x4 v = *((const f32x4*)(ckv + ((size_t)(layer * NPOOL + page) * PAGE + (t & 127)) * 512) + lane);
          u32x2 w; w.x = pk2(v[0], v[1]); w.y = pk2(v[2], v[3]);
          *(u32x2*)(cs + ((size_t)(((layer * 2 + kv) * DECB + b) * 2 + gg) * PAST + t) * 64 + c4 * 4) = w; } }
    for (int it = gw; it < 4 * 4 * 32; it += NGW) { const int mt = it >> 7, hc = (it >> 5) & 3, sl = it & 31; const int h = hc * 64 + lane;
        const float* pe = (const float*)in_ptr(12) + (size_t)mt * 2048; const float* w1 = (const float*)in_ptr(13) + (size_t)mt * 2048 * 256;
        float s = 0.f;
#pragma unroll 8
        for (int k = 0; k < 64; ++k) { const int kk = sl * 64 + k; s += pe[kk] * w1[(size_t)kk * 256 + h]; }
        ((float*)(ws + WS_B1PART))[(mt * 32 + sl) * 256 + h] = s; }
    { const f32x4* src = (const f32x4*)in_ptr(3); f32x4* dst = (f32x4*)(F.out + O_WINS);
      const size_t per = (size_t)508 * 64, tot = (size_t)2 * DECB * per;
      for (size_t e = (size_t)gw * 64 + lane; e < tot; e += (size_t)NGW * 64) { const size_t jb = e / per, q = e % per; dst[jb * (512 * 64) + q] = src[jb * (512 * 64) + 4 * 64 + q]; } }
}

__device__ __forceinline__ void load_b1p(Frame& F) {
    LAS float* tb = (LAS float*)(F.lds + LDS_B1P_OFF); const float* part = (const float*)(F.ws + WS_B1PART);
    for (int o = F.tid; o < 1024; o += 512) { const int mt = o >> 8, h = o & 255; float s = ((const float*)in_ptr(14))[o];
        for (int sl = 0; sl < 32; ++sl) s += part[(mt * 32 + sl) * 256 + h];
        tb[o] = s; }
    __syncthreads();
}

__device__ __forceinline__ void cmp_stage2(Frame& F, const bf16_t* hid, const bf16_t* w2t_base, int rows_per_mat, int nrows, bf16_t* outp) {
    const int gw = F.vcu * NWAVES + F.wave, NGW = F.G * NWAVES, lane = F.lane, r32 = lane & 31, hi = lane >> 5;
    for (int task = gw; task < nrows / 32; task += NGW) { const int R0 = task * 32; const bf16_t* w2t = w2t_base + (size_t)(R0 / rows_per_mat) * 64 * 256;
        f32x16 o0 = {0}, o1 = {0};
#pragma unroll 4
        for (int ks = 0; ks < 16; ++ks) {
            const bf16x8 hf = *(const bf16x8*)(hid + (size_t)(R0 + r32) * 256 + 16 * ks + 8 * hi);
            const bf16x8 w0 = *(const bf16x8*)(w2t + (size_t)r32 * 256 + 16 * ks + 8 * hi), w1 = *(const bf16x8*)(w2t + (size_t)(32 + r32) * 256 + 16 * ks + 8 * hi);
            o0 = __builtin_amdgcn_mfma_f32_32x32x16_bf16(w0, hf, o0, 0, 0, 0); o1 = __builtin_amdgcn_mfma_f32_32x32x16_bf16(w1, hf, o1, 0, 0, 0); }
        bf16_t* op = outp + (size_t)(R0 + r32) * 64;
#pragma unroll
        for (int k4 = 0; k4 < 4; ++k4) { u32x2 w; w.x = pk2(o0[4 * k4], o0[4 * k4 + 1]); w.y = pk2(o0[4 * k4 + 2], o0[4 * k4 + 3]); *(u32x2*)(op + 8 * k4 + 4 * hi) = w;
            u32x2 w2; w2.x = pk2(o1[4 * k4], o1[4 * k4 + 1]); w2.y = pk2(o1[4 * k4 + 2], o1[4 * k4 + 3]); *(u32x2*)(op + 32 + 8 * k4 + 4 * hi) = w2; } }
}

__device__ __forceinline__ void ln_phase(Frame& F, const float* pre, const float* g, const float* bta, float* h32, bf16_t* hb) {
    const int gw = F.vcu * NWAVES + F.wave, NGW = F.G * NWAVES, lane = F.lane;
    f32x4 gv[4], bv[4];
#pragma unroll
    for (int jj = 0; jj < 4; ++jj) { gv[jj] = *((const f32x4*)g + lane + 64 * jj); bv[jj] = *((const f32x4*)bta + lane + 64 * jj); }
    for (int m = gw; m < MT; m += NGW) {
        const f32x4* xr = (const f32x4*)(pre + (size_t)m * D) + lane; f32x4 v[4]; float s = 0.f;
#pragma unroll
        for (int jj = 0; jj < 4; ++jj) { v[jj] = xr[64 * jj]; s += (v[jj][0] + v[jj][1]) + (v[jj][2] + v[jj][3]); }
        const float mean = wave_sum(s) * (1.f / D); float s2 = 0.f;
#pragma unroll
        for (int jj = 0; jj < 4; ++jj) { v[jj] = v[jj] - mean; s2 += (v[jj][0] * v[jj][0] + v[jj][1] * v[jj][1]) + (v[jj][2] * v[jj][2] + v[jj][3] * v[jj][3]); }
        const float rstd = 1.f / sqrtf(wave_sum(s2) * (1.f / D) + LN_EPS);
#pragma unroll
        for (int jj = 0; jj < 4; ++jj) { const f32x4 y = v[jj] * rstd * gv[jj] + bv[jj]; *((f32x4*)(h32 + (size_t)m * D) + lane + 64 * jj) = y;
            u32x2 w; w.x = pk2(y[0], y[1]); w.y = pk2(y[2], y[3]); *((u32x2*)(hb + (size_t)m * D) + lane + 64 * jj) = w; }
    }
}

__device__ __forceinline__ void unpack8(const u32x4& w, float (&f)[8]) { f[0] = bflo(w.x); f[1] = bfhi(w.x); f[2] = bflo(w.y); f[3] = bfhi(w.y); f[4] = bflo(w.z); f[5] = bfhi(w.z); f[6] = bflo(w.w); f[7] = bfhi(w.w); }

__device__ __forceinline__ void ffn_conv_phase(Frame& F, const bf16_t* U, const float* cw, const float* cb, const float* state  , bf16_t* ACT) {
    const int gt = F.vcu * 512 + F.tid, NT = F.G * 512;
    constexpr int CG = DFF / 8;
    constexpr int NPI = (MP / 16) * CG;
    constexpr int NSI = DECB * CG;
    for (int it = gt; it < NPI + NSI; it += NT) {
        const bool samp = it >= NPI; const int q = samp ? it - NPI : it; const int cg = q % CG, rc = q / CG, c = cg * 8;
        float w[2][3][8], bb[2][8];
#pragma unroll
        for (int h = 0; h < 2; ++h) {
#pragma unroll
            for (int k = 0; k < 3; ++k) { const f32x4 a = *(const f32x4*)(cw + (size_t)k * 6144 + h * DFF + c), b = *(const f32x4*)(cw + (size_t)k * 6144 + h * DFF + c + 4);
#pragma unroll
                for (int e = 0; e < 4; ++e) { w[h][k][e] = a[e]; w[h][k][4 + e] = b[e]; } }
            const f32x4 a = *(const f32x4*)(cb + h * DFF + c), b = *(const f32x4*)(cb + h * DFF + c + 4);
#pragma unroll
            for (int e = 0; e < 4; ++e) { bb[h][e] = a[e]; bb[h][4 + e] = b[e]; } }
        float p2[2][8], p1[2][8];
        int row0, nrows;
        if (!samp) { row0 = rc * 16; nrows = 16; const int t0 = row0 & 2047;
#pragma unroll
            for (int h = 0; h < 2; ++h) {
                if (t0 == 0) {
#pragma unroll
                    for (int e = 0; e < 8; ++e) { p2[h][e] = 0.f; p1[h][e] = 0.f; } }
                else { unpack8(*(const u32x4*)(U + (size_t)(row0 - 2) * 6144 + h * DFF + c), p2[h]); unpack8(*(const u32x4*)(U + (size_t)(row0 - 1) * 6144 + h * DFF + c), p1[h]); } } }
        else { row0 = MP + rc * 4; nrows = 4;
#pragma unroll
            for (int h = 0; h < 2; ++h) { const float* s0 = state + ((size_t)rc * 2 + 0) * 6144 + h * DFF + c; const float* s1 = state + ((size_t)rc * 2 + 1) * 6144 + h * DFF + c;
#pragma unroll
                for (int e = 0; e < 8; ++e) { p2[h][e] = s0[e]; p1[h][e] = s1[e]; } } }
        for (int r = 0; r < nrows; ++r) {
            float cur[2][8], res[8];
            unpack8(*(const u32x4*)(U + (size_t)(row0 + r) * 6144 + c), cur[0]); unpack8(*(const u32x4*)(U + (size_t)(row0 + r) * 6144 + DFF + c), cur[1]);
#pragma unroll
            for (int e = 0; e < 8; ++e) {
                const float ua = bb[0][e] + p2[0][e] * w[0][0][e] + p1[0][e] * w[0][1][e] + cur[0][e] * w[0][2][e];
                const float ub = bb[1][e] + p2[1][e] * w[1][0][e] + p1[1][e] * w[1][1][e] + cur[1][e] * w[1][2][e];
                res[e] = gelu_t(ua) * ub; p2[0][e] = p1[0][e]; p1[0][e] = cur[0][e]; p2[1][e] = p1[1][e]; p1[1][e] = cur[1][e]; }
            u32x4 o; o.x = pk2(res[0], res[1]); o.y = pk2(res[2], res[3]); o.z = pk2(res[4], res[5]); o.w = pk2(res[6], res[7]);
            *(u32x4*)(ACT + (size_t)(row0 + r) * DFF + c) = o; }
    }
}

__device__ __forceinline__ void rg_conv_phase(Frame& F, const bf16_t* RECB, const float* cw  , const float* cb, const float* state  , bf16_t* REC) {
    const int gt = F.vcu * 512 + F.tid, NT = F.G * 512;
    constexpr int CG = D / 8; constexpr int NPI = (MP / 16) * CG, NSI = DECB * CG;
    for (int it = gt; it < NPI + NSI; it += NT) {
        const bool samp = it >= NPI; const int q = samp ? it - NPI : it; const int cg = q % CG, rc = q / CG, c = cg * 8;
        float w[4][8], bb[8];
#pragma unroll
        for (int k = 0; k < 4; ++k) {
#pragma unroll
            for (int e = 0; e < 8; ++e) w[k][e] = cw[k * D + c + e]; }
#pragma unroll
        for (int e = 0; e < 8; ++e) bb[e] = cb[c + e];
        float p3[8], p2[8], p1[8]; int row0, nrows;
        if (!samp) { row0 = rc * 16; nrows = 16; const int t0 = row0 & 2047;
            if (t0 == 0) {
#pragma unroll
                for (int e = 0; e < 8; ++e) { p3[e] = 0.f; p2[e] = 0.f; p1[e] = 0.f; } }
            else { unpack8(*(const u32x4*)(RECB + (size_t)(row0 - 3) * D + c), p3); unpack8(*(const u32x4*)(RECB + (size_t)(row0 - 2) * D + c), p2); unpack8(*(const u32x4*)(RECB + (size_t)(row0 - 1) * D + c), p1); } }
        else { row0 = MP + rc * 4; nrows = 4;
#pragma unroll
            for (int e = 0; e < 8; ++e) { p3[e] = state[((size_t)rc * 3 + 0) * D + c + e]; p2[e] = state[((size_t)rc * 3 + 1) * D + c + e]; p1[e] = state[((size_t)rc * 3 + 2) * D + c + e]; } }
        for (int r = 0; r < nrows; ++r) {
            float cur[8], res[8]; unpack8(*(const u32x4*)(RECB + (size_t)(row0 + r) * D + c), cur);
#pragma unroll
            for (int e = 0; e < 8; ++e) { res[e] = bb[e] + p3[e] * w[0][e] + p2[e] * w[1][e] + p1[e] * w[2][e] + cur[e] * w[3][e]; p3[e] = p2[e]; p2[e] = p1[e]; p1[e] = cur[e]; }
            u32x4 o; o.x = pk2(res[0], res[1]); o.y = pk2(res[2], res[3]); o.z = pk2(res[4], res[5]); o.w = pk2(res[6], res[7]);
            *(u32x4*)(REC + (size_t)(row0 + r) * D + c) = o; }
    }
}

struct RgCoef { float gab, gxb, sp; };
__device__ __forceinline__ RgCoef rg_coef(const float* ga_b, const float* gx_b, const float* lam, int c) { RgCoef k; k.gab = ga_b[c]; k.gxb = gx_b[c]; k.sp = -8.f * log1pf(__expf(-lam[c])); return k; }
__device__ __forceinline__ void rg_au(const RgCoef& k, float pa, float px, float rec, float& a, float& u) {
    const float r = sigm(pa + k.gab), ig = sigm(px + k.gxb), la = k.sp * r; a = __expf(la); u = sqrtf(-expm1f(2.f * la)) * ig * rec; }
__device__ __forceinline__ void scan1_phase(Frame& F, const float* AA, const float* UU, const bf16_t* REC, const float* ga_b, const float* gx_b, const float* lam, float* CA, float* CH) {
    for (int it = F.vcu; it < BATCH * 32 * 2; it += F.G) { const int bc = it >> 1, c = (it & 1) * 512 + F.tid; const int b = bc >> 5, ch = bc & 31;
        const RgCoef k = rg_coef(ga_b, gx_b, lam, c);
        const size_t r0 = (size_t)b * SEQ + ch * 64; float a = 1.f, h = 0.f;
#pragma unroll 4
        for (int t = 0; t < 64; ++t) { float at, ut; rg_au(k, AA[(r0 + t) * D + c], UU[(r0 + t) * D + c], bf2f(REC[(r0 + t) * D + c]), at, ut); h = at * h + ut; a *= at; }
        CA[(size_t)bc * D + c] = a; CH[(size_t)bc * D + c] = h; }
}
__device__ __forceinline__ void scan2_phase(Frame& F, const float* AA, const float* UU, const bf16_t* REC, const float* ga_b, const float* gx_b, const float* lam, const float* CA, const float* CH, const bf16_t* GG, bf16_t* HG, const float* h0s  , float* out, int j) {
    constexpr int NPI = BATCH * 32 * 2, NSI = DECB * 2;
    for (int it = F.vcu; it < NPI + NSI; it += F.G) {
        if (it < NPI) { const int bc = it >> 1, c = (it & 1) * 512 + F.tid; const int b = bc >> 5, ch = bc & 31;
            const RgCoef k = rg_coef(ga_b, gx_b, lam, c);
            float h = 0.f;
            for (int kk = 0; kk < ch; ++kk) h = CA[(size_t)(b * 32 + kk) * D + c] * h + CH[(size_t)(b * 32 + kk) * D + c];
            const size_t r0 = (size_t)b * SEQ + ch * 64;
#pragma unroll 4
            for (int t = 0; t < 64; ++t) { float at, ut; rg_au(k, AA[(r0 + t) * D + c], UU[(r0 + t) * D + c], bf2f(REC[(r0 + t) * D + c]), at, ut); h = at * h + ut;
                HG[(r0 + t) * D + c] = (bf16_t)f2bf(h * bf2f(GG[(r0 + t) * D + c])); }
            if (ch == 31) out[O_HP + (size_t)(j * BATCH + b) * D + c] = h; }
        else { const int q = it - NPI, b = q >> 1, c = (q & 1) * 512 + F.tid; float h = h0s[(size_t)b * D + c];
            const RgCoef k = rg_coef(ga_b, gx_b, lam, c);
#pragma unroll
            for (int s = 0; s < 4; ++s) { const size_t r = (size_t)MP + b * 4 + s; float at, ut; rg_au(k, AA[r * D + c], UU[r * D + c], bf2f(REC[r * D + c]), at, ut); h = at * h + ut; HG[r * D + c] = (bf16_t)f2bf(h * bf2f(GG[r * D + c])); }
            out[O_HS + (size_t)(j * DECB + b) * D + c] = h; }
    }
}

namespace att {
__device__ __forceinline__ int crow(int r, int hi) { return (r & 3) + 8 * (r >> 2) + 4 * hi; }
__device__ __forceinline__ int koff(int key, int c16) { return key * 128 + ((c16 ^ ((key >> 1) & 7)) << 4); }
__device__ __forceinline__ int voff8(int key, int c8) { return key * 128 + ((c8 ^ (((key >> 1) & 1) << 3)) << 3); }
__device__ __forceinline__ float pmax(float v) { auto rr = __builtin_amdgcn_permlane32_swap(__float_as_uint(v), __float_as_uint(v), false, false); return fmaxf(__uint_as_float(rr[0]), __uint_as_float(rr[1])); }
__device__ __forceinline__ float psum(float v) { auto rr = __builtin_amdgcn_permlane32_swap(__float_as_uint(v), __float_as_uint(v), false, false); return __uint_as_float(rr[0]) + __uint_as_float(rr[1]); }
__device__ __forceinline__ float pother(float v, int hi) { auto rr = __builtin_amdgcn_permlane32_swap(__float_as_uint(v), __float_as_uint(v), false, false); return hi ? __uint_as_float(rr[0]) : __uint_as_float(rr[1]); }
typedef short v4i16_t __attribute__((ext_vector_type(4)));
__device__ __forceinline__ s16x4 vtr(const LAS unsigned char* p) { return __builtin_bit_cast(s16x4, __builtin_amdgcn_ds_read_tr16_b64_v4i16((LAS v4i16_t*)p)); }

__device__ __forceinline__ f32x16 s_tile(const LAS unsigned char* Kt, int key0, const bf16x8 (&qf)[4], int lane) {
    const int kq = lane & 31, hi = lane >> 5; f32x16 s = {0};
#pragma unroll
    for (int ks = 0; ks < 4; ++ks) { const bf16x8 kf = *(const LAS bf16x8*)(Kt + koff(key0 + kq, 2 * ks + hi)); s = __builtin_amdgcn_mfma_f32_32x32x16_bf16(kf, qf[ks], s, 0, 0, 0); }
    return s;
}
__device__ __forceinline__ void pv_tile(const LAS unsigned char* Vt, int key0, const f32x16& p, f32x16 (&o)[2], int lane) {
    const int hi = lane >> 5, gI = (lane >> 4) & 1, l15 = lane & 15, qp = l15 >> 2, pp = l15 & 3;
    unsigned pk[8];
#pragma unroll
    for (int i = 0; i < 8; ++i) pk[i] = pk2(p[2 * i], p[2 * i + 1]);
#pragma unroll
    for (int st = 0; st < 2; ++st) { const u32x4 pw = {pk[4 * st], pk[4 * st + 1], pk[4 * st + 2], pk[4 * st + 3]}; const bf16x8 pb = __builtin_bit_cast(bf16x8, pw);
#pragma unroll
        for (int dt = 0; dt < 2; ++dt) { const int c8 = 8 * dt + 4 * gI + pp, k1 = key0 + 16 * st + 4 * hi + qp;
            const s16x4 lo = vtr(Vt + voff8(k1, c8)), h4 = vtr(Vt + voff8(k1 + 8, c8));
            const bf16x8 vf = {lo[0], lo[1], lo[2], lo[3], h4[0], h4[1], h4[2], h4[3]};
            o[dt] = __builtin_amdgcn_mfma_f32_32x32x16_bf16(vf, pb, o[dt], 0, 0, 0); } }
}
template <class VF>
__device__ __forceinline__ void flash32(const LAS unsigned char* Kt, const LAS unsigned char* Vt, int key0, const bf16x8 (&qf)[4], float& m, float& l, f32x16 (&o)[2], int lane, VF valid) {
    f32x16 s = s_tile(Kt, key0, qf, lane); const int hi = lane >> 5;
    float tm = -1e30f;
#pragma unroll
    for (int r = 0; r < 16; ++r) { const bool v = valid(crow(r, hi)); s[r] = v ? s[r] : -1e30f; tm = fmaxf(tm, s[r]); }
    tm = pmax(tm);
    const float mn = fmaxf(m, tm), f = ex2(m - mn); m = mn;
    float ps = 0.f;
#pragma unroll
    for (int r = 0; r < 16; ++r) { const float p = s[r] > -1e29f ? ex2(s[r] - mn) : 0.f; s[r] = p; ps += p; }
    l = l * f + ps;
#pragma unroll
    for (int r = 0; r < 16; ++r) { o[0][r] *= f; o[1][r] *= f; }
    pv_tile(Vt, key0, s, o, lane);
}

constexpr int P_KT0 = 0, P_VT0 = 8192, P_KT1 = 16384, P_VT1 = 24576, P_KC = 32768, P_VC = 49152, P_IMP = 65536, P_IMPS = 98304, P_SELM = 102400;

__device__ __forceinline__ void stage_kv64(LAS unsigned char* Kt, LAS unsigned char* Vt, const u32x4& rk, const u32x4& rv, int tid) {
    const int key = tid >> 3, c16 = tid & 7;
    *(LAS u32x4*)(Kt + koff(key, c16)) = rk; *(LAS u32x4*)(Vt + key * 128 + ((c16 ^ (((key >> 1) & 1) << 2)) << 4)) = rv;
}

__device__ __forceinline__ void nsa_prompt_item(LAS unsigned char* lds, int b, int qblk, int g, const bf16_t* QB, const bf16_t* KV6, const bf16_t* KCP, const float* G32, bf16_t* OB) {
    int tid_ = threadIdx.x; asm volatile("" : "+v"(tid_));
    const int tid = tid_, lane = tid & 63, w = __builtin_amdgcn_readfirstlane(tid >> 6), q = lane & 31, hi = lane >> 5;
    const int t0 = 32 * qblk, t = t0 + q, cur = qblk >> 1, head = 8 * g + w; const size_t m = (size_t)b * SEQ + t;
#pragma unroll
    for (int i = 0; i < 2; ++i) { const int idx = tid + 512 * i, key = idx >> 3, c16 = idx & 7;
        const u32x4 kk = *(const u32x4*)(KCP + ((size_t)((0 * 16 + b * 2 + g) * 128 + key)) * 64 + c16 * 8), vv = *(const u32x4*)(KCP + ((size_t)((1 * 16 + b * 2 + g) * 128 + key)) * 64 + c16 * 8);
        *(LAS u32x4*)(lds + P_KC + koff(key, c16)) = kk; *(LAS u32x4*)(lds + P_VC + key * 128 + ((c16 ^ (((key >> 1) & 1) << 2)) << 4)) = vv; }
    bf16x8 qf[4];
#pragma unroll
    for (int ks = 0; ks < 4; ++ks) qf[ks] = *(const bf16x8*)(QB + m * 1024 + head * 64 + 16 * ks + 8 * hi);
    const float g0 = G32[m * 48 + g * 24 + w * 3 + 0], g1 = G32[m * 48 + g * 24 + w * 3 + 1], g2 = G32[m * 48 + g * 24 + w * 3 + 2];
    __syncthreads();
    f32x16 otot[2];
    {
        f32x16 s[4]; float mx = -1e30f;
#pragma unroll
        for (int tl = 0; tl < 4; ++tl) { s[tl] = s_tile(lds + P_KC, 32 * tl, qf, lane);
#pragma unroll
            for (int r = 0; r < 16; ++r) { const int c = 32 * tl + crow(r, hi); const bool v = (16 * c + 31 <= t); s[tl][r] = v ? s[tl][r] : -1e30f; mx = fmaxf(mx, s[tl][r]); } }
        mx = pmax(mx); float sum = 0.f;
#pragma unroll
        for (int tl = 0; tl < 4; ++tl)
#pragma unroll
            for (int r = 0; r < 16; ++r) { const float e = s[tl][r] > -1e29f ? ex2(s[tl][r] - mx) : 0.f; s[tl][r] = e; sum += e; }
        sum = psum(sum); const float inv = 1.f / fmaxf(sum, 1e-30f);
        float G[16], lastv[16];
#pragma unroll
        for (int tl = 0; tl < 4; ++tl)
#pragma unroll
            for (int k = 0; k < 4; ++k) { float a = 0.f;
#pragma unroll
                for (int i = 0; i < 4; ++i) { s[tl][4 * k + i] *= inv; a += s[tl][4 * k + i]; }
                G[4 * tl + k] = a; lastv[4 * tl + k] = s[tl][4 * k + 3]; }
        float oth[16];
#pragma unroll
        for (int i = 0; i < 16; ++i) oth[i] = pother(lastv[i], hi);
        LAS float* imp = (LAS float*)(lds + P_IMP) + (w * 32 + q) * 32;
#pragma unroll
        for (int i = 0; i < 16; ++i) { const int tl = i >> 2, k = i & 3; const int n = 2 * k + hi + 8 * tl;
            const float prev = hi ? oth[i] : (i ? oth[i - 1] : 0.f); imp[n] = G[i] + prev; }
        f32x16 oc[2] = {{0}, {0}};
#pragma unroll
        for (int tl = 0; tl < 4; ++tl) pv_tile(lds + P_VC, 32 * tl, s[tl], oc, lane);
        otot[0] = oc[0] * g0; otot[1] = oc[1] * g0;
    }
    __syncthreads();
    {
        const int qq = lane >> 4, n2 = lane & 15, qs = 4 * w + qq;
        LAS float* imps = (LAS float*)(lds + P_IMPS) + qs * 32; float val[2];
#pragma unroll
        for (int e = 0; e < 2; ++e) { const int n = n2 + 16 * e; float v = 0.f;
#pragma unroll
            for (int ww = 0; ww < 8; ++ww) v += ((LAS float*)(lds + P_IMP))[(ww * 32 + qs) * 32 + n];
            if (n == 0 || n == cur || n == cur - 1) v = 1e6f;
            if (n > cur) v = -1.f;
            val[e] = v; imps[n] = v; }
        LDS_WAIT(); asm volatile("" ::: "memory");
        int rank0 = 0, rank1 = 0;
        for (int np = 0; np < 32; ++np) { const float vp = imps[np];
            rank0 += (vp > val[0] || (vp == val[0] && np < n2)) ? 1 : 0; rank1 += (vp > val[1] || (vp == val[1] && np < n2 + 16)) ? 1 : 0; }
        const unsigned long long b0 = __ballot(rank0 < 16), b1 = __ballot(rank1 < 16);
        const unsigned mask = (unsigned)((b0 >> (16 * qq)) & 0xffffull) | ((unsigned)((b1 >> (16 * qq)) & 0xffffull) << 16);
        if (n2 == 0) ((LAS unsigned*)(lds + P_SELM))[qs] = mask;
    }
    __syncthreads();
    const unsigned mymask = ((LAS unsigned*)(lds + P_SELM))[q];
    unsigned um = mymask;
#pragma unroll
    for (int o = 1; o < 32; o <<= 1) um |= (unsigned)__shfl_xor((int)um, o);
    um = (unsigned)__builtin_amdgcn_readfirstlane((int)um);
    const bf16_t* Ksel = KV6 + ((size_t)((2 * 8 + b) * 2 + g) * 2048) * 64; const bf16_t* Vsel = KV6 + ((size_t)((3 * 8 + b) * 2 + g) * 2048) * 64;
    const bf16_t* Kwin = KV6 + ((size_t)((4 * 8 + b) * 2 + g) * 2048) * 64; const bf16_t* Vwin = KV6 + ((size_t)((5 * 8 + b) * 2 + g) * 2048) * 64;
    const int ldoff = (tid >> 3) * 64 + (tid & 7) * 8;
    {
        unsigned rem = um & (cur == 31 ? 0xffffffffu : ((1u << (cur + 1)) - 1u));
        float mm = -1e30f, ll = 0.f; f32x16 o[2] = {{0}, {0}};
        int n = __builtin_ctz(rem); rem &= rem - 1;
        u32x4 rk = *(const u32x4*)(Ksel + (size_t)n * 4096 + ldoff), rv = *(const u32x4*)(Vsel + (size_t)n * 4096 + ldoff);
        int buf = 0;
        for (;;) {
            LAS unsigned char* Kt = lds + (buf ? P_KT1 : P_KT0); LAS unsigned char* Vt = lds + (buf ? P_VT1 : P_VT0);
            stage_kv64(Kt, Vt, rk, rv, tid);
            __syncthreads();
            const int nn = rem ? __builtin_ctz(rem) : -1;
            if (nn >= 0) { rem &= rem - 1; rk = *(const u32x4*)(Ksel + (size_t)nn * 4096 + ldoff); rv = *(const u32x4*)(Vsel + (size_t)nn * 4096 + ldoff); }
            const bool selq = (mymask >> n) & 1u;
#pragma unroll
            for (int hf = 0; hf < 2; ++hf) { const int kb = 64 * n + 32 * hf;
                flash32(Kt, Vt, 32 * hf, qf, mm, ll, o, lane, [&](int kk) { return selq && (kb + kk <= t); }); }
            if (nn < 0) break;
            n = nn; buf ^= 1;
        }
        ll = psum(ll); const float sc = g1 / fmaxf(ll, 1e-30f);
        otot[0] += o[0] * sc; otot[1] += o[1] * sc;
    }
    __syncthreads();
    {
        const int nlo = cur - 8 < 0 ? 0 : cur - 8;
        float mm = -1e30f, ll = 0.f; f32x16 o[2] = {{0}, {0}};
        u32x4 rk = *(const u32x4*)(Kwin + (size_t)nlo * 4096 + ldoff), rv = *(const u32x4*)(Vwin + (size_t)nlo * 4096 + ldoff);
        int buf = 0;
        for (int n = nlo; n <= cur; ++n) {
            LAS unsigned char* Kt = lds + (buf ? P_KT1 : P_KT0); LAS unsigned char* Vt = lds + (buf ? P_VT1 : P_VT0);
            stage_kv64(Kt, Vt, rk, rv, tid);
            __syncthreads();
            if (n < cur) { rk = *(const u32x4*)(Kwin + (size_t)(n + 1) * 4096 + ldoff); rv = *(const u32x4*)(Vwin + (size_t)(n + 1) * 4096 + ldoff); }
#pragma unroll
            for (int hf = 0; hf < 2; ++hf) { const int kb = 64 * n + 32 * hf;
                flash32(Kt, Vt, 32 * hf, qf, mm, ll, o, lane, [&](int kk) { const int key = kb + kk; return key <= t && key >= t - 512; }); }
            buf ^= 1;
        }
        ll = psum(ll); const float sc = g2 / fmaxf(ll, 1e-30f);
        otot[0] += o[0] * sc; otot[1] += o[1] * sc;
    }
    bf16_t* op = OB + m * 1024 + head * 64;
#pragma unroll
    for (int dt = 0; dt < 2; ++dt)
#pragma unroll
        for (int k4 = 0; k4 < 4; ++k4) { u32x2 wv; wv.x = pk2(otot[dt][4 * k4], otot[dt][4 * k4 + 1]); wv.y = pk2(otot[dt][4 * k4 + 2], otot[dt][4 * k4 + 3]);
            *(u32x2*)(op + 32 * dt + 8 * k4 + 4 * hi) = wv; }
    __syncthreads();
}

constexpr int S_TILE = 0  , S_OBUF = 0  , S_KC = 65536, S_VC = 81920, S_PBUF = 98304  ,
              S_MST = 114688  , S_LST = 115712, S_IMPS = 116736  , S_SELF = 117376  ;

__device__ __forceinline__ void s_write_partial(LAS unsigned char* lds, int w, int lane, float mm, float ll, const f32x16 (&o)[2]) {
    const int j = lane & 31, hi = lane >> 5;
    if (hi == 0) { ((LAS float*)(lds + S_MST))[w * 32 + j] = mm; ((LAS float*)(lds + S_LST))[w * 32 + j] = ll; }
    LAS float* ob = (LAS float*)(lds + S_OBUF) + w * 2048;
#pragma unroll
    for (int dt = 0; dt < 2; ++dt)
#pragma unroll
        for (int r = 0; r < 16; ++r) ob[(32 * dt + crow(r, hi)) * 32 + j] = o[dt][r];
}
__device__ __forceinline__ void s_merge(LAS unsigned char* lds, int nw, int tid, float gate, float (&acc)[4]) {
    const int j = tid & 31; const LAS float* ms = (const LAS float*)(lds + S_MST); const LAS float* ls = (const LAS float*)(lds + S_LST);
    float M = -1e30f;
    for (int w = 0; w < nw; ++w) M = fmaxf(M, ms[w * 32 + j]);
    float L = 0.f, wt[8];
    for (int w = 0; w < 8; ++w) { wt[w] = (w < nw) ? ex2(ms[w * 32 + j] - M) : 0.f; if (w < nw) L += ls[w * 32 + j] * wt[w]; }
    const float sc = gate / fmaxf(L, 1e-30f);
#pragma unroll
    for (int i = 0; i < 4; ++i) { const int d = (tid >> 5) + 16 * i; float v = 0.f;
        for (int w = 0; w < nw; ++w) v += ((const LAS float*)(lds + S_OBUF))[w * 2048 + d * 32 + j] * wt[w];
        acc[i] += v * sc; }
}
__device__ __forceinline__ void s_load_half_f32(LAS unsigned char* Kt, LAS unsigned char* Vt, const float* ksrc, const float* vsrc, size_t rstride, int nvalid, int lane) {
    const int kr = lane >> 4, c = lane & 15;
#pragma unroll
    for (int i = 0; i < 8; ++i) { const int key = 4 * i + kr; f32x4 kv = {0.f, 0.f, 0.f, 0.f}, vv = {0.f, 0.f, 0.f, 0.f};
        if (key < nvalid) { kv = *(const f32x4*)(ksrc + (size_t)key * rstride + 4 * c); vv = *(const f32x4*)(vsrc + (size_t)key * rstride + 4 * c); }
        u32x2 kw; kw.x = pk2(kv[0], kv[1]); kw.y = pk2(kv[2], kv[3]); u32x2 vw; vw.x = pk2(vv[0], vv[1]); vw.y = pk2(vv[2], vv[3]);
        *(LAS u32x2*)(Kt + koff(key, c >> 1) + 8 * (c & 1)) = kw; *(LAS u32x2*)(Vt + voff8(key, c)) = vw; }
}
__device__ __forceinline__ void s_load_rows_bf16(LAS unsigned char* Kt, LAS unsigned char* Vt, int key0, const bf16_t* ksrc, const bf16_t* vsrc, size_t rstride, int nvalid, int lane) {
    const int kr = lane >> 4, c = lane & 15;
    for (int i = 0; i < 8; ++i) { const int kk = 4 * i + kr; if (kk >= nvalid) break;
        const u32x2 kw = *(const u32x2*)(ksrc + (size_t)kk * rstride + 4 * c), vw = *(const u32x2*)(vsrc + (size_t)kk * rstride + 4 * c);
        *(LAS u32x2*)(Kt + koff(key0 + kk, c >> 1) + 8 * (c & 1)) = kw; *(LAS u32x2*)(Vt + voff8(key0 + kk, c)) = vw; }
}

__device__ __forceinline__ void nsa_sample_item(LAS unsigned char* lds, int b, int g, int layer, const bf16_t* QB, const bf16_t* KVS, const bf16_t* KCS, const float* G32,
                                                const float* ckv, const float* cwin, const int* pt, bf16_t* OB) {
    int tid_ = threadIdx.x; asm volatile("" : "+v"(tid_));
    const int tid = tid_, lane = tid & 63, w = __builtin_amdgcn_readfirstlane(tid >> 6), j = lane & 31, hi = lane >> 5, qy = j >> 3, hh = j & 7;
    const size_t ms = (size_t)MP + 4 * b + qy; const int head = 8 * g + hh;
#pragma unroll
    for (int i = 0; i < 2; ++i) { const int idx = tid + 512 * i, key = idx >> 3, c16 = idx & 7;
        const u32x4 kk = *(const u32x4*)(KCS + ((size_t)((((layer * 2 + 0) * DECB + b) * 2 + g) * 128 + key)) * 64 + c16 * 8), vv = *(const u32x4*)(KCS + ((size_t)((((layer * 2 + 1) * DECB + b) * 2 + g) * 128 + key)) * 64 + c16 * 8);
        *(LAS u32x4*)(lds + S_KC + koff(key, c16)) = kk; *(LAS u32x4*)(lds + S_VC + key * 128 + ((c16 ^ (((key >> 1) & 1) << 2)) << 4)) = vv; }
    bf16x8 qf[4];
#pragma unroll
    for (int ks = 0; ks < 4; ++ks) qf[ks] = *(const bf16x8*)(QB + ms * 1024 + head * 64 + 16 * ks + 8 * hi);
    const float g0 = G32[ms * 48 + g * 24 + hh * 3 + 0], g1 = G32[ms * 48 + g * 24 + hh * 3 + 1], g2 = G32[ms * 48 + g * 24 + hh * 3 + 2];
    float acc[4] = {0.f, 0.f, 0.f, 0.f};
    __syncthreads();
    if (w < 4) {
        f32x16 s = s_tile(lds + S_KC, 32 * w, qf, lane); float mx = -1e30f;
#pragma unroll
        for (int r = 0; r < 16; ++r) { const int c = 32 * w + crow(r, hi); s[r] = (c < 127) ? s[r] : -1e30f; mx = fmaxf(mx, s[r]); }
        mx = pmax(mx); float sum = 0.f;
#pragma unroll
        for (int r = 0; r < 16; ++r) { const float e = s[r] > -1e29f ? ex2(s[r] - mx) : 0.f; s[r] = e; sum += e; ((LAS float*)(lds + S_PBUF))[(32 * w + crow(r, hi)) * 32 + j] = e; }
        sum = psum(sum);
        f32x16 o[2] = {{0}, {0}}; pv_tile(lds + S_VC, 32 * w, s, o, lane);
        s_write_partial(lds, w, lane, mx, sum, o);
    }
    __syncthreads();
    s_merge(lds, 4, tid, g0, acc);
    if (tid < 132) { const int q4 = tid / 33, n = tid % 33; float v = 0.f;
        const LAS float* msb = (const LAS float*)(lds + S_MST); const LAS float* lsb = (const LAS float*)(lds + S_LST);
        for (int h8 = 0; h8 < 8; ++h8) { const int jj = 8 * q4 + h8; float M = -1e30f;
            for (int ww = 0; ww < 4; ++ww) M = fmaxf(M, msb[ww * 32 + jj]);
            float L = 0.f; for (int ww = 0; ww < 4; ++ww) L += lsb[ww * 32 + jj] * ex2(msb[ww * 32 + jj] - M);
            float a = 0.f;
            for (int c = 4 * n - 1; c <= 4 * n + 3; ++c) if (c >= 0 && c < 127) a += ((const LAS float*)(lds + S_PBUF))[c * 32 + jj] * ex2(msb[(c >> 5) * 32 + jj] - M);
            v += a / fmaxf(L, 1e-30f); }
        if (n == 0 || n == 32 || n == 31) v = 1e6f;
        ((LAS float*)(lds + S_IMPS))[q4 * 33 + n] = v; }
    __syncthreads();
    if (tid < 132) { const int q4 = tid / 33, n = tid % 33; const float v = ((const LAS float*)(lds + S_IMPS))[q4 * 33 + n]; int rank = 0;
        for (int np = 0; np < 33; ++np) { const float vp = ((const LAS float*)(lds + S_IMPS))[q4 * 33 + np]; rank += (vp > v || (vp == v && np < n)) ? 1 : 0; }
        ((LAS unsigned*)(lds + S_SELF))[q4 * 33 + n] = rank < 16 ? 1u : 0u; }
    __syncthreads();
    unsigned long long mymask = 0ull, um = 0ull;
    for (int n = 0; n < 33; ++n) { const LAS unsigned* sf = (const LAS unsigned*)(lds + S_SELF);
        if (sf[qy * 33 + n]) mymask |= 1ull << n;
        if (sf[n] | sf[33 + n] | sf[66 + n] | sf[99 + n]) um |= 1ull << n; }
    LAS unsigned char* Kt = lds + S_TILE + w * 8192; LAS unsigned char* Vt = Kt + 4096;
    {
        float mm = -1e30f, ll = 0.f; f32x16 o[2] = {{0}, {0}}; int idx = 0;
        for (int n = 0; n < 33; ++n) { if (!((um >> n) & 1ull)) continue;
            for (int hf = 0; hf < 2; ++hf) { if (n == 32 && hf == 1) break;
                if ((idx++ & 7) != w) continue;
                if (n < 32) { const int page = pt[b * NPAGES + (n >> 1)]; const float* base = ckv + ((size_t)(layer * NPOOL + page) * PAGE + (n & 1) * 64 + 32 * hf) * 512 + g * 64;
                    s_load_half_f32(Kt, Vt, base + 2 * 128, base + 3 * 128, 512, 32, lane); }
                else { s_load_half_f32(Kt, Vt, nullptr, nullptr, 0, 0, lane); LDS_WAIT();
                    s_load_rows_bf16(Kt, Vt, 0, KVS + (size_t)(4 * b) * 768 + 2 * 128 + g * 64, KVS + (size_t)(4 * b) * 768 + 3 * 128 + g * 64, 768, 4, lane); }
                LDS_WAIT(); asm volatile("" ::: "memory");
                const bool selq = (mymask >> n) & 1ull; const int pos0 = 64 * n + 32 * hf;
                flash32(Kt, Vt, 0, qf, mm, ll, o, lane, [&](int kk) { return selq && (pos0 + kk <= PAST + qy); });
                LDS_WAIT(); asm volatile("" ::: "memory"); } }
        ll = psum(ll);
        __syncthreads();
        s_write_partial(lds, w, lane, mm, ll, o);
        __syncthreads();
        s_merge(lds, 8, tid, g1, acc);
        __syncthreads();
    }
    {
        float mm = -1e30f, ll = 0.f; f32x16 o[2] = {{0}, {0}};
        for (int ht = w; ht < 17; ht += 8) {
            if (ht < 16) { const float* base = cwin + ((size_t)(layer * DECB + b) * 512 + 32 * ht) * 256 + g * 64; s_load_half_f32(Kt, Vt, base, base + 128, 256, 32, lane); }
            else { s_load_half_f32(Kt, Vt, nullptr, nullptr, 0, 0, lane); LDS_WAIT();
                s_load_rows_bf16(Kt, Vt, 0, KVS + (size_t)(4 * b) * 768 + 4 * 128 + g * 64, KVS + (size_t)(4 * b) * 768 + 5 * 128 + g * 64, 768, 4, lane); }
            LDS_WAIT(); asm volatile("" ::: "memory");
            const int i0 = 32 * ht;
            flash32(Kt, Vt, 0, qf, mm, ll, o, lane, [&](int kk) { const int ix = i0 + kk; return ix >= qy && ix <= 512 + qy; });
            LDS_WAIT(); asm volatile("" ::: "memory"); }
        ll = psum(ll);
        __syncthreads();
        s_write_partial(lds, w, lane, mm, ll, o);
        __syncthreads();
        s_merge(lds, 8, tid, g2, acc);
    }
    { const int jj = tid & 31; const size_t mr = (size_t)MP + 4 * b + (jj >> 3); const int hd = 8 * g + (jj & 7);
#pragma unroll
      for (int i = 0; i < 4; ++i) { const int d = (tid >> 5) + 16 * i; OB[mr * 1024 + hd * 64 + d] = (bf16_t)f2bf(acc[i]); } }
    __syncthreads();
}
}

constexpr int N_PHASES = 4 + 4 * 12;
__global__ void __launch_bounds__(NWAVES * 64, 2) mega_fwd(Args args) {
    extern __shared__ __attribute__((aligned(16))) unsigned char lds_raw[];
    Frame F;
    F.lds = (LAS unsigned char*)lds_raw; F.tid = threadIdx.x; F.lane = F.tid & 63; F.wave = __builtin_amdgcn_readfirstlane(F.tid >> 6);
    F.G = gridDim.x; { const int bx = blockIdx.x; F.vcu = (F.G % 8 == 0) ? (bx % 8) * (F.G / 8) + bx / 8 : bx; }
    F.ws = args.ws; F.out = args.out;
    unsigned char* ws0 = args.ws; float* out0 = args.out; int layer0 = 0;
#define PH_LOCALS unsigned char* ws = ws0; asm volatile("" : "+s"(ws)); float* outl = out0; asm volatile("" : "+s"(outl)); int layer = layer0; asm volatile("" : "+s"(layer)); const int j = layer >> 1; (void)j; int bx = (int)blockIdx.x; asm volatile("" : "+s"(bx)); (void)bx; F.ws = ws; F.out = outl; { const int G_ = F.G; F.vcu = (G_ % 8 == 0) ? (bx % 8) * (G_ / 8) + bx / 8 : bx; } { int t_ = threadIdx.x; asm volatile("" : "+v"(t_)); F.tid = t_; F.lane = t_ & 63; F.wave = __builtin_amdgcn_readfirstlane(t_ >> 6); }
    for (int u = F.tid; u < (LDS_BYTES - LDSCTL_OFF) / 4; u += NWAVES * 64) ((LAS unsigned*)(F.lds + LDSCTL_OFF))[u] = 0u;
    __syncthreads();
    const int lo = args.ph_lo, hi = args.ph_hi;
    XcdBarrier bar = xcd_barrier_post((unsigned*)(ws0 + WS_CTL) + CW_BAR, (volatile LAS unsigned*)(F.lds + MISC_OFF) + 8);
    int ph = 0;
#define IN_PH() (lo <= ph && ph < hi)
#ifndef ONLY_SITE
#define SITE(k) true
#else
#define SITE(k) ((k) == ONLY_SITE)
#endif
#define END_PH() do { if (lo <= ph && ph + 1 < hi) xcd_barrier(bar); ++ph; } while (0)

#ifndef SKIP_P0
    if (IN_PH() && SITE(1)) { PH_LOCALS; p0_prologue(F); }
#endif
    END_PH();
    if (IN_PH() && SITE(2)) { PH_LOCALS;
        { pg8::Gemm g{(const bf16_t*)(ws + WS_PB), (const bf16_t*)(ws + WS_W_PROJ), DPLE, DPLE, DPLE}; pg8::Sched S; S.init(4 * MT / 256, 4, F.G, bx, DPLE, DPLE);
          S.b_pm_mul = pg8::Sched::rmul(MT / 256); S.b_pm_bytes = (long)1024 * DPLE * 2;
          pg8::EpiBf16G<false> E{(bf16_t*)(ws + WS_PP), D, nullptr, 0};
          pg8::gemm_phase(F.lds, g, S, E); }
    }
    END_PH();
    if (IN_PH() && SITE(21)) { PH_LOCALS;
        load_b1p(F);
        { pg8::Gemm g{(const bf16_t*)(ws + WS_CS), (const bf16_t*)(ws + WS_W_CMP1), 1024, 2048, 2048}; pg8::Sched S; S.init(512, 1, F.G, bx, 1024, 2048);
          S.b_pm_mul = pg8::Sched::rmul(128); S.b_pm_bytes = (long)256 * 2048 * 2;
          pg8::EpiBf16G<true> E{(bf16_t*)(ws + WS_HIDS), 256, (const LAS float*)(F.lds + LDS_B1P_OFF), 7};
          pg8::gemm_phase(F.lds, g, S, E); }
    }
    END_PH();
    if (IN_PH() && SITE(3)) { PH_LOCALS; cmp_stage2(F, (const bf16_t*)(ws + WS_HIDS), (const bf16_t*)(ws + WS_W_CMP2), 32768, 131072, (bf16_t*)(ws + WS_KCS)); }
    END_PH();

    for (layer0 = 0; layer0 < DEPTH; ++layer0) {
        if ((layer0 & 1) == 0) {
            if (IN_PH() && SITE(4)) { PH_LOCALS;
                pg8::Gemm g{(const bf16_t*)(ws + WS_XB), (const bf16_t*)(ws + WS_W_NSA_IN) + (size_t)j * NSA_NP * 1024, D, D, D}; pg8::Sched S; S.init(MT / 256, NSA_NP / 256, F.G, bx, D, D);
                pg8::EpiNsaIn E{(bf16_t*)(ws + WS_QB), (bf16_t*)(ws + WS_KV6), (bf16_t*)(ws + WS_KVS), (float*)(ws + WS_G32), F.out, j};
                pg8::gemm_phase(F.lds, g, S, E);
            }
            END_PH();
            if (IN_PH() && SITE(5)) { PH_LOCALS;
                load_b1p(F);
                pg8::Gemm g{(const bf16_t*)(ws + WS_KV6), (const bf16_t*)(ws + WS_W_CMP1) + (size_t)j * 2 * 256 * 2048, 1024, 2048, 2048}; pg8::Sched S; S.init(16, 1, F.G, bx, 1024, 2048);
                S.b_pm_mul = pg8::Sched::rmul(8); S.b_pm_bytes = (long)256 * 2048 * 2;
                pg8::EpiBf16G<true> E{(bf16_t*)(ws + WS_HIDP), 256, (const LAS float*)(F.lds + LDS_B1P_OFF) + j * 512, 3};
                pg8::gemm_phase(F.lds, g, S, E);
            }
            END_PH();
            if (IN_PH() && SITE(6)) { PH_LOCALS; cmp_stage2(F, (const bf16_t*)(ws + WS_HIDP), (const bf16_t*)(ws + WS_W_CMP2) + (size_t)j * 2 * 64 * 256, 2048, 4096, (bf16_t*)(ws + WS_KCP)); }
            END_PH();
            if (IN_PH() && SITE(7)) { PH_LOCALS;
                for (int it = F.vcu; it < 1024; it += F.G) { const int k = it >> 8, a16 = (it >> 4) & 15, bg = it & 15;
                    const int qblk = k == 0 ? 63 - a16 : k == 1 ? 32 + a16 : k == 2 ? 31 - a16 : a16;
                    att::nsa_prompt_item(F.lds, bg >> 1, qblk, bg & 1, (const bf16_t*)(ws + WS_QB), (const bf16_t*)(ws + WS_KV6), (const bf16_t*)(ws + WS_KCP), (const float*)(ws + WS_G32), (bf16_t*)(ws + WS_OB)); }
            }
            END_PH();
            if (IN_PH() && SITE(22)) { PH_LOCALS;
                for (int q = F.vcu; q < 256; q += F.G)
                    att::nsa_sample_item(F.lds, q >> 1, q & 1, j, (const bf16_t*)(ws + WS_QB), (const bf16_t*)(ws + WS_KVS), (const bf16_t*)(ws + WS_KCS), (const float*)(ws + WS_G32),
                                         (const float*)in_ptr(2), (const float*)in_ptr(3), (const int*)in_ptr(7), (bf16_t*)(ws + WS_OB));
            }
            END_PH();
            if (IN_PH() && SITE(8)) { PH_LOCALS;
                pg8::Gemm g{(const bf16_t*)(ws + WS_OB), (const bf16_t*)(ws + WS_W_NSA_OUT) + (size_t)j * D * D, D, D, D}; pg8::Sched S; S.init(MT / 256, 4, F.G, bx, D, D);
                pg8::EpiResid E{(const float*)(ws + WS_X32), (float*)(ws + WS_PRE)};
                pg8::gemm_phase(F.lds, g, S, E);
            }
            END_PH();
        } else {
            if (IN_PH() && SITE(9)) { PH_LOCALS;
                pg8::Gemm g{(const bf16_t*)(ws + WS_XB), (const bf16_t*)(ws + WS_W_RG_IN) + (size_t)j * 2048 * D, D, D, D}; pg8::Sched S; S.init(MT / 256, 8, F.G, bx, D, D);
                pg8::EpiRgIn E{(bf16_t*)(ws + WS_GG), (bf16_t*)(ws + WS_RECB), F.out, j};
                pg8::gemm_phase(F.lds, g, S, E);
            }
            END_PH();
            if (IN_PH() && SITE(10)) { PH_LOCALS; rg_conv_phase(F, (const bf16_t*)(ws + WS_RECB), (const float*)in_ptr(17) + (size_t)j * 4 * D, (const float*)in_ptr(18) + (size_t)j * D,
                                         (const float*)in_ptr(5) + (size_t)j * DECB * 3 * D, (bf16_t*)(ws + WS_REC)); }
            END_PH();
            if (IN_PH() && SITE(11)) { PH_LOCALS;
                pg8::Gemm g{(const bf16_t*)(ws + WS_REC), (const bf16_t*)(ws + WS_W_RG_G) + (size_t)j * 8 * 256 * 256, D, 256, 256}; pg8::Sched S; S.init(MT / 256, 8, F.G, bx, D, 256);
                S.a_pn_mul = pg8::Sched::rmul(2); S.a_pn_bytes = 256 * 2;
                pg8::EpiRgGate E{(float*)(ws + WS_AA), (float*)(ws + WS_UU)};
                pg8::gemm_phase(F.lds, g, S, E);
            }
            END_PH();
            if (IN_PH() && SITE(12)) { PH_LOCALS; scan1_phase(F, (const float*)(ws + WS_AA), (const float*)(ws + WS_UU), (const bf16_t*)(ws + WS_REC), (const float*)in_ptr(20) + (size_t)j * D, (const float*)in_ptr(22) + (size_t)j * D, (const float*)in_ptr(23) + (size_t)j * D, (float*)(ws + WS_CA), (float*)(ws + WS_CH)); }
            END_PH();
            if (IN_PH() && SITE(13)) { PH_LOCALS; scan2_phase(F, (const float*)(ws + WS_AA), (const float*)(ws + WS_UU), (const bf16_t*)(ws + WS_REC), (const float*)in_ptr(20) + (size_t)j * D, (const float*)in_ptr(22) + (size_t)j * D, (const float*)in_ptr(23) + (size_t)j * D, (const float*)(ws + WS_CA), (const float*)(ws + WS_CH), (const bf16_t*)(ws + WS_GG), (bf16_t*)(ws + WS_HG),
                                       (const float*)in_ptr(4) + (size_t)j * DECB * D, F.out, j); }
            END_PH();
            if (IN_PH() && SITE(14)) { PH_LOCALS;
                pg8::Gemm g{(const bf16_t*)(ws + WS_HG), (const bf16_t*)(ws + WS_W_RG_OUT) + (size_t)j * D * D, D, D, D}; pg8::Sched S; S.init(MT / 256, 4, F.G, bx, D, D);
                pg8::EpiResid E{(const float*)(ws + WS_X32), (float*)(ws + WS_PRE)};
                pg8::gemm_phase(F.lds, g, S, E);
            }
            END_PH();
        }
        if (IN_PH() && SITE(15)) { PH_LOCALS; ln_phase(F, (const float*)(ws + WS_PRE), (const float*)in_ptr(29) + (size_t)layer * D, (const float*)in_ptr(30) + (size_t)layer * D, (float*)(ws + WS_H32), (bf16_t*)(ws + WS_HB)); }
        END_PH();
        if (IN_PH() && SITE(16)) { PH_LOCALS;
            pg8::Gemm g{(const bf16_t*)(ws + WS_HB), (const bf16_t*)(ws + WS_W_UP) + (size_t)layer * 6144 * D, D, D, D}; pg8::Sched S; S.init(MT / 256, 24, F.G, bx, D, D);
            pg8::EpiUp E{(bf16_t*)(ws + WS_U), F.out, layer};
            pg8::gemm_phase(F.lds, g, S, E);
        }
        END_PH();
        if (IN_PH() && SITE(17)) { PH_LOCALS; ffn_conv_phase(F, (const bf16_t*)(ws + WS_U), (const float*)in_ptr(26) + (size_t)layer * 3 * 6144, (const float*)in_ptr(27) + (size_t)layer * 6144,
                                      (const float*)in_ptr(6) + (size_t)layer * DECB * 2 * 6144, (bf16_t*)(ws + WS_ACT)); }
        END_PH();
        if (IN_PH() && SITE(18)) { PH_LOCALS;
            pg8::Gemm g{(const bf16_t*)(ws + WS_ACT), (const bf16_t*)(ws + WS_W_DOWN) + (size_t)layer * D * DFF, DFF, DFF, DFF}; pg8::Sched S; S.init(MT / 256, 4, F.G, bx, DFF, DFF);
            pg8::EpiResid E{(const float*)(ws + WS_H32), (float*)(ws + WS_PRE)};
            pg8::gemm_phase(F.lds, g, S, E);
        }
        END_PH();
        if (IN_PH() && SITE(19)) { PH_LOCALS; ln_phase(F, (const float*)(ws + WS_PRE), (const float*)in_ptr(31) + (size_t)layer * D, (const float*)in_ptr(32) + (size_t)layer * D, (float*)(ws + WS_H32), (bf16_t*)(ws + WS_HB)); }
        END_PH();
        if (IN_PH() && SITE(20)) { PH_LOCALS;
            pg8::Gemm g{(const bf16_t*)(ws + WS_HB), (const bf16_t*)(ws + WS_W_GATE) + (size_t)layer * D * D, D, D, D}; pg8::Sched S; S.init(MT / 256, 4, F.G, bx, D, D);
            pg8::EpiPle E{(const float*)(ws + WS_H32), (const bf16_t*)(ws + WS_PP) + (size_t)layer * MT * D, (float*)(ws + WS_X32), (bf16_t*)(ws + WS_XB), F.out, layer == DEPTH - 1 ? 1 : 0};
            pg8::gemm_phase(F.lds, g, S, E);
        }
        END_PH();
    }
}

extern "C" void kernel_launch(void* const* d_in, const int* in_sizes, int n_in, void* d_out, int out_size, void* d_ws, size_t ws_size, hipStream_t stream) {
    static int grid = 0;
    if (grid == 0) {
        if (n_in != 35 || (size_t)out_size != O_END || ws_size < WS_END) { fprintf(stderr, "kernel_launch: unexpected problem (n_in %d, out %d, ws %zu need %zu)\n", n_in, out_size, ws_size, (size_t)WS_END); grid = -1; return; }
        int dev = 0, cus = 0, per_cu = 0;
        if (hipGetDevice(&dev) != hipSuccess || hipDeviceGetAttribute(&cus, hipDeviceAttributeMultiprocessorCount, dev) != hipSuccess) { grid = -1; return; }
        if (hipFuncSetAttribute((const void*)mega_fwd, hipFuncAttributeMaxDynamicSharedMemorySize, LDS_BYTES) != hipSuccess) { fprintf(stderr, "kernel_launch: hipFuncSetAttribute failed\n"); grid = -1; return; }
        if (hipOccupancyMaxActiveBlocksPerMultiprocessor(&per_cu, (const void*)mega_fwd, NWAVES * 64, LDS_BYTES) != hipSuccess || per_cu < 1)
            fprintf(stderr, "kernel_launch: occupancy query reports %d blocks per CU\n", per_cu);
        (void)hipGetLastError();
        grid = cus;
    }
    if (grid < 0) return;
    hipMemsetAsync((char*)d_ws + WS_CTL, 0, CTL_ZERO_BYTES, stream);
    Args a{};
    for (int i = 0; i < 35; ++i) a.in[i] = d_in[i];
    a.out = (float*)d_out; a.ws = (unsigned char*)d_ws;
#if MK_ONE_LAUNCH
    a.ph_lo = 0; a.ph_hi = N_PHASES;
    hipLaunchKernelGGL(mega_fwd, dim3(grid), dim3(NWAVES * 64), LDS_BYTES, stream, a);
#else
    for (int p = 0; p < N_PHASES; ++p) { a.ph_lo = p; a.ph_hi = p + 1; hipLaunchKernelGGL(mega_fwd, dim3(grid), dim3(NWAVES * 64), LDS_BYTES, stream, a); }
#endif
}
```

```cpp
#include <hip/hip_runtime.h>
#include <cstdio>
#include <cstdint>

#ifndef MK_ONE_LAUNCH
#define MK_ONE_LAUNCH 1
#endif
#ifndef PROBE_MASK
#define PROBE_MASK 0ull
#endif

#define LAS __attribute__((address_space(3)))
#define GAS __attribute__((address_space(1)))
typedef unsigned short bf16_t;
typedef short bf16x8 __attribute__((ext_vector_type(8)));
typedef short s16x4 __attribute__((ext_vector_type(4)));
typedef float f32x4 __attribute__((ext_vector_type(4)));
typedef float f32x2 __attribute__((ext_vector_type(2)));
typedef float f32x16 __attribute__((ext_vector_type(16)));
typedef unsigned u32x4 __attribute__((ext_vector_type(4)));
typedef unsigned u32x2 __attribute__((ext_vector_type(2)));

constexpr int D = 1024, BATCH = 8, SEQ = 2048, DEPTH = 4, DECB = 128, DECS = 4, PAST = 2048, PAGE = 128;
constexpr int MP = BATCH * SEQ, MS = DECB * DECS, MT = MP + MS;
constexpr int NPOOL = 2560, NPAGES = 16;
constexpr int DFF = 3072, DPLE = 256;
constexpr int NSA_N = 1840, NSA_NP = 2048;
constexpr float ALPHA = 1.6817928305074290f;
constexpr float LN_EPS = 1e-5f;
constexpr float QSCALE = 0.125f * 1.4426950408889634f;

constexpr size_t O_YP = 0;
constexpr size_t O_YS = O_YP + (size_t)MP * D;
constexpr size_t O_KVP = O_YS + (size_t)MS * D;
constexpr size_t O_KVS = O_KVP + (size_t)2 * MP * 512;
constexpr size_t O_WINP = O_KVS + (size_t)2 * MS * 512;
constexpr size_t O_WINS = O_WINP + (size_t)2 * BATCH * 512 * 256;
constexpr size_t O_HP = O_WINS + (size_t)2 * DECB * 512 * 256;
constexpr size_t O_HS = O_HP + (size_t)2 * BATCH * D;
constexpr size_t O_RCP = O_HS + (size_t)2 * DECB * D;
constexpr size_t O_RCS = O_RCP + (size_t)2 * BATCH * 3 * D;
constexpr size_t O_FCP = O_RCS + (size_t)2 * DECB * 3 * D;
constexpr size_t O_FCS = O_FCP + (size_t)4 * BATCH * 2 * 6144;
constexpr size_t O_END = O_FCS + (size_t)4 * DECB * 2 * 6144;
static_assert(O_END == 78053376, "output size");

constexpr size_t MiB = 1u << 20;
constexpr size_t WS_CTL = 0, CTL_ZERO_BYTES = 1 * MiB;
constexpr size_t WS_W_NSA_IN = 2 * MiB;
constexpr size_t WS_W_NSA_OUT = WS_W_NSA_IN + 8 * MiB;
constexpr size_t WS_W_CMP1 = WS_W_NSA_OUT + 4 * MiB;
constexpr size_t WS_W_CMP2 = WS_W_CMP1 + 4 * MiB;
constexpr size_t WS_W_RG_IN = WS_W_CMP2 + 1 * MiB;
constexpr size_t WS_W_RG_G = WS_W_RG_IN + 8 * MiB;
constexpr size_t WS_W_RG_OUT = WS_W_RG_G + 2 * MiB;
constexpr size_t WS_W_UP = WS_W_RG_OUT + 4 * MiB;
constexpr size_t WS_W_DOWN = WS_W_UP + 48 * MiB;
constexpr size_t WS_W_PROJ = WS_W_DOWN + 24 * MiB;
constexpr size_t WS_W_GATE = WS_W_PROJ + 2 * MiB;
constexpr size_t WS_B1PART = WS_W_GATE + 8 * MiB;
constexpr size_t WS_X32 = WS_B1PART + 1 * MiB;
constexpr size_t WS_XB = WS_X32 + 66 * MiB;
constexpr size_t WS_PB = WS_XB + 33 * MiB;
constexpr size_t WS_PP = WS_PB + 33 * MiB;
constexpr size_t WS_CS = WS_PP + 132 * MiB;
constexpr size_t WS_HIDS = WS_CS + 257 * MiB;
constexpr size_t WS_KCS = WS_HIDS + 64 * MiB;
constexpr size_t WS_QB = WS_KCS + 16 * MiB;
constexpr size_t WS_KV6 = WS_QB + 33 * MiB;
constexpr size_t WS_KVS = WS_KV6 + 25 * MiB;
constexpr size_t WS_G32 = WS_KVS + 1 * MiB;
constexpr size_t WS_HIDP = WS_G32 + 4 * MiB;
constexpr size_t WS_KCP = WS_HIDP + 2 * MiB;
constexpr size_t WS_OB = WS_KCP + 1 * MiB;
constexpr size_t WS_PRE = WS_OB + 33 * MiB;
constexpr size_t WS_H32 = WS_PRE + 66 * MiB;
constexpr size_t WS_HB = WS_H32 + 66 * MiB;
constexpr size_t WS_U = WS_HB + 33 * MiB;
constexpr size_t WS_ACT = WS_U + 198 * MiB;
constexpr size_t WS_GG = WS_ACT + 99 * MiB;
constexpr size_t WS_RECB = WS_GG + 33 * MiB;
constexpr size_t WS_REC = WS_RECB + 33 * MiB;
constexpr size_t WS_AA = WS_REC + 33 * MiB;
constexpr size_t WS_UU = WS_AA + 66 * MiB;
constexpr size_t WS_CA = WS_UU + 66 * MiB;
constexpr size_t WS_CH = WS_CA + 1 * MiB;
constexpr size_t WS_HG = WS_CH + 1 * MiB;
constexpr size_t WS_SPT = WS_HG + 33 * MiB;
constexpr size_t WS_END = WS_SPT + 1 * MiB;

constexpr int CW_BAR = 4096;

constexpr int RING_BYTES = 131072;
constexpr int LDSCTL_OFF = RING_BYTES, MISC_OFF = LDSCTL_OFF + 320;
constexpr int LDS_B1P_OFF = RING_BYTES + 1024;
constexpr int LDS_BYTES = 147456;
constexpr int NWAVES = 8;

__device__ __forceinline__ unsigned f2bf(float f) { unsigned u = __builtin_bit_cast(unsigned, f); return (u + 0x7fffu + ((u >> 16) & 1u)) >> 16; }
__device__ __forceinline__ unsigned pk2(float lo, float hi) { return f2bf(lo) | (f2bf(hi) << 16); }
__device__ __forceinline__ float bf2f(unsigned short h) { return __builtin_bit_cast(float, (unsigned)h << 16); }
__device__ __forceinline__ float bflo(unsigned w) { return __builtin_bit_cast(float, w << 16); }
__device__ __forceinline__ float bfhi(unsigned w) { return __builtin_bit_cast(float, w & 0xffff0000u); }
__device__ __forceinline__ float sigm(float x) { return 1.f / (1.f + __expf(-x)); }
__device__ __forceinline__ float gelu_t(float x) { const float u = 0.7978845608028654f * (x + 0.044715f * x * x * x); return x / (1.f + __expf(-2.f * u)); }
__device__ __forceinline__ float ex2(float x) { return __builtin_amdgcn_exp2f(x); }
__device__ __forceinline__ void unpack8(const u32x4& w, float (&f)[8]) { f[0] = bflo(w.x); f[1] = bfhi(w.x); f[2] = bflo(w.y); f[3] = bfhi(w.y); f[4] = bflo(w.z); f[5] = bfhi(w.z); f[6] = bflo(w.w); f[7] = bfhi(w.w); }
__device__ __forceinline__ int make_tid(int wave) { unsigned ones = ~0u; asm volatile("" : "+s"(ones)); asm volatile("" : "+s"(wave)); return wave * 64 + (int)__builtin_amdgcn_mbcnt_hi(ones, __builtin_amdgcn_mbcnt_lo(ones, 0u)); }
#define LDS_WAIT() asm volatile("s_waitcnt lgkmcnt(0)" ::: "memory")
#define VM_WAIT() asm volatile("s_waitcnt vmcnt(0)" ::: "memory")

namespace pg8 {
constexpr int BM = 256, BK = 64, HALF = 128, HTB = HALF * BK * 2, STAGE_BYTES = 8 * HTB, NXCD = 8, WGM = 8;
__host__ __device__ __forceinline__ int lds_byte(int r, int c) { const int st = (r >> 4) * 2 + (c >> 5), rr = r & 15, cc = c & 31, ob = rr * 64 + cc * 2; return st * 1024 + (ob ^ (((ob >> 9) & 1) << 5)); }
__host__ __device__ __forceinline__ void stage_rc(int b, int& R, int& C) { const int st = b / 1024, sb = b % 1024, swz = sb ^ (((sb >> 9) & 1) << 5); R = (st >> 1) * 16 + swz / 64; C = (st & 1) * 32 + (swz % 64) / 2; }
__host__ __device__ __forceinline__ int perm32(int rho) { const int n = rho >> 4, i = rho & 15; return 8 * (i >> 2) + 4 * n + (i & 3); }

struct Unit { int pm, pn; long aoff, boff; };
struct Gemm { const bf16_t* A; const bf16_t* Bt; int lda, ldb, K; };

struct Sched {
    int nM, nN, nwg, G, c;
    long a_tile, b_tile;
    int a_pn_mul; long a_pn_bytes;
    int b_pm_mul; long b_pm_bytes;
    __device__ void init(int nM_, int nN_, int G_, int c_, int lda, int ldb) {
        nM = nM_; nN = nN_; nwg = nM * nN; G = G_; c = c_; a_tile = (long)BM * lda * 2; b_tile = (long)BM * ldb * 2;
        a_pn_mul = 0; a_pn_bytes = 0; b_pm_mul = 0; b_pm_bytes = 0; }
    __device__ static constexpr int rmul(int div) { return (65536 + div - 1) / div; }
    __device__ bool next(int i, Unit& u) const {
        const long L = (long)i * G + c; if (L >= nwg) return false;
        int wgid = (int)L; { const int q = nwg / NXCD, r = nwg % NXCD, xcd = wgid % NXCD, off = wgid / NXCD; wgid = (xcd < r ? xcd * (q + 1) : r * (q + 1) + (xcd - r) * q) + off; }
        const int nig = WGM * nN, gid = wgid / nig, fm = gid * WGM, gsz = (nM - fm) < WGM ? (nM - fm) : WGM;
        u.pm = fm + ((wgid % nig) % gsz); u.pn = (wgid % nig) / gsz;
        u.aoff = (long)u.pm * a_tile + (long)((u.pn * a_pn_mul) >> 16) * a_pn_bytes; u.boff = (long)u.pn * b_tile + (long)((u.pm * b_pm_mul) >> 16) * b_pm_bytes;
        return true; }
};

template <class Epi>
__device__ __forceinline__ void gemm_phase(LAS unsigned char* lds, const Gemm g, const Sched& S, const Epi& E, int tid_in) {
    const int tid = tid_in, wid = __builtin_amdgcn_readfirstlane(tid >> 6), lane = tid & 63, wr = wid >> 2, wc = wid & 3, fr = lane & 15, fq = lane >> 4;
    int K_ = g.K; asm volatile("" : "+s"(K_));
    const int K = K_, nt = K / BK;
    unsigned voffA, voffB;
    { int R, C; stage_rc(tid * 16, R, C); const int Rb = (R & ~31) + perm32(R & 31); voffA = (unsigned)(R * g.lda + C) * 2u; voffB = (unsigned)(Rb * g.ldb + C) * 2u; }
    const size_t piecevoffA = (size_t)64 * g.lda * 2, piecevoffB = (size_t)64 * g.ldb * 2;
    const size_t kstep = (size_t)(BK * 2);
    const size_t hstepA = (size_t)HALF * g.lda * 2, hstepB = (size_t)HALF * g.ldb * 2;
    const unsigned ldsw = (unsigned)wid * 1024u;
    const int aoff = lds_byte(wr * 64 + fr, fq * 8), boff = lds_byte(wc * 32 + fr, fq * 8);
#define PG8_SA(b, h) (((b) * 2 + (h)) * HTB)
#define PG8_SB(b, h) ((4 + (b) * 2 + (h)) * HTB)
#define PG8_STAGE_(bufoff, gbase, voff, piece) do { \
        __builtin_amdgcn_global_load_lds((const unsigned*)((const char*)(gbase) + (voff)), (LAS unsigned*)(lds + (bufoff) + ldsw), 16, 0, 0); \
        __builtin_amdgcn_global_load_lds((const unsigned*)((const char*)(gbase) + (piece) + (voff)), (LAS unsigned*)(lds + (bufoff) + ldsw + 8192), 16, 0, 0); } while (0)
#define PG8_STAGE(bufoff, gbase, voff) PG8_STAGE_(bufoff, gbase, voff, piece##voff)
#define PG8_LDA(dst, b, h) do { _Pragma("unroll") for (int m = 0; m < 4; ++m) _Pragma("unroll") for (int k = 0; k < 2; ++k) dst[m][k] = *(const LAS bf16x8*)(lds + PG8_SA(b, h) + aoff + m * 2048 + k * 1024); } while (0)
#define PG8_LDB(dst, b, h) do { _Pragma("unroll") for (int n = 0; n < 2; ++n) _Pragma("unroll") for (int k = 0; k < 2; ++k) dst[n][k] = *(const LAS bf16x8*)(lds + PG8_SB(b, h) + boff + n * 2048 + k * 1024); } while (0)
#define PG8_MMA(ai, bj, At, Bt) do { __builtin_amdgcn_s_setprio(1); _Pragma("unroll") for (int m = 0; m < 4; ++m) _Pragma("unroll") for (int n = 0; n < 2; ++n) _Pragma("unroll") for (int k = 0; k < 2; ++k) \
        acc[ai][bj][m][n] = __builtin_amdgcn_mfma_f32_16x16x32_bf16(Bt[n][k], At[m][k], acc[ai][bj][m][n], 0, 0, 0); __builtin_amdgcn_s_setprio(0); } while (0)
#define PG8_WAIT_V(n) asm volatile("s_waitcnt vmcnt(" #n ")" ::: "memory")
#define PG8_WAIT_L(n) asm volatile("s_waitcnt lgkmcnt(" #n ")" ::: "memory")
#define PG8_BAR __builtin_amdgcn_s_barrier()
#define PG8_SCHED __builtin_amdgcn_sched_barrier(0)
    Unit cur, nxt; int ui = 0;
    if (!S.next(0, cur)) return;
    f32x4 acc[2][2][4][2];
#pragma unroll
    for (int a = 0; a < 2; ++a)
#pragma unroll
        for (int b = 0; b < 2; ++b)
#pragma unroll
            for (int m = 0; m < 4; ++m)
#pragma unroll
                for (int n = 0; n < 2; ++n) acc[a][b][m][n] = (f32x4){0.f, 0.f, 0.f, 0.f};
    bf16x8 At[4][2], B0[2][2], B1[2][2];
    const char* cA = (const char*)g.A + cur.aoff; const char* cB = (const char*)g.Bt + cur.boff;
    PG8_STAGE(PG8_SB(0, 0), cB, voffB); PG8_STAGE(PG8_SB(0, 1), cB + hstepB, voffB); PG8_STAGE(PG8_SA(0, 0), cA, voffA); PG8_STAGE(PG8_SA(0, 1), cA + hstepA, voffA);
    if (wr == 1) PG8_BAR;
    PG8_WAIT_V(2); PG8_BAR;
    PG8_STAGE(PG8_SB(1, 0), cB + kstep, voffB); PG8_STAGE(PG8_SA(1, 0), cA + kstep, voffA); PG8_STAGE(PG8_SB(1, 1), cB + hstepB + kstep, voffB);
    PG8_WAIT_V(6); PG8_BAR;
    for (;;) {
        const bool has_next = S.next(ui + 1, nxt);
        const char* nA = has_next ? (const char*)g.A + nxt.aoff : cA; const char* nB = has_next ? (const char*)g.Bt + nxt.boff : cB;
        for (int t = 0; t < nt; t += 2) {
            const bool last = (t == nt - 2);
            const char* a1 = cA + (size_t)(t + 1) * kstep;
            const char* a2 = last ? nA : cA + (size_t)(t + 2) * kstep; const char* b2 = last ? nB : cB + (size_t)(t + 2) * kstep;
            const char* a3 = a2 + kstep; const char* b3 = b2 + kstep;
            PG8_LDB(B0, 0, 0); PG8_LDB(B1, 0, 1); PG8_SCHED; PG8_LDA(At, 0, 0); PG8_STAGE(PG8_SA(1, 1), a1 + hstepA, voffA);
            PG8_WAIT_V(8); PG8_WAIT_L(0); PG8_BAR; PG8_MMA(0, 0, At, B0); PG8_MMA(0, 1, At, B1); PG8_BAR; PG8_SCHED;
            PG8_LDA(At, 0, 1); PG8_STAGE(PG8_SB(0, 0), b2, voffB); PG8_STAGE(PG8_SB(0, 1), b2 + hstepB, voffB); PG8_STAGE(PG8_SA(0, 0), a2, voffA);
            PG8_WAIT_V(8); PG8_WAIT_L(0); PG8_BAR; PG8_MMA(1, 0, At, B0); PG8_MMA(1, 1, At, B1); PG8_BAR; PG8_SCHED;
            PG8_LDB(B0, 1, 0); PG8_LDB(B1, 1, 1); PG8_SCHED; PG8_LDA(At, 1, 0); PG8_STAGE(PG8_SA(0, 1), a2 + hstepA, voffA);
            PG8_WAIT_V(8); PG8_WAIT_L(0); PG8_BAR; PG8_MMA(0, 0, At, B0); PG8_MMA(0, 1, At, B1); PG8_BAR; PG8_SCHED;
            PG8_LDA(At, 1, 1); PG8_STAGE(PG8_SB(1, 0), b3, voffB); PG8_STAGE(PG8_SB(1, 1), b3 + hstepB, voffB); PG8_STAGE(PG8_SA(1, 0), a3, voffA);
            PG8_WAIT_V(8); PG8_WAIT_L(0); PG8_BAR; PG8_MMA(1, 0, At, B0); PG8_MMA(1, 1, At, B1); PG8_BAR; PG8_SCHED;
        }
        if (wr == 0) PG8_BAR;
        E(acc, cur, wr, wc, fr, fq);
        if (!has_next) break;
#pragma unroll
        for (int a = 0; a < 2; ++a)
#pragma unroll
            for (int b = 0; b < 2; ++b)
#pragma unroll
                for (int m = 0; m < 4; ++m)
#pragma unroll
                    for (int n = 0; n < 2; ++n) acc[a][b][m][n] = (f32x4){0.f, 0.f, 0.f, 0.f};
        cur = nxt; cA = nA; cB = nB; ++ui;
        if (wr == 1) PG8_BAR;
    }
    PG8_WAIT_V(0);
    PG8_BAR;
#undef PG8_SA
#undef PG8_SB
#undef PG8_STAGE
#undef PG8_STAGE_
#undef PG8_LDA
#undef PG8_LDB
#undef PG8_MMA
#undef PG8_WAIT_V
#undef PG8_WAIT_L
#undef PG8_BAR
#undef PG8_SCHED
}

__device__ __forceinline__ u32x4 pack8(const f32x4& v0, const f32x4& v1) { u32x4 w; w.x = pk2(v0[0], v0[1]); w.y = pk2(v0[2], v0[3]); w.z = pk2(v1[0], v1[1]); w.w = pk2(v1[2], v1[3]); return w; }
#define EPI_PIECES(...) \
    _Pragma("unroll") for (int ai = 0; ai < 2; ++ai) _Pragma("unroll") for (int m = 0; m < 4; ++m) { const int rowU = u.pm * BM + ai * HALF + m * 16; (void)rowU; \
        _Pragma("unroll") for (int bj = 0; bj < 2; ++bj) { const f32x4 v0 = acc[ai][bj][m][0], v1 = acc[ai][bj][m][1]; (void)v0; (void)v1; __VA_ARGS__ } \
        asm volatile("" ::: "memory"); }
#define ST_F32X8(ptr, a, b) do { *(f32x4*)(ptr) = (a); *(f32x4*)((ptr) + 16) = (b); } while (0)

template <bool BA> struct EpiBf16G {
    bf16_t* O; int ldc; const LAS float* bias; int bias_pm_shift;
    __device__ __forceinline__ void operator()(const f32x4 (&acc)[2][2][4][2], const Unit& u, int wr, int wc, int fr, int fq) const {
        const LAS float* bp0 = BA ? bias + (u.pm >> bias_pm_shift) * 256 + wc * 32 + 8 * fq : nullptr;
        const unsigned lo = (unsigned)(((wr * 64 + fr) * ldc + wc * 32 + 8 * fq) * 2);
        EPI_PIECES(
            char* op = (char*)O + ((size_t)rowU * ldc + u.pn * BM + bj * HALF) * 2;
            f32x4 a = v0; f32x4 b = v1;
            if (BA) { const LAS float* bp = bp0 + bj * HALF;
                _Pragma("unroll") for (int e = 0; e < 4; ++e) { a[e] = gelu_t(a[e] + bp[e]); b[e] = gelu_t(b[e] + bp[4 + e]); } }
            *(u32x4*)(op + lo) = pack8(a, b); )
    }
};

struct EpiNsaIn {
    bf16_t* QB; bf16_t* KV6; bf16_t* KVS; float* G32; float* out; int j;
    __device__ __forceinline__ void operator()(const f32x4 (&acc)[2][2][4][2], const Unit& u, int wr, int wc, int fr, int fq) const {
        const bool samp = u.pm >= MP / BM; const int rowL = wr * 64 + fr, colL = wc * 32 + 8 * fq;
        if (u.pn < 4) {
            const unsigned lo = (unsigned)((rowL * 1024 + colL) * 2);
            EPI_PIECES( char* op = (char*)QB + ((size_t)rowU * 1024 + u.pn * BM + bj * HALF) * 2; *(u32x4*)(op + lo) = pack8(v0 * QSCALE, v1 * QSCALE); )
        } else if (u.pn < 7) {
            const int gg = wc >> 1, d = (wc & 1) * 32 + 8 * fq;
            if (!samp) {
                const int b = u.pm >> 3; const bool wintail = (u.pm & 7) >= 6;
                const unsigned lo_kv = (unsigned)(((gg * 2048 + rowL) * 64 + d) * 2), lo_o = (unsigned)((rowL * 512 + colL) * 4), lo_w = (unsigned)((rowL * 256 + colL) * 4);
                EPI_PIECES(
                    const int kc0 = u.pn * BM + bj * HALF - 1024, comp = kc0 >> 7, tU = rowU & 2047;
                    char* kp = (char*)KV6 + ((size_t)((comp * 8 + b) * 2 * 2048 + tU) * 64) * 2; *(u32x4*)(kp + lo_kv) = pack8(v0, v1);
                    if (comp < 4) { char* op = (char*)(out + O_KVP) + ((size_t)((j * BATCH + b) * SEQ + tU) * 512 + kc0) * 4; ST_F32X8(op + lo_o, v0, v1); }
                    else if (wintail) { char* op = (char*)(out + O_WINP) + ((size_t)((j * BATCH + b) * 512 + (tU - (SEQ - 512))) * 256 + (kc0 - 512)) * 4; ST_F32X8(op + lo_w, v0, v1); } )
            } else {
                const unsigned lo_s = (unsigned)((rowL * 768 + colL) * 2), lo_o = (unsigned)((rowL * 512 + colL) * 4), lo_w = (unsigned)((((rowL >> 2) * 512 + (rowL & 3)) * 256 + colL) * 4);
                EPI_PIECES(
                    const int kc0 = u.pn * BM + bj * HALF - 1024, comp = kc0 >> 7, srU = rowU - MP;
                    char* sp = (char*)KVS + ((size_t)srU * 768 + kc0) * 2; *(u32x4*)(sp + lo_s) = pack8(v0, v1);
                    if (comp < 4) { char* op = (char*)(out + O_KVS) + ((size_t)(j * MS + srU) * 512 + kc0) * 4; ST_F32X8(op + lo_o, v0, v1); }
                    else { char* op = (char*)(out + O_WINS) + ((size_t)((j * DECB + (srU >> 2)) * 512 + 508) * 256 + (kc0 - 512)) * 4; ST_F32X8(op + lo_w, v0, v1); } )
            }
        } else {
            const unsigned lo = (unsigned)((rowL * 48 + colL) * 4);
            if (colL < 48) {
#pragma unroll
                for (int ai = 0; ai < 2; ++ai)
#pragma unroll
                    for (int m = 0; m < 4; ++m) { const int rowU = u.pm * BM + ai * HALF + m * 16; char* op = (char*)G32 + (size_t)rowU * 48 * 4;
                        f32x4 a = acc[ai][0][m][0], b = acc[ai][0][m][1];
#pragma unroll
                        for (int e = 0; e < 4; ++e) { a[e] = sigm(a[e]); b[e] = sigm(b[e]); }
                        ST_F32X8(op + lo, a, b); }
            }
        }
    }
};

struct EpiResid {
    const float* base; float* pre;
    __device__ __forceinline__ void operator()(const f32x4 (&acc)[2][2][4][2], const Unit& u, int wr, int wc, int fr, int fq) const {
        const unsigned lo = (unsigned)(((wr * 64 + fr) * D + wc * 32 + 8 * fq) * 4);
        EPI_PIECES(
            const size_t uo = ((size_t)rowU * D + u.pn * BM + bj * HALF) * 4; const char* bp = (const char*)base + uo; char* op = (char*)pre + uo;
            const f32x4 b0 = *(const f32x4*)(bp + lo), b1 = *(const f32x4*)(bp + lo + 16);
            ST_F32X8(op + lo, b0 * ALPHA + v0, b1 * ALPHA + v1); )
    }
};

struct EpiUp {
    bf16_t* U; float* out; int layer;
    __device__ __forceinline__ void operator()(const f32x4 (&acc)[2][2][4][2], const Unit& u, int wr, int wc, int fr, int fq) const {
        const bool samp = u.pm >= MP / BM; const int rowL = wr * 64 + fr, colL = wc * 32 + 8 * fq;
        const unsigned lo = (unsigned)((rowL * 6144 + colL) * 2);
        EPI_PIECES(
            const int ncU = bj * DFF + u.pn * 128;
            char* op = (char*)U + ((size_t)rowU * 6144 + ncU) * 2; *(u32x4*)(op + lo) = pack8(v0, v1);
            if (!samp) { if ((u.pm & 7) == 7 && ai == 1 && m == 3 && rowL >= 64 + 14) { const int b = u.pm >> 3, tt = rowL - (64 + 14);
                    float* o = out + O_FCP + ((size_t)(layer * BATCH + b) * 2 + tt) * 6144 + ncU + colL; ST_F32X8((char*)o, v0, v1); } }
            else { const int sr = rowU - MP + rowL, b = sr >> 2, s = sr & 3;
                if (s >= 2) { float* o = out + O_FCS + ((size_t)(layer * DECB + b) * 2 + (s - 2)) * 6144 + ncU + colL; ST_F32X8((char*)o, v0, v1); } } )
    }
};

struct EpiPle {
    const float* h2; const bf16_t* pp; float* x32; bf16_t* xb; float* out; int last;
    __device__ __forceinline__ void operator()(const f32x4 (&acc)[2][2][4][2], const Unit& u, int wr, int wc, int fr, int fq) const {
        const unsigned le = (unsigned)((wr * 64 + fr) * D + wc * 32 + 8 * fq);
        EPI_PIECES(
            const size_t ue = (size_t)rowU * D + u.pn * BM + bj * HALF;
            const char* hp = (const char*)h2 + ue * 4; const char* ppp = (const char*)pp + ue * 2;
            const f32x4 h0 = *(const f32x4*)(hp + le * 4), h1 = *(const f32x4*)(hp + le * 4 + 16); const u32x4 pw = *(const u32x4*)(ppp + le * 2);
            f32x4 r0; f32x4 r1;
            r0[0] = h0[0] + sigm(v0[0]) * bflo(pw.x); r0[1] = h0[1] + sigm(v0[1]) * bfhi(pw.x); r0[2] = h0[2] + sigm(v0[2]) * bflo(pw.y); r0[3] = h0[3] + sigm(v0[3]) * bfhi(pw.y);
            r1[0] = h1[0] + sigm(v1[0]) * bflo(pw.z); r1[1] = h1[1] + sigm(v1[1]) * bfhi(pw.z); r1[2] = h1[2] + sigm(v1[2]) * bflo(pw.w); r1[3] = h1[3] + sigm(v1[3]) * bfhi(pw.w);
            if (last) { char* op = (char*)(out + O_YP) + ue * 4; ST_F32X8(op + le * 4, r0, r1); }
            else { char* xp = (char*)x32 + ue * 4; ST_F32X8(xp + le * 4, r0, r1); char* bp = (char*)xb + ue * 2; *(u32x4*)(bp + le * 2) = pack8(r0, r1); } )
    }
};

struct EpiRgIn {
    bf16_t* GG; bf16_t* RECB; float* out; int j;
    __device__ __forceinline__ void operator()(const f32x4 (&acc)[2][2][4][2], const Unit& u, int wr, int wc, int fr, int fq) const {
        const bool samp = u.pm >= MP / BM; const int rowL = wr * 64 + fr, colL = wc * 32 + 8 * fq;
        const unsigned lo = (unsigned)((rowL * D + colL) * 2);
        if (u.pn < 4) {
            EPI_PIECES( char* op = (char*)GG + ((size_t)rowU * D + u.pn * BM + bj * HALF) * 2; f32x4 a = v0; f32x4 b = v1;
                _Pragma("unroll") for (int e = 0; e < 4; ++e) { a[e] = gelu_t(a[e]); b[e] = gelu_t(b[e]); }
                *(u32x4*)(op + lo) = pack8(a, b); )
        } else {
            EPI_PIECES(
                const int cU = (u.pn - 4) * BM + bj * HALF;
                char* op = (char*)RECB + ((size_t)rowU * D + cU) * 2; *(u32x4*)(op + lo) = pack8(v0, v1);
                if (!samp) { if ((u.pm & 7) == 7 && ai == 1 && m == 3 && rowL >= 64 + 13) { const int b = u.pm >> 3, tt = rowL - (64 + 13);
                        float* o = out + O_RCP + ((size_t)(j * BATCH + b) * 3 + tt) * D + cU + colL; ST_F32X8((char*)o, v0, v1); } }
                else { const int sr = rowU - MP + rowL, b = sr >> 2, s = sr & 3;
                    if (s >= 1) { float* o = out + O_RCS + ((size_t)(j * DECB + b) * 3 + (s - 1)) * D + cU + colL; ST_F32X8((char*)o, v0, v1); } } )
        }
    }
};

struct EpiRgGate {
    const bf16_t* REC; const float* ga_b; const float* gx_b; const float* spt; float* AA; float* UU;
    __device__ __forceinline__ void operator()(const f32x4 (&acc)[2][2][4][2], const Unit& u, int wr, int wc, int fr, int fq) const {
        const int cU = (u.pn >> 1) * 256 + (u.pn & 1) * 128, cL = wc * 32 + 8 * fq;
        const unsigned lo4 = (unsigned)(((wr * 64 + fr) * D + cL) * 4), lo2 = lo4 >> 1;
        float gab[8], gxb[8], sp[8];
#pragma unroll
        for (int e = 0; e < 8; ++e) { gab[e] = ga_b[cU + cL + e]; gxb[e] = gx_b[cU + cL + e]; sp[e] = spt[cU + cL + e]; }
        constexpr float L2E = 1.4426950408889634f;
#pragma unroll
        for (int ai = 0; ai < 2; ++ai)
#pragma unroll
            for (int m = 0; m < 4; ++m) { const size_t ue = (size_t)(u.pm * BM + ai * HALF + m * 16) * D + cU;
                float rec[8]; unpack8(*(const u32x4*)((const char*)REC + ue * 2 + lo2), rec);
                f32x4 av[2], uv[2];
#pragma unroll
                for (int e = 0; e < 8; ++e) { const float pa = acc[ai][0][m][e >> 2][e & 3] + gab[e], px = acc[ai][1][m][e >> 2][e & 3] + gxb[e];
                    const float r = __builtin_amdgcn_rcpf(1.f + ex2(-L2E * pa)), ig = __builtin_amdgcn_rcpf(1.f + ex2(-L2E * px));
                    const float t = sp[e] * r, a = ex2(t), a2 = ex2(2.f * t);
                    av[e >> 2][e & 3] = a; uv[e >> 2][e & 3] = __builtin_amdgcn_sqrtf(fmaxf(1.f - a2, 0.f)) * ig * rec[e]; }
                char* ap = (char*)AA + ue * 4; char* up = (char*)UU + ue * 4;
                ST_F32X8(ap + lo4, av[0], av[1]); ST_F32X8(up + lo4, uv[0], uv[1]);
                asm volatile("" ::: "memory"); }
    }
};
}

#define XB_TMO      128
#define XB_XCNT(j)  (256  + 64 * (j))
#define XB_XSUB(j)  (1280 + 64 * (j))
#define XB_XGEN(j)  (2304 + 64 * (j))
#define XB_TOP      3328
#define XB_TOPGEN   3392
#define XCD_BAR_WORDS 3456
#define XB_SPIN_CAP (1u << 18)
__device__ __forceinline__ unsigned xb_ld(unsigned* p)              { return __hip_atomic_load(p, __ATOMIC_RELAXED, __HIP_MEMORY_SCOPE_AGENT); }
__device__ __forceinline__ unsigned xb_add(unsigned* p, unsigned v) { return __hip_atomic_fetch_add(p, v, __ATOMIC_RELAXED, __HIP_MEMORY_SCOPE_AGENT); }
__device__ __forceinline__ unsigned xb_xcc_id() { return (unsigned)__builtin_amdgcn_s_getreg((3 << 11) | 20) & 0xFu; }
#define XB_SPIN(cond, bar) do { unsigned _sp = 0; while (cond) { __builtin_amdgcn_s_sleep(1); \
    if ((++_sp & 255u) == 0u) { if (xb_ld(&(bar)[XB_TMO])) break; if (_sp > XB_SPIN_CAP) { atomicAdd(&(bar)[XB_TMO], 1u); break; } } } } while (0)
struct XcdBarrier { unsigned* bar; unsigned x; volatile LAS unsigned* st; };
__device__ __forceinline__ XcdBarrier xcd_barrier_post(unsigned* bar, volatile LAS unsigned* st, int tid) {
    XcdBarrier b; b.bar = bar; b.x = xb_xcc_id(); b.st = st;
    if (tid == 0) (void)xb_add(&bar[XB_XCNT(b.x)], 1u);
    return b;
}
__device__ __forceinline__ void xcd_barrier_complete(unsigned* bar, unsigned x, unsigned& nloc, unsigned& nx) {
    const unsigned G = gridDim.x * gridDim.y * gridDim.z;
    unsigned sum, cnt, mine, sp = 0u;
    for (;;) {
        sum = 0u; cnt = 0u; mine = 0u;
#pragma unroll
        for (unsigned j = 0; j < 16; ++j) { const unsigned c = xb_ld(&bar[XB_XCNT(j)]); sum += c; cnt += (c > 0u) ? 1u : 0u; mine = (j == x) ? c : mine; }
        if (sum == G) break;
        __builtin_amdgcn_s_sleep(1);
        if ((++sp & 255u) == 0u) { if (xb_ld(&bar[XB_TMO])) break; if (sp > XB_SPIN_CAP) { atomicAdd(&bar[XB_TMO], 1u); break; } }
    }
    nloc = mine > 0u ? mine : 1u; nx = cnt > 0u ? cnt : 1u;
}
__device__ __forceinline__ void xcd_barrier(const XcdBarrier& b, int tid) {
    asm volatile("s_waitcnt vmcnt(0)" ::: "memory");
    __syncthreads();
    if (tid == 0) {
        unsigned* bar = b.bar;
        __builtin_amdgcn_s_waitcnt(0);
        unsigned nloc = b.st[0], nx = b.st[1];
        if (nloc == 0u) { xcd_barrier_complete(bar, b.x, nloc, nx); b.st[0] = nloc; b.st[1] = nx; }
        const unsigned old = xb_add(&bar[XB_XSUB(b.x)], 1u);
        const unsigned gen = old / nloc;
        if (old + 1u == (gen + 1u) * nloc) {
            __builtin_amdgcn_fence(__ATOMIC_RELEASE, "agent");
            asm volatile("s_waitcnt vmcnt(0)" ::: "memory");
            const unsigned og = xb_add(&bar[XB_TOP], 1u);
            const unsigned tg = og / nx;
            if (og + 1u == (tg + 1u) * nx) xb_add(&bar[XB_TOPGEN], 1u);
            else XB_SPIN(xb_ld(&bar[XB_TOPGEN]) == tg, bar);
            __builtin_amdgcn_fence(__ATOMIC_ACQUIRE, "agent");
            xb_add(&bar[XB_XGEN(b.x)], 1u);
            asm volatile("s_waitcnt vmcnt(0)" ::: "memory");
        } else {
            XB_SPIN(xb_ld(&bar[XB_XGEN(b.x)]) == gen, bar);
            __builtin_amdgcn_fence(__ATOMIC_ACQUIRE, "agent");
            asm volatile("s_waitcnt vmcnt(0)" ::: "memory");
        }
    }
    __syncthreads();
}

struct Args { const void* in[35]; float* out; unsigned char* ws; int ph_lo, ph_hi; };
struct Frame {
    LAS unsigned char* lds; int tid, lane, wave, vcu, G;
    unsigned char* ws; float* out;
};
__device__ __forceinline__ float wave_sum(float v) {
#pragma unroll
    for (int o = 1; o < 64; o <<= 1) v += __shfl_xor(v, o);
    return v;
}

__device__ __forceinline__ const void* in_ptr(int k) {
    const void* const __attribute__((address_space(4)))* p = (const void* const __attribute__((address_space(4)))*)__builtin_amdgcn_kernarg_segment_ptr();
    asm volatile("" : "+s"(k));
    return p[k];
}
__device__ __forceinline__ void tr_item(const float* W, int ldw, int k0, int n_src0, int n_valid, bf16_t* WT, int ldt, int dst_row0, LAS float* scr, int lane) {
#pragma unroll 8
    for (int i = 0; i < 32; ++i) { const int kk = 2 * i + (lane >> 5), nn = lane & 31; scr[kk * 33 + nn] = (nn < n_valid) ? W[(size_t)(k0 + kk) * ldw + n_src0 + nn] : 0.f; }
    LDS_WAIT(); asm volatile("" ::: "memory");
    const int c = lane & 7;
#pragma unroll
    for (int jj = 0; jj < 4; ++jj) { const int n = (lane >> 3) + 8 * jj; const LAS float* s = scr + (8 * c) * 33 + n;
        u32x4 o; o.x = pk2(s[0 * 33], s[1 * 33]); o.y = pk2(s[2 * 33], s[3 * 33]); o.z = pk2(s[4 * 33], s[5 * 33]); o.w = pk2(s[6 * 33], s[7 * 33]);
        *(u32x4*)(WT + (size_t)(dst_row0 + n) * ldt + k0 + 8 * c) = o; }
    LDS_WAIT(); asm volatile("" ::: "memory");
}

__device__ __forceinline__ void p0_prologue(Frame& F) {
    unsigned char* ws = F.ws;
    LAS float* scr = (LAS float*)(F.lds + F.wave * 16384);
    const int gw = F.vcu * NWAVES + F.wave, NGW = F.G * NWAVES, lane = F.lane;
    constexpr int I_NSA_IN = 16 * 64, I_SQ = 16 * 32, I_CMP1 = 32 * 8, I_CMP2 = 4 * 2, I_RG_IN = 16 * 64, I_RG_G = 4 * 8, I_UP = 16 * 192, I_DOWN = 48 * 32, I_PROJ = 4 * 32;
    constexpr int NITEMS = 2 * I_NSA_IN + 2 * I_SQ + 4 * I_CMP1 + 4 * I_CMP2 + 2 * I_RG_IN + 16 * I_RG_G + 2 * I_SQ + 4 * I_UP + 4 * I_DOWN + 4 * I_PROJ + 4 * I_SQ;
    for (int it = gw; it < NITEMS; it += NGW) {
        int r = it;
        if (r < 2 * I_NSA_IN) { const int j = r / I_NSA_IN, q = r % I_NSA_IN, kb = q / 64, nb = q % 64; const int nv = NSA_N - 32 * nb;
            tr_item((const float*)in_ptr(10) + (size_t)j * 1024 * NSA_N, NSA_N, 64 * kb, 32 * nb, nv < 0 ? 0 : (nv > 32 ? 32 : nv), (bf16_t*)(ws + WS_W_NSA_IN) + (size_t)j * NSA_NP * 1024, 1024, 32 * nb, scr, lane); continue; } r -= 2 * I_NSA_IN;
        if (r < 2 * I_SQ) { const int j = r / I_SQ, q = r % I_SQ, kb = q / 32, nb = q % 32;
            tr_item((const float*)in_ptr(11) + (size_t)j * 1024 * 1024, 1024, 64 * kb, 32 * nb, 32, (bf16_t*)(ws + WS_W_NSA_OUT) + (size_t)j * 1024 * 1024, 1024, 32 * nb, scr, lane); continue; } r -= 2 * I_SQ;
        if (r < 4 * I_CMP1) { const int mt = r / I_CMP1, q = r % I_CMP1, kb = q / 8, nb = q % 8;
            tr_item((const float*)in_ptr(13) + (size_t)mt * 2048 * 256, 256, 64 * kb, 32 * nb, 32, (bf16_t*)(ws + WS_W_CMP1) + (size_t)mt * 256 * 2048, 2048, 32 * nb, scr, lane); continue; } r -= 4 * I_CMP1;
        if (r < 4 * I_CMP2) { const int mt = r / I_CMP2, q = r % I_CMP2, kb = q / 2, nb = q % 2;
            tr_item((const float*)in_ptr(15) + (size_t)mt * 256 * 64, 64, 64 * kb, 32 * nb, 32, (bf16_t*)(ws + WS_W_CMP2) + (size_t)mt * 64 * 256, 256, 32 * nb, scr, lane); continue; } r -= 4 * I_CMP2;
        if (r < 2 * I_RG_IN) { const int j = r / I_RG_IN, q = r % I_RG_IN, kb = q / 64, nb = q % 64;
            tr_item((const float*)in_ptr(16) + (size_t)j * 1024 * 2048, 2048, 64 * kb, 32 * nb, 32, (bf16_t*)(ws + WS_W_RG_IN) + (size_t)j * 2048 * 1024, 1024, 32 * nb, scr, lane); continue; } r -= 2 * I_RG_IN;
        if (r < 16 * I_RG_G) { const int mt = r / I_RG_G, q = r % I_RG_G, kb = q / 8, nt = q % 8; const int j = mt >> 3, src = (mt >> 2) & 1, nb = mt & 3;
            const float* W = (const float*)in_ptr(src ? 21 : 19) + (size_t)(j * 4 + nb) * 256 * 256;
            tr_item(W, 256, 64 * kb, 32 * nt, 32, (bf16_t*)(ws + WS_W_RG_G) + (size_t)j * 8 * 256 * 256, 256, (nb * 2 + nt / 4) * 256 + src * 128 + (nt % 4) * 32, scr, lane); continue; } r -= 16 * I_RG_G;
        if (r < 2 * I_SQ) { const int j = r / I_SQ, q = r % I_SQ, kb = q / 32, nb = q % 32;
            tr_item((const float*)in_ptr(24) + (size_t)j * 1024 * 1024, 1024, 64 * kb, 32 * nb, 32, (bf16_t*)(ws + WS_W_RG_OUT) + (size_t)j * 1024 * 1024, 1024, 32 * nb, scr, lane); continue; } r -= 2 * I_SQ;
        if (r < 4 * I_UP) { const int i = r / I_UP, q = r % I_UP, kb = q / 192, nt = q % 192; const int n0 = 32 * nt, half = n0 / DFF, within = n0 % DFF;
            tr_item((const float*)in_ptr(25) + (size_t)i * 1024 * 6144, 6144, 64 * kb, n0, 32, (bf16_t*)(ws + WS_W_UP) + (size_t)i * 6144 * 1024, 1024, (within / 128) * 256 + half * 128 + (within % 128), scr, lane); continue; } r -= 4 * I_UP;
        if (r < 4 * I_DOWN) { const int i = r / I_DOWN, q = r % I_DOWN, kb = q / 32, nb = q % 32;
            tr_item((const float*)in_ptr(28) + (size_t)i * 3072 * 1024, 1024, 64 * kb, 32 * nb, 32, (bf16_t*)(ws + WS_W_DOWN) + (size_t)i * 1024 * 3072, 3072, 32 * nb, scr, lane); continue; } r -= 4 * I_DOWN;
        if (r < 4 * I_PROJ) { const int i = r / I_PROJ, q = r % I_PROJ, kb = q / 32, nb = q % 32;
            tr_item((const float*)in_ptr(33) + (size_t)i * 256 * 1024, 1024, 64 * kb, 32 * nb, 32, (bf16_t*)(ws + WS_W_PROJ) + (size_t)i * 1024 * 256, 256, 32 * nb, scr, lane); continue; } r -= 4 * I_PROJ;
        { const int i = r / I_SQ, q = r % I_SQ, kb = q / 32, nb = q % 32;
            tr_item((const float*)in_ptr(34) + (size_t)i * 1024 * 1024, 1024, 64 * kb, 32 * nb, 32, (bf16_t*)(ws + WS_W_GATE) + (size_t)i * 1024 * 1024, 1024, 32 * nb, scr, lane); }
    }
    for (int m0 = 2 * gw; m0 < MT; m0 += 2 * NGW) {
        f32x4 v[2][4];
#pragma unroll
        for (int r = 0; r < 2; ++r) { const int m = m0 + r; const float* src = (m < MP) ? (const float*)in_ptr(0) + (size_t)m * D : (const float*)in_ptr(1) + (size_t)(m - MP) * D;
#pragma unroll
            for (int jj = 0; jj < 4; ++jj) v[r][jj] = *((const f32x4*)src + lane + 64 * jj); }
#pragma unroll
        for (int r = 0; r < 2; ++r) { const int m = m0 + r; float* x32 = (float*)(ws + WS_X32) + (size_t)m * D; bf16_t* xb = (bf16_t*)(ws + WS_XB) + (size_t)m * D;
#pragma unroll
            for (int jj = 0; jj < 4; ++jj) { *((f32x4*)x32 + lane + 64 * jj) = v[r][jj]; u32x2 w; w.x = pk2(v[r][jj][0], v[r][jj][1]); w.y = pk2(v[r][jj][2], v[r][jj][3]); *((u32x2*)xb + lane + 64 * jj) = w; } }
    }
    for (int r0 = 8 * gw; r0 < 4 * MT; r0 += 8 * NGW) {
        f32x4 v[8];
#pragma unroll
        for (int r = 0; r < 8; ++r) { const int rr = r0 + r, i = rr / MT, m = rr % MT;
            const float* src = (m < MP) ? (const float*)in_ptr(8) + ((size_t)i * MP + m) * DPLE : (const float*)in_ptr(9) + ((size_t)i * MS + (m - MP)) * DPLE;
            v[r] = *((const f32x4*)src + lane); }
#pragma unroll
        for (int r = 0; r < 8; ++r) { u32x2 w; w.x = pk2(v[r][0], v[r][1]); w.y = pk2(v[r][2], v[r][3]); *((u32x2*)((bf16_t*)(ws + WS_PB) + (size_t)(r0 + r) * DPLE) + lane) = w; }
    }
    { const int* pt = (const int*)in_ptr(7); const float* ckv = (const float*)in_ptr(2); bf16_t* cs = (bf16_t*)(ws + WS_CS);
      const int kv = lane >> 5, gg = (lane >> 4) & 1, c4 = lane & 15;
      for (int it = gw; it < 2 * DECB * NPAGES * 4; it += NGW) { const int qr = it & 3, ps = (it >> 2) & 15, b = (it >> 6) & 127, layer = it >> 13;
          const int page = pt[b * NPAGES + ps]; const float* srow = ckv + ((size_t)(layer * NPOOL + page) * PAGE + qr * 32) * 512;
          bf16_t* drow = cs + ((size_t)(((layer * 2 + kv) * DECB + b) * 2 + gg) * PAST + ps * 128 + qr * 32) * 64 + c4 * 4;
#pragma unroll
          for (int r0 = 0; r0 < 32; r0 += 8) { f32x4 v[8];
#pragma unroll
              for (int r = 0; r < 8; ++r) v[r] = *((const f32x4*)(srow + (size_t)(r0 + r) * 512) + lane);
#pragma unroll
              for (int r = 0; r < 8; ++r) { u32x2 w; w.x = pk2(v[r][0], v[r][1]); w.y = pk2(v[r][2], v[r][3]); *(u32x2*)(drow + (size_t)(r0 + r) * 64) = w; } } } }
    for (int o = F.vcu * 512 + F.tid; o < 2 * D; o += F.G * 512) ((float*)(ws + WS_SPT))[o] = -8.f * 1.4426950408889634f * log1pf(__expf(-((const float*)in_ptr(23))[o]));
    for (int it = gw; it < 4 * 4 * 32; it += NGW) { const int mt = it >> 7, hc = (it >> 5) & 3, sl = it & 31; const int h = hc * 64 + lane;
        const float* pe = (const float*)in_ptr(12) + (size_t)mt * 2048; const float* w1 = (const float*)in_ptr(13) + (size_t)mt * 2048 * 256;
        float s = 0.f;
#pragma unroll 8
        for (int k = 0; k < 64; ++k) { const int kk = sl * 64 + k; s += pe[kk] * w1[(size_t)kk * 256 + h]; }
        ((float*)(ws + WS_B1PART))[(mt * 32 + sl) * 256 + h] = s; }
    for (int jb = F.vcu; jb < 2 * DECB; jb += F.G) { const f32x4* src = (const f32x4*)in_ptr(3) + (size_t)jb * (512 * 64) + 4 * 64; f32x4* dst = (f32x4*)(F.out + O_WINS) + (size_t)jb * (512 * 64);
        for (int k0 = 0; k0 < 64; k0 += 8) { f32x4 v[8];
#pragma unroll
            for (int k = 0; k < 8; ++k) { const int idx = F.tid + 512 * (k0 + k); if (idx < 508 * 64) v[k] = src[idx]; }
#pragma unroll
            for (int k = 0; k < 8; ++k) { const int idx = F.tid + 512 * (k0 + k); if (idx < 508 * 64) dst[idx] = v[k]; } } }
}

__device__ __forceinline__ void load_b1p(Frame& F) {
    LAS float* tb = (LAS float*)(F.lds + LDS_B1P_OFF); const float* part = (const float*)(F.ws + WS_B1PART);
    for (int o = F.tid; o < 1024; o += 512) { const int mt = o >> 8, h = o & 255; float s = ((const float*)in_ptr(14))[o];
        for (int sl = 0; sl < 32; ++sl) s += part[(mt * 32 + sl) * 256 + h];
        tb[o] = s; }
    __syncthreads();
}

__device__ __forceinline__ void cmp_stage2(Frame& F, const bf16_t* hid, const bf16_t* w2t_base, int rows_per_mat, int nrows, bf16_t* outp) {
    const int gw = F.vcu * NWAVES + F.wave, NGW = F.G * NWAVES, lane = F.lane, r32 = lane & 31, hi = lane >> 5;
    for (int task = gw; task < nrows / 32; task += NGW) { const int R0 = task * 32; const bf16_t* w2t = w2t_base + (size_t)(R0 / rows_per_mat) * 64 * 256;
        f32x16 o0 = {0}, o1 = {0};
#pragma unroll 4
        for (int ks = 0; ks < 16; ++ks) {
            const bf16x8 hf = *(const bf16x8*)(hid + (size_t)(R0 + r32) * 256 + 16 * ks + 8 * hi);
            const bf16x8 w0 = *(const bf16x8*)(w2t + (size_t)r32 * 256 + 16 * ks + 8 * hi), w1 = *(const bf16x8*)(w2t + (size_t)(32 + r32) * 256 + 16 * ks + 8 * hi);
            o0 = __builtin_amdgcn_mfma_f32_32x32x16_bf16(w0, hf, o0, 0, 0, 0); o1 = __builtin_amdgcn_mfma_f32_32x32x16_bf16(w1, hf, o1, 0, 0, 0); }
        bf16_t* op = outp + (size_t)(R0 + r32) * 64;
#pragma unroll
        for (int k4 = 0; k4 < 4; ++k4) { u32x2 w; w.x = pk2(o0[4 * k4], o0[4 * k4 + 1]); w.y = pk2(o0[4 * k4 + 2], o0[4 * k4 + 3]); *(u32x2*)(op + 8 * k4 + 4 * hi) = w;
            u32x2 w2; w2.x = pk2(o1[4 * k4], o1[4 * k4 + 1]); w2.y = pk2(o1[4 * k4 + 2], o1[4 * k4 + 3]); *(u32x2*)(op + 32 + 8 * k4 + 4 * hi) = w2; } }
}

__device__ __forceinline__ void ln_phase(Frame& F, const float* pre, const float* g, const float* bta, float* h32, bf16_t* hb) {
    const int gw = F.vcu * NWAVES + F.wave, NGW = F.G * NWAVES, lane = F.lane;
    f32x4 gv[4], bv[4];
#pragma unroll
    for (int jj = 0; jj < 4; ++jj) { gv[jj] = *((const f32x4*)g + lane + 64 * jj); bv[jj] = *((const f32x4*)bta + lane + 64 * jj); }
    for (int m = gw; m < MT; m += NGW) {
        const f32x4* xr = (const f32x4*)(pre + (size_t)m * D) + lane; f32x4 v[4]; float s = 0.f;
#pragma unroll
        for (int jj = 0; jj < 4; ++jj) { v[jj] = xr[64 * jj]; s += (v[jj][0] + v[jj][1]) + (v[jj][2] + v[jj][3]); }
        const float mean = wave_sum(s) * (1.f / D); float s2 = 0.f;
#pragma unroll
        for (int jj = 0; jj < 4; ++jj) { v[jj] = v[jj] - mean; s2 += (v[jj][0] * v[jj][0] + v[jj][1] * v[jj][1]) + (v[jj][2] * v[jj][2] + v[jj][3] * v[jj][3]); }
        const float rstd = 1.f / sqrtf(wave_sum(s2) * (1.f / D) + LN_EPS);
#pragma unroll
        for (int jj = 0; jj < 4; ++jj) { const f32x4 y = v[jj] * rstd * gv[jj] + bv[jj]; *((f32x4*)(h32 + (size_t)m * D) + lane + 64 * jj) = y;
            u32x2 w; w.x = pk2(y[0], y[1]); w.y = pk2(y[2], y[3]); *((u32x2*)(hb + (size_t)m * D) + lane + 64 * jj) = w; }
    }
}


template <int NR> __device__ __forceinline__ void ffn_conv_rows(const bf16_t* U, bf16_t* ACT, int row0, int c, const float (&w)[2][3][8], const float (&bb)[2][8], float (&p2)[2][8], float (&p1)[2][8]) {
    u32x4 ua[NR], ub[NR];
#pragma unroll
    for (int r = 0; r < NR; ++r) { ua[r] = *(const u32x4*)(U + (size_t)(row0 + r) * 6144 + c); ub[r] = *(const u32x4*)(U + (size_t)(row0 + r) * 6144 + DFF + c); }
#pragma unroll
    for (int r = 0; r < NR; ++r) { float cur[2][8], res[8]; unpack8(ua[r], cur[0]); unpack8(ub[r], cur[1]);
#pragma unroll
        for (int e = 0; e < 8; ++e) {
            const float xa = bb[0][e] + p2[0][e] * w[0][0][e] + p1[0][e] * w[0][1][e] + cur[0][e] * w[0][2][e];
            const float xb = bb[1][e] + p2[1][e] * w[1][0][e] + p1[1][e] * w[1][1][e] + cur[1][e] * w[1][2][e];
            res[e] = gelu_t(xa) * xb; p2[0][e] = p1[0][e]; p1[0][e] = cur[0][e]; p2[1][e] = p1[1][e]; p1[1][e] = cur[1][e]; }
        u32x4 o; o.x = pk2(res[0], res[1]); o.y = pk2(res[2], res[3]); o.z = pk2(res[4], res[5]); o.w = pk2(res[6], res[7]);
        *(u32x4*)(ACT + (size_t)(row0 + r) * DFF + c) = o; }
}
__device__ __forceinline__ void ffn_conv_phase(Frame& F, const bf16_t* U, const float* cw, const float* cb, const float* state  , bf16_t* ACT) {
    const int gt = F.vcu * 512 + F.tid, NT = F.G * 512;
    constexpr int CG = DFF / 8;
    constexpr int NPI = (MP / 16) * CG;
    constexpr int NSI = DECB * CG;
    for (int it = gt; it < NPI + NSI; it += NT) {
        const bool samp = it >= NPI; const int q = samp ? it - NPI : it; const int cg = q % CG, rc = q / CG, c = cg * 8;
        float w[2][3][8], bb[2][8];
#pragma unroll
        for (int h = 0; h < 2; ++h) {
#pragma unroll
            for (int k = 0; k < 3; ++k) { const f32x4 a = *(const f32x4*)(cw + (size_t)k * 6144 + h * DFF + c), b = *(const f32x4*)(cw + (size_t)k * 6144 + h * DFF + c + 4);
#pragma unroll
                for (int e = 0; e < 4; ++e) { w[h][k][e] = a[e]; w[h][k][4 + e] = b[e]; } }
            const f32x4 a = *(const f32x4*)(cb + h * DFF + c), b = *(const f32x4*)(cb + h * DFF + c + 4);
#pragma unroll
            for (int e = 0; e < 4; ++e) { bb[h][e] = a[e]; bb[h][4 + e] = b[e]; } }
        float p2[2][8], p1[2][8];
        if (!samp) { const int row0 = rc * 16, t0 = row0 & 2047;
#pragma unroll
            for (int h = 0; h < 2; ++h) {
                if (t0 == 0) {
#pragma unroll
                    for (int e = 0; e < 8; ++e) { p2[h][e] = 0.f; p1[h][e] = 0.f; } }
                else { unpack8(*(const u32x4*)(U + (size_t)(row0 - 2) * 6144 + h * DFF + c), p2[h]); unpack8(*(const u32x4*)(U + (size_t)(row0 - 1) * 6144 + h * DFF + c), p1[h]); } }
            ffn_conv_rows<8>(U, ACT, row0, c, w, bb, p2, p1); ffn_conv_rows<8>(U, ACT, row0 + 8, c, w, bb, p2, p1); }
        else { const int row0 = MP + rc * 4;
#pragma unroll
            for (int h = 0; h < 2; ++h) { const float* s0 = state + ((size_t)rc * 2 + 0) * 6144 + h * DFF + c; const float* s1 = state + ((size_t)rc * 2 + 1) * 6144 + h * DFF + c;
#pragma unroll
                for (int e = 0; e < 8; ++e) { p2[h][e] = s0[e]; p1[h][e] = s1[e]; } }
            ffn_conv_rows<4>(U, ACT, row0, c, w, bb, p2, p1); }
    }
}

__device__ __forceinline__ void rg_conv_phase(Frame& F, const bf16_t* RECB, const float* cw  , const float* cb, const float* state  , bf16_t* REC) {
    const int gt = F.vcu * 512 + F.tid, NT = F.G * 512;
    constexpr int CG = D / 8; constexpr int NPI = (MP / 16) * CG, NSI = DECB * CG;
    for (int it = gt; it < NPI + NSI; it += NT) {
        const bool samp = it >= NPI; const int q = samp ? it - NPI : it; const int cg = q % CG, rc = q / CG, c = cg * 8;
        float w[4][8], bb[8];
#pragma unroll
        for (int k = 0; k < 4; ++k) {
#pragma unroll
            for (int e = 0; e < 8; ++e) w[k][e] = cw[k * D + c + e]; }
#pragma unroll
        for (int e = 0; e < 8; ++e) bb[e] = cb[c + e];
        float p3[8], p2[8], p1[8]; int row0, nrows;
        if (!samp) { row0 = rc * 16; nrows = 16; const int t0 = row0 & 2047;
            if (t0 == 0) {
#pragma unroll
                for (int e = 0; e < 8; ++e) { p3[e] = 0.f; p2[e] = 0.f; p1[e] = 0.f; } }
            else { unpack8(*(const u32x4*)(RECB + (size_t)(row0 - 3) * D + c), p3); unpack8(*(const u32x4*)(RECB + (size_t)(row0 - 2) * D + c), p2); unpack8(*(const u32x4*)(RECB + (size_t)(row0 - 1) * D + c), p1); } }
        else { row0 = MP + rc * 4; nrows = 4;
#pragma unroll
            for (int e = 0; e < 8; ++e) { p3[e] = state[((size_t)rc * 3 + 0) * D + c + e]; p2[e] = state[((size_t)rc * 3 + 1) * D + c + e]; p1[e] = state[((size_t)rc * 3 + 2) * D + c + e]; } }
        for (int r = 0; r < nrows; ++r) {
            float cur[8], res[8]; unpack8(*(const u32x4*)(RECB + (size_t)(row0 + r) * D + c), cur);
#pragma unroll
            for (int e = 0; e < 8; ++e) { res[e] = bb[e] + p3[e] * w[0][e] + p2[e] * w[1][e] + p1[e] * w[2][e] + cur[e] * w[3][e]; p3[e] = p2[e]; p2[e] = p1[e]; p1[e] = cur[e]; }
            u32x4 o; o.x = pk2(res[0], res[1]); o.y = pk2(res[2], res[3]); o.z = pk2(res[4], res[5]); o.w = pk2(res[6], res[7]);
            *(u32x4*)(REC + (size_t)(row0 + r) * D + c) = o; }
    }
}

__device__ __forceinline__ void scan1_phase(Frame& F, const float* AA, const float* UU, float* CA, float* CH) {
    for (int it = F.vcu; it < BATCH * 32 * 2; it += F.G) { const int bc = it >> 1, c = (it & 1) * 512 + F.tid; const int b = bc >> 5, ch = bc & 31;
        const size_t r0 = (size_t)b * SEQ + ch * 64; float a = 1.f, h = 0.f;
#pragma unroll
        for (int t0 = 0; t0 < 64; t0 += 16) { float at[16], ut[16];
#pragma unroll
            for (int t = 0; t < 16; ++t) { at[t] = AA[(r0 + t0 + t) * D + c]; ut[t] = UU[(r0 + t0 + t) * D + c]; }
#pragma unroll
            for (int t = 0; t < 16; ++t) { h = at[t] * h + ut[t]; a *= at[t]; } }
        CA[(size_t)bc * D + c] = a; CH[(size_t)bc * D + c] = h; }
}
__device__ __forceinline__ void scan2_phase(Frame& F, const float* AA, const float* UU, const float* CA, const float* CH, const bf16_t* GG, bf16_t* HG, const float* h0s  , float* out, int j) {
    constexpr int NPI = BATCH * 32 * 2, NSI = DECB * 2;
    for (int it = F.vcu; it < NPI + NSI; it += F.G) {
        if (it < NPI) { const int bc = it >> 1, c = (it & 1) * 512 + F.tid; const int b = bc >> 5, ch = bc & 31;
            float h = 0.f;
#pragma unroll
            for (int k0 = 0; k0 < 32; k0 += 16) { float ca[16], chh[16];
#pragma unroll
                for (int k = 0; k < 16; ++k) { const bool on = (k0 + k) < ch; ca[k] = on ? CA[(size_t)(b * 32 + k0 + k) * D + c] : 1.f; chh[k] = on ? CH[(size_t)(b * 32 + k0 + k) * D + c] : 0.f; }
#pragma unroll
                for (int k = 0; k < 16; ++k) h = ca[k] * h + chh[k]; }
            const size_t r0 = (size_t)b * SEQ + ch * 64;
#pragma unroll
            for (int t0 = 0; t0 < 64; t0 += 16) { float at[16], ut[16]; bf16_t gv[16];
#pragma unroll
                for (int t = 0; t < 16; ++t) { at[t] = AA[(r0 + t0 + t) * D + c]; ut[t] = UU[(r0 + t0 + t) * D + c]; gv[t] = GG[(r0 + t0 + t) * D + c]; }
#pragma unroll
                for (int t = 0; t < 16; ++t) { h = at[t] * h + ut[t]; HG[(r0 + t0 + t) * D + c] = (bf16_t)f2bf(h * bf2f(gv[t])); } }
            if (ch == 31) out[O_HP + (size_t)(j * BATCH + b) * D + c] = h; }
        else { const int q = it - NPI, b = q >> 1, c = (q & 1) * 512 + F.tid; float h = h0s[(size_t)b * D + c];
#pragma unroll
            for (int s = 0; s < 4; ++s) { const size_t r = (size_t)MP + b * 4 + s; h = AA[r * D + c] * h + UU[r * D + c]; HG[r * D + c] = (bf16_t)f2bf(h * bf2f(GG[r * D + c])); }
            out[O_HS + (size_t)(j * DECB + b) * D + c] = h; }
    }
}

namespace att {
__device__ __forceinline__ int crow(int r, int hi) { return (r & 3) + 8 * (r >> 2) + 4 * hi; }
__device__ __forceinline__ int koff(int key, int c16) { return key * 128 + ((c16 ^ ((key >> 1) & 7)) << 4); }
__device__ __forceinline__ int voff8(int key, int c8) { return key * 128 + ((c8 ^ (((key >> 1) & 1) << 3)) << 3); }
__device__ __forceinline__ float pmax(float v) { auto rr = __builtin_amdgcn_permlane32_swap(__float_as_uint(v), __float_as_uint(v), false, false); return fmaxf(__uint_as_float(rr[0]), __uint_as_float(rr[1])); }
__device__ __forceinline__ float psum(float v) { auto rr = __builtin_amdgcn_permlane32_swap(__float_as_uint(v), __float_as_uint(v), false, false); return __uint_as_float(rr[0]) + __uint_as_float(rr[1]); }
__device__ __forceinline__ float pother(float v, int hi) { auto rr = __builtin_amdgcn_permlane32_swap(__float_as_uint(v), __float_as_uint(v), false, false); return hi ? __uint_as_float(rr[0]) : __uint_as_float(rr[1]); }
typedef short v4i16_t __attribute__((ext_vector_type(4)));
__device__ __forceinline__ s16x4 vtr(const LAS unsigned char* p) { return __builtin_bit_cast(s16x4, __builtin_amdgcn_ds_read_tr16_b64_v4i16((LAS v4i16_t*)p)); }

__device__ __forceinline__ f32x16 s_tile(const LAS unsigned char* Kt, int key0, const bf16x8 (&qf)[4], int lane) {
    const int kq = lane & 31, hi = lane >> 5; f32x16 s = {0};
#pragma unroll
    for (int ks = 0; ks < 4; ++ks) { const bf16x8 kf = *(const LAS bf16x8*)(Kt + koff(key0 + kq, 2 * ks + hi)); s = __builtin_amdgcn_mfma_f32_32x32x16_bf16(kf, qf[ks], s, 0, 0, 0); }
    return s;
}
__device__ __forceinline__ void pv_tile(const LAS unsigned char* Vt, int key0, const f32x16& p, f32x16 (&o)[2], int lane) {
    const int hi = lane >> 5, gI = (lane >> 4) & 1, l15 = lane & 15, qp = l15 >> 2, pp = l15 & 3;
    unsigned pk[8];
#pragma unroll
    for (int i = 0; i < 8; ++i) pk[i] = pk2(p[2 * i], p[2 * i + 1]);
#pragma unroll
    for (int st = 0; st < 2; ++st) { const u32x4 pw = {pk[4 * st], pk[4 * st + 1], pk[4 * st + 2], pk[4 * st + 3]}; const bf16x8 pb = __builtin_bit_cast(bf16x8, pw);
#pragma unroll
        for (int dt = 0; dt < 2; ++dt) { const int c8 = 8 * dt + 4 * gI + pp, k1 = key0 + 16 * st + 4 * hi + qp;
            const s16x4 lo = vtr(Vt + voff8(k1, c8)), h4 = vtr(Vt + voff8(k1 + 8, c8));
            const bf16x8 vf = {lo[0], lo[1], lo[2], lo[3], h4[0], h4[1], h4[2], h4[3]};
            o[dt] = __builtin_amdgcn_mfma_f32_32x32x16_bf16(vf, pb, o[dt], 0, 0, 0); } }
}
template <class VF>
__device__ __forceinline__ void flash32(const LAS unsigned char* Kt, const LAS unsigned char* Vt, int key0, const bf16x8 (&qf)[4], float& m, float& l, f32x16 (&o)[2], int lane, VF valid) {
    f32x16 s = s_tile(Kt, key0, qf, lane); const int hi = lane >> 5;
    float tm = -1e30f;
#pragma unroll
    for (int r = 0; r < 16; ++r) { const bool v = valid(crow(r, hi)); s[r] = v ? s[r] : -1e30f; tm = fmaxf(tm, s[r]); }
    tm = pmax(tm);
    const float mn = fmaxf(m, tm), f = ex2(m - mn); m = mn;
    float ps = 0.f;
#pragma unroll
    for (int r = 0; r < 16; ++r) { const float p = s[r] > -1e29f ? ex2(s[r] - mn) : 0.f; s[r] = p; ps += p; }
    l = l * f + ps;
#pragma unroll
    for (int r = 0; r < 16; ++r) { o[0][r] *= f; o[1][r] *= f; }
    pv_tile(Vt, key0, s, o, lane);
}

constexpr int P_KT0 = 0, P_VT0 = 8192, P_KT1 = 16384, P_VT1 = 24576, P_KC = 32768, P_VC = 49152, P_IMP = 65536, P_IMPS = 98304, P_SELM = 102400;

__device__ __forceinline__ void stage_kv64(LAS unsigned char* Kt, LAS unsigned char* Vt, const u32x4& rk, const u32x4& rv, int tid) {
    const int key = tid >> 3, c16 = tid & 7;
    *(LAS u32x4*)(Kt + koff(key, c16)) = rk; *(LAS u32x4*)(Vt + key * 128 + ((c16 ^ (((key >> 1) & 1) << 2)) << 4)) = rv;
}

__device__ __forceinline__ void nsa_prompt_item(LAS unsigned char* lds, int b, int qblk, int g, const bf16_t* QB, const bf16_t* KV6, const bf16_t* KCP, const float* G32, bf16_t* OB, int tid_in) {
    int tid_ = tid_in; asm volatile("" : "+v"(tid_));
    const int tid = tid_, lane = tid & 63, w = __builtin_amdgcn_readfirstlane(tid >> 6), q = lane & 31, hi = lane >> 5;
    const int t0 = 32 * qblk, t = t0 + q, cur = qblk >> 1, head = 8 * g + w; const size_t m = (size_t)b * SEQ + t;
#pragma unroll
    for (int i = 0; i < 2; ++i) { const int idx = tid + 512 * i, key = idx >> 3, c16 = idx & 7;
        const u32x4 kk = *(const u32x4*)(KCP + ((size_t)((0 * 16 + b * 2 + g) * 128 + key)) * 64 + c16 * 8), vv = *(const u32x4*)(KCP + ((size_t)((1 * 16 + b * 2 + g) * 128 + key)) * 64 + c16 * 8);
        *(LAS u32x4*)(lds + P_KC + koff(key, c16)) = kk; *(LAS u32x4*)(lds + P_VC + key * 128 + ((c16 ^ (((key >> 1) & 1) << 2)) << 4)) = vv; }
    bf16x8 qf[4];
#pragma unroll
    for (int ks = 0; ks < 4; ++ks) qf[ks] = *(const bf16x8*)(QB + m * 1024 + head * 64 + 16 * ks + 8 * hi);
    const float g0 = G32[m * 48 + g * 24 + w * 3 + 0], g1 = G32[m * 48 + g * 24 + w * 3 + 1], g2 = G32[m * 48 + g * 24 + w * 3 + 2];
    __syncthreads();
    f32x16 otot[2];
    {
        f32x16 s[4]; float mx = -1e30f;
#pragma unroll
        for (int tl = 0; tl < 4; ++tl) { s[tl] = s_tile(lds + P_KC, 32 * tl, qf, lane);
#pragma unroll
            for (int r = 0; r < 16; ++r) { const int c = 32 * tl + crow(r, hi); const bool v = (16 * c + 31 <= t); s[tl][r] = v ? s[tl][r] : -1e30f; mx = fmaxf(mx, s[tl][r]); } }
        mx = pmax(mx); float sum = 0.f;
#pragma unroll
        for (int tl = 0; tl < 4; ++tl)
#pragma unroll
            for (int r = 0; r < 16; ++r) { const float e = s[tl][r] > -1e29f ? ex2(s[tl][r] - mx) : 0.f; s[tl][r] = e; sum += e; }
        sum = psum(sum); const float inv = 1.f / fmaxf(sum, 1e-30f);
        float G[16], lastv[16];
#pragma unroll
        for (int tl = 0; tl < 4; ++tl)
#pragma unroll
            for (int k = 0; k < 4; ++k) { float a = 0.f;
#pragma unroll
                for (int i = 0; i < 4; ++i) { s[tl][4 * k + i] *= inv; a += s[tl][4 * k + i]; }
                G[4 * tl + k] = a; lastv[4 * tl + k] = s[tl][4 * k + 3]; }
        float oth[16];
#pragma unroll
        for (int i = 0; i < 16; ++i) oth[i] = pother(lastv[i], hi);
        LAS float* imp = (LAS float*)(lds + P_IMP) + (w * 32 + q) * 32;
#pragma unroll
        for (int i = 0; i < 16; ++i) { const int tl = i >> 2, k = i & 3; const int n = 2 * k + hi + 8 * tl;
            const float prev = hi ? oth[i] : (i ? oth[i - 1] : 0.f); imp[n] = G[i] + prev; }
        f32x16 oc[2] = {{0}, {0}};
#pragma unroll
        for (int tl = 0; tl < 4; ++tl) pv_tile(lds + P_VC, 32 * tl, s[tl], oc, lane);
        otot[0] = oc[0] * g0; otot[1] = oc[1] * g0;
    }
    __syncthreads();
    {
        const int qq = lane >> 4, n2 = lane & 15, qs = 4 * w + qq;
        LAS float* imps = (LAS float*)(lds + P_IMPS) + qs * 32; float val[2];
#pragma unroll
        for (int e = 0; e < 2; ++e) { const int n = n2 + 16 * e; float v = 0.f;
#pragma unroll
            for (int ww = 0; ww < 8; ++ww) v += ((LAS float*)(lds + P_IMP))[(ww * 32 + qs) * 32 + n];
            if (n == 0 || n == cur || n == cur - 1) v = 1e6f;
            if (n > cur) v = -1.f;
            val[e] = v; imps[n] = v; }
        LDS_WAIT(); asm volatile("" ::: "memory");
        int rank0 = 0, rank1 = 0;
        for (int np = 0; np < 32; ++np) { const float vp = imps[np];
            rank0 += (vp > val[0] || (vp == val[0] && np < n2)) ? 1 : 0; rank1 += (vp > val[1] || (vp == val[1] && np < n2 + 16)) ? 1 : 0; }
        const unsigned long long b0 = __ballot(rank0 < 16), b1 = __ballot(rank1 < 16);
        const unsigned mask = (unsigned)((b0 >> (16 * qq)) & 0xffffull) | ((unsigned)((b1 >> (16 * qq)) & 0xffffull) << 16);
        if (n2 == 0) ((LAS unsigned*)(lds + P_SELM))[qs] = mask;
    }
    __syncthreads();
    const unsigned mymask = ((LAS unsigned*)(lds + P_SELM))[q];
    unsigned um = mymask;
#pragma unroll
    for (int o = 1; o < 32; o <<= 1) um |= (unsigned)__shfl_xor((int)um, o);
    um = (unsigned)__builtin_amdgcn_readfirstlane((int)um);
    const bf16_t* Ksel = KV6 + ((size_t)((2 * 8 + b) * 2 + g) * 2048) * 64; const bf16_t* Vsel = KV6 + ((size_t)((3 * 8 + b) * 2 + g) * 2048) * 64;
    const bf16_t* Kwin = KV6 + ((size_t)((4 * 8 + b) * 2 + g) * 2048) * 64; const bf16_t* Vwin = KV6 + ((size_t)((5 * 8 + b) * 2 + g) * 2048) * 64;
    const int ldoff = (tid >> 3) * 64 + (tid & 7) * 8;
    {
        unsigned rem = um & (cur == 31 ? 0xffffffffu : ((1u << (cur + 1)) - 1u));
        float mm = -1e30f, ll = 0.f; f32x16 o[2] = {{0}, {0}};
        int n = __builtin_ctz(rem); rem &= rem - 1;
        u32x4 rk = *(const u32x4*)(Ksel + (size_t)n * 4096 + ldoff), rv = *(const u32x4*)(Vsel + (size_t)n * 4096 + ldoff);
        int buf = 0;
        for (;;) {
            LAS unsigned char* Kt = lds + (buf ? P_KT1 : P_KT0); LAS unsigned char* Vt = lds + (buf ? P_VT1 : P_VT0);
            stage_kv64(Kt, Vt, rk, rv, tid);
            __syncthreads();
            const int nn = rem ? __builtin_ctz(rem) : -1;
            if (nn >= 0) { rem &= rem - 1; rk = *(const u32x4*)(Ksel + (size_t)nn * 4096 + ldoff); rv = *(const u32x4*)(Vsel + (size_t)nn * 4096 + ldoff); }
            const bool selq = (mymask >> n) & 1u;
#pragma unroll
            for (int hf = 0; hf < 2; ++hf) { const int kb = 64 * n + 32 * hf;
                flash32(Kt, Vt, 32 * hf, qf, mm, ll, o, lane, [&](int kk) { return selq && (kb + kk <= t); }); }
            if (nn < 0) break;
            n = nn; buf ^= 1;
        }
        ll = psum(ll); const float sc = g1 / fmaxf(ll, 1e-30f);
        otot[0] += o[0] * sc; otot[1] += o[1] * sc;
    }
    __syncthreads();
    {
        const int nlo = cur - 8 < 0 ? 0 : cur - 8;
        float mm = -1e30f, ll = 0.f; f32x16 o[2] = {{0}, {0}};
        u32x4 rk = *(const u32x4*)(Kwin + (size_t)nlo * 4096 + ldoff), rv = *(const u32x4*)(Vwin + (size_t)nlo * 4096 + ldoff);
        int buf = 0;
        for (int n = nlo; n <= cur; ++n) {
            LAS unsigned char* Kt = lds + (buf ? P_KT1 : P_KT0); LAS unsigned char* Vt = lds + (buf ? P_VT1 : P_VT0);
            stage_kv64(Kt, Vt, rk, rv, tid);
            __syncthreads();
            if (n < cur) { rk = *(const u32x4*)(Kwin + (size_t)(n + 1) * 4096 + ldoff); rv = *(const u32x4*)(Vwin + (size_t)(n + 1) * 4096 + ldoff); }
#pragma unroll
            for (int hf = 0; hf < 2; ++hf) { const int kb = 64 * n + 32 * hf;
                flash32(Kt, Vt, 32 * hf, qf, mm, ll, o, lane, [&](int kk) { const int key = kb + kk; return key <= t && key >= t - 512; }); }
            buf ^= 1;
        }
        ll = psum(ll); const float sc = g2 / fmaxf(ll, 1e-30f);
        otot[0] += o[0] * sc; otot[1] += o[1] * sc;
    }
    bf16_t* op = OB + m * 1024 + head * 64;
#pragma unroll
    for (int dt = 0; dt < 2; ++dt)
#pragma unroll
        for (int k4 = 0; k4 < 4; ++k4) { u32x2 wv; wv.x = pk2(otot[dt][4 * k4], otot[dt][4 * k4 + 1]); wv.y = pk2(otot[dt][4 * k4 + 2], otot[dt][4 * k4 + 3]);
            *(u32x2*)(op + 32 * dt + 8 * k4 + 4 * hi) = wv; }
    __syncthreads();
}

constexpr int S_TILE = 0  , S_OBUF = 0  , S_KC = 65536, S_VC = 81920, S_PBUF = 98304  ,
              S_MST = 114688  , S_LST = 115712, S_IMPS = 116736  , S_SELF = 117376  ;

__device__ __forceinline__ void s_write_partial(LAS unsigned char* lds, int w, int lane, float mm, float ll, const f32x16 (&o)[2]) {
    const int j = lane & 31, hi = lane >> 5;
    if (hi == 0) { ((LAS float*)(lds + S_MST))[w * 32 + j] = mm; ((LAS float*)(lds + S_LST))[w * 32 + j] = ll; }
    LAS float* ob = (LAS float*)(lds + S_OBUF) + w * 2048;
#pragma unroll
    for (int dt = 0; dt < 2; ++dt)
#pragma unroll
        for (int r = 0; r < 16; ++r) ob[(32 * dt + crow(r, hi)) * 32 + j] = o[dt][r];
}
__device__ __forceinline__ void s_merge(LAS unsigned char* lds, int nw, int tid, float gate, float (&acc)[4]) {
    const int j = tid & 31; const LAS float* ms = (const LAS float*)(lds + S_MST); const LAS float* ls = (const LAS float*)(lds + S_LST);
    float M = -1e30f;
    for (int w = 0; w < nw; ++w) M = fmaxf(M, ms[w * 32 + j]);
    float L = 0.f, wt[8];
    for (int w = 0; w < 8; ++w) { wt[w] = (w < nw) ? ex2(ms[w * 32 + j] - M) : 0.f; if (w < nw) L += ls[w * 32 + j] * wt[w]; }
    const float sc = gate / fmaxf(L, 1e-30f);
#pragma unroll
    for (int i = 0; i < 4; ++i) { const int d = (tid >> 5) + 16 * i; float v = 0.f;
        for (int w = 0; w < nw; ++w) v += ((const LAS float*)(lds + S_OBUF))[w * 2048 + d * 32 + j] * wt[w];
        acc[i] += v * sc; }
}
__device__ __forceinline__ void s_load_half_f32(LAS unsigned char* Kt, LAS unsigned char* Vt, const float* ksrc, const float* vsrc, size_t rstride, int nvalid, int lane) {
    const int kr = lane >> 4, c = lane & 15;
#pragma unroll
    for (int i = 0; i < 8; ++i) { const int key = 4 * i + kr; f32x4 kv = {0.f, 0.f, 0.f, 0.f}, vv = {0.f, 0.f, 0.f, 0.f};
        if (key < nvalid) { kv = *(const f32x4*)(ksrc + (size_t)key * rstride + 4 * c); vv = *(const f32x4*)(vsrc + (size_t)key * rstride + 4 * c); }
        u32x2 kw; kw.x = pk2(kv[0], kv[1]); kw.y = pk2(kv[2], kv[3]); u32x2 vw; vw.x = pk2(vv[0], vv[1]); vw.y = pk2(vv[2], vv[3]);
        *(LAS u32x2*)(Kt + koff(key, c >> 1) + 8 * (c & 1)) = kw; *(LAS u32x2*)(Vt + voff8(key, c)) = vw; }
}
__device__ __forceinline__ void s_load_rows_bf16(LAS unsigned char* Kt, LAS unsigned char* Vt, int key0, const bf16_t* ksrc, const bf16_t* vsrc, size_t rstride, int nvalid, int lane) {
    const int kr = lane >> 4, c = lane & 15;
    for (int i = 0; i < 8; ++i) { const int kk = 4 * i + kr; if (kk >= nvalid) break;
        const u32x2 kw = *(const u32x2*)(ksrc + (size_t)kk * rstride + 4 * c), vw = *(const u32x2*)(vsrc + (size_t)kk * rstride + 4 * c);
        *(LAS u32x2*)(Kt + koff(key0 + kk, c >> 1) + 8 * (c & 1)) = kw; *(LAS u32x2*)(Vt + voff8(key0 + kk, c)) = vw; }
}

__device__ __forceinline__ void nsa_sample_item(LAS unsigned char* lds, int b, int g, int layer, const bf16_t* QB, const bf16_t* KVS, const bf16_t* KCS, const float* G32,
                                                const float* ckv, const float* cwin, const int* pt, bf16_t* OB, int tid_in) {
    int tid_ = tid_in; asm volatile("" : "+v"(tid_));
    const int tid = tid_, lane = tid & 63, w = __builtin_amdgcn_readfirstlane(tid >> 6), j = lane & 31, hi = lane >> 5, qy = j >> 3, hh = j & 7;
    const size_t ms = (size_t)MP + 4 * b + qy; const int head = 8 * g + hh;
#pragma unroll
    for (int i = 0; i < 2; ++i) { const int idx = tid + 512 * i, key = idx >> 3, c16 = idx & 7;
        const u32x4 kk = *(const u32x4*)(KCS + ((size_t)((((layer * 2 + 0) * DECB + b) * 2 + g) * 128 + key)) * 64 + c16 * 8), vv = *(const u32x4*)(KCS + ((size_t)((((layer * 2 + 1) * DECB + b) * 2 + g) * 128 + key)) * 64 + c16 * 8);
        *(LAS u32x4*)(lds + S_KC + koff(key, c16)) = kk; *(LAS u32x4*)(lds + S_VC + key * 128 + ((c16 ^ (((key >> 1) & 1) << 2)) << 4)) = vv; }
    bf16x8 qf[4];
#pragma unroll
    for (int ks = 0; ks < 4; ++ks) qf[ks] = *(const bf16x8*)(QB + ms * 1024 + head * 64 + 16 * ks + 8 * hi);
    const float g0 = G32[ms * 48 + g * 24 + hh * 3 + 0], g1 = G32[ms * 48 + g * 24 + hh * 3 + 1], g2 = G32[ms * 48 + g * 24 + hh * 3 + 2];
    float acc[4] = {0.f, 0.f, 0.f, 0.f};
    if (tid < 8) ((LAS unsigned*)(lds + S_SELF))[tid] = 0u;
    __syncthreads();
    if (w < 4) {
        f32x16 s = s_tile(lds + S_KC, 32 * w, qf, lane); float mx = -1e30f;
#pragma unroll
        for (int r = 0; r < 16; ++r) { const int c = 32 * w + crow(r, hi); s[r] = (c < 127) ? s[r] : -1e30f; mx = fmaxf(mx, s[r]); }
        mx = pmax(mx); float sum = 0.f;
#pragma unroll
        for (int r = 0; r < 16; ++r) { const float e = s[r] > -1e29f ? ex2(s[r] - mx) : 0.f; s[r] = e; sum += e; ((LAS float*)(lds + S_PBUF))[(32 * w + crow(r, hi)) * 32 + j] = e; }
        sum = psum(sum);
        f32x16 o[2] = {{0}, {0}}; pv_tile(lds + S_VC, 32 * w, s, o, lane);
        s_write_partial(lds, w, lane, mx, sum, o);
    }
    __syncthreads();
    s_merge(lds, 4, tid, g0, acc);
    if (tid < 132) { const int q4 = tid / 33, n = tid % 33; float v = 0.f;
        const LAS float* msb = (const LAS float*)(lds + S_MST); const LAS float* lsb = (const LAS float*)(lds + S_LST);
        for (int h8 = 0; h8 < 8; ++h8) { const int jj = 8 * q4 + h8; float M = -1e30f;
            for (int ww = 0; ww < 4; ++ww) M = fmaxf(M, msb[ww * 32 + jj]);
            float L = 0.f; for (int ww = 0; ww < 4; ++ww) L += lsb[ww * 32 + jj] * ex2(msb[ww * 32 + jj] - M);
            float a = 0.f;
            for (int c = 4 * n - 1; c <= 4 * n + 3; ++c) if (c >= 0 && c < 127) a += ((const LAS float*)(lds + S_PBUF))[c * 32 + jj] * ex2(msb[(c >> 5) * 32 + jj] - M);
            v += a / fmaxf(L, 1e-30f); }
        if (n == 0 || n == 32 || n == 31) v = 1e6f;
        ((LAS float*)(lds + S_IMPS))[q4 * 33 + n] = v; }
    __syncthreads();
    if (tid < 132) { const int q4 = tid / 33, n = tid % 33; const float v = ((const LAS float*)(lds + S_IMPS))[q4 * 33 + n]; int rank = 0;
        for (int np = 0; np < 33; ++np) { const float vp = ((const LAS float*)(lds + S_IMPS))[q4 * 33 + np]; rank += (vp > v || (vp == v && np < n)) ? 1 : 0; }
        if (rank < 16) __hip_atomic_fetch_or((LAS unsigned*)(lds + S_SELF) + q4 * 2 + (n >> 5), 1u << (n & 31), __ATOMIC_RELAXED, __HIP_MEMORY_SCOPE_WORKGROUP); }
    __syncthreads();
    unsigned long long mymask, um;
    { const LAS unsigned* sf = (const LAS unsigned*)(lds + S_SELF);
      mymask = (unsigned long long)sf[qy * 2] | ((unsigned long long)sf[qy * 2 + 1] << 32);
      um = (unsigned long long)(sf[0] | sf[2] | sf[4] | sf[6]) | ((unsigned long long)(sf[1] | sf[3] | sf[5] | sf[7]) << 32); }
    LAS unsigned char* Kt = lds + S_TILE + w * 8192; LAS unsigned char* Vt = Kt + 4096;
    {
        float mm = -1e30f, ll = 0.f; f32x16 o[2] = {{0}, {0}}; int idx = 0;
        for (int n = 0; n < 33; ++n) { if (!((um >> n) & 1ull)) continue;
            for (int hf = 0; hf < 2; ++hf) { if (n == 32 && hf == 1) break;
                if ((idx++ & 7) != w) continue;
                if (n < 32) { const int page = pt[b * NPAGES + (n >> 1)]; const float* base = ckv + ((size_t)(layer * NPOOL + page) * PAGE + (n & 1) * 64 + 32 * hf) * 512 + g * 64;
                    s_load_half_f32(Kt, Vt, base + 2 * 128, base + 3 * 128, 512, 32, lane); }
                else { s_load_half_f32(Kt, Vt, nullptr, nullptr, 0, 0, lane); LDS_WAIT();
                    s_load_rows_bf16(Kt, Vt, 0, KVS + (size_t)(4 * b) * 768 + 2 * 128 + g * 64, KVS + (size_t)(4 * b) * 768 + 3 * 128 + g * 64, 768, 4, lane); }
                LDS_WAIT(); asm volatile("" ::: "memory");
                const bool selq = (mymask >> n) & 1ull; const int pos0 = 64 * n + 32 * hf;
                flash32(Kt, Vt, 0, qf, mm, ll, o, lane, [&](int kk) { return selq && (pos0 + kk <= PAST + qy); });
                LDS_WAIT(); asm volatile("" ::: "memory"); } }
        ll = psum(ll);
        __syncthreads();
        s_write_partial(lds, w, lane, mm, ll, o);
        __syncthreads();
        s_merge(lds, 8, tid, g1, acc);
        __syncthreads();
    }
    {
        float mm = -1e30f, ll = 0.f; f32x16 o[2] = {{0}, {0}};
        for (int ht = w; ht < 17; ht += 8) {
            if (ht < 16) { const float* base = cwin + ((size_t)(layer * DECB + b) * 512 + 32 * ht) * 256 + g * 64; s_load_half_f32(Kt, Vt, base, base + 128, 256, 32, lane); }
            else { s_load_half_f32(Kt, Vt, nullptr, nullptr, 0, 0, lane); LDS_WAIT();
                s_load_rows_bf16(Kt, Vt, 0, KVS + (size_t)(4 * b) * 768 + 4 * 128 + g * 64, KVS + (size_t)(4 * b) * 768 + 5 * 128 + g * 64, 768, 4, lane); }
            LDS_WAIT(); asm volatile("" ::: "memory");
            const int i0 = 32 * ht;
            flash32(Kt, Vt, 0, qf, mm, ll, o, lane, [&](int kk) { const int ix = i0 + kk; return ix >= qy && ix <= 512 + qy; });
            LDS_WAIT(); asm volatile("" ::: "memory"); }
        ll = psum(ll);
        __syncthreads();
        s_write_partial(lds, w, lane, mm, ll, o);
        __syncthreads();
        s_merge(lds, 8, tid, g2, acc);
    }
    { const int jj = tid & 31; const size_t mr = (size_t)MP + 4 * b + (jj >> 3); const int hd = 8 * g + (jj & 7);
#pragma unroll
      for (int i = 0; i < 4; ++i) { const int d = (tid >> 5) + 16 * i; OB[mr * 1024 + hd * 64 + d] = (bf16_t)f2bf(acc[i]); } }
    __syncthreads();
}
}

constexpr int N_PHASES = 4 + 4 * 12;
__global__ void __launch_bounds__(NWAVES * 64, 2) mega_fwd(Args args) {
    extern __shared__ __attribute__((aligned(16))) unsigned char lds_raw[];
    Frame F;
    const int wave0 = __builtin_amdgcn_readfirstlane((int)threadIdx.x >> 6);
    F.lds = (LAS unsigned char*)lds_raw; F.tid = make_tid(wave0); F.lane = F.tid & 63; F.wave = wave0;
    F.G = gridDim.x; { const int bx0 = blockIdx.x; F.vcu = (F.G % 8 == 0) ? (bx0 % 8) * (F.G / 8) + bx0 / 8 : bx0; }
    F.ws = args.ws; F.out = args.out;
    unsigned char* ws0 = args.ws; float* out0 = args.out; int layer0 = 0;
#define PH_LOCALS unsigned char* ws = ws0; asm volatile("" : "+s"(ws)); float* outl = out0; asm volatile("" : "+s"(outl)); int layer = layer0; asm volatile("" : "+s"(layer)); const int j = layer >> 1; (void)j; int bx = (int)blockIdx.x; asm volatile("" : "+s"(bx)); (void)bx; F.ws = ws; F.out = outl; { const int G_ = F.G; F.vcu = (G_ % 8 == 0) ? (bx % 8) * (G_ / 8) + bx / 8 : bx; } { const int t_ = make_tid(wave0); F.tid = t_; F.lane = t_ & 63; F.wave = __builtin_amdgcn_readfirstlane(t_ >> 6); }
    for (int u = F.tid; u < (LDS_BYTES - LDSCTL_OFF) / 4; u += NWAVES * 64) ((LAS unsigned*)(F.lds + LDSCTL_OFF))[u] = 0u;
    __syncthreads();
    const int lo = args.ph_lo, hi = args.ph_hi;
    XcdBarrier bar = xcd_barrier_post((unsigned*)(ws0 + WS_CTL) + CW_BAR, (volatile LAS unsigned*)(F.lds + MISC_OFF) + 8, F.tid);
    int ph = 0;
#define IN_PH() (lo <= ph && ph < hi)
#ifndef ONLY_SITE
#define SITE(k) true
#else
#define SITE(k) ((k) == ONLY_SITE)
#endif
#define REPS(k) ((((unsigned long long)(PROBE_MASK)) >> (k)) & 1ull ? 2 : 1)
#define END_PH() do { if (lo <= ph && ph + 1 < hi) xcd_barrier(bar, make_tid(wave0)); ++ph; } while (0)

#ifndef SKIP_P0
    if (IN_PH() && SITE(1)) for (int rep_ = 0; rep_ < REPS(1); ++rep_) { PH_LOCALS; p0_prologue(F); }
#endif
    END_PH();
    if (IN_PH() && SITE(2)) for (int rep_ = 0; rep_ < REPS(2); ++rep_) { PH_LOCALS;
        { pg8::Gemm g{(const bf16_t*)(ws + WS_PB), (const bf16_t*)(ws + WS_W_PROJ), DPLE, DPLE, DPLE}; pg8::Sched S; S.init(4 * MT / 256, 4, F.G, bx, DPLE, DPLE);
          S.b_pm_mul = pg8::Sched::rmul(MT / 256); S.b_pm_bytes = (long)1024 * DPLE * 2;
          pg8::EpiBf16G<false> E{(bf16_t*)(ws + WS_PP), D, nullptr, 0};
          pg8::gemm_phase(F.lds, g, S, E, F.tid); }
    }
    END_PH();
    if (IN_PH() && SITE(21)) for (int rep_ = 0; rep_ < REPS(21); ++rep_) { PH_LOCALS;
        load_b1p(F);
        { pg8::Gemm g{(const bf16_t*)(ws + WS_CS), (const bf16_t*)(ws + WS_W_CMP1), 1024, 2048, 2048}; pg8::Sched S; S.init(512, 1, F.G, bx, 1024, 2048);
          S.b_pm_mul = pg8::Sched::rmul(128); S.b_pm_bytes = (long)256 * 2048 * 2;
          pg8::EpiBf16G<true> E{(bf16_t*)(ws + WS_HIDS), 256, (const LAS float*)(F.lds + LDS_B1P_OFF), 7};
          pg8::gemm_phase(F.lds, g, S, E, F.tid); }
    }
    END_PH();
    if (IN_PH() && SITE(3)) for (int rep_ = 0; rep_ < REPS(3); ++rep_) { PH_LOCALS; cmp_stage2(F, (const bf16_t*)(ws + WS_HIDS), (const bf16_t*)(ws + WS_W_CMP2), 32768, 131072, (bf16_t*)(ws + WS_KCS)); }
    END_PH();

    for (layer0 = 0; layer0 < DEPTH; ++layer0) {
        if ((layer0 & 1) == 0) {
            if (IN_PH() && SITE(4)) for (int rep_ = 0; rep_ < REPS(4); ++rep_) { PH_LOCALS;
                pg8::Gemm g{(const bf16_t*)(ws + WS_XB), (const bf16_t*)(ws + WS_W_NSA_IN) + (size_t)j * NSA_NP * 1024, D, D, D}; pg8::Sched S; S.init(MT / 256, NSA_NP / 256, F.G, bx, D, D);
                pg8::EpiNsaIn E{(bf16_t*)(ws + WS_QB), (bf16_t*)(ws + WS_KV6), (bf16_t*)(ws + WS_KVS), (float*)(ws + WS_G32), F.out, j};
                pg8::gemm_phase(F.lds, g, S, E, F.tid);
            }
            END_PH();
            if (IN_PH() && SITE(5)) for (int rep_ = 0; rep_ < REPS(5); ++rep_) { PH_LOCALS;
                load_b1p(F);
                pg8::Gemm g{(const bf16_t*)(ws + WS_KV6), (const bf16_t*)(ws + WS_W_CMP1) + (size_t)j * 2 * 256 * 2048, 1024, 2048, 2048}; pg8::Sched S; S.init(16, 1, F.G, bx, 1024, 2048);
                S.b_pm_mul = pg8::Sched::rmul(8); S.b_pm_bytes = (long)256 * 2048 * 2;
                pg8::EpiBf16G<true> E{(bf16_t*)(ws + WS_HIDP), 256, (const LAS float*)(F.lds + LDS_B1P_OFF) + j * 512, 3};
                pg8::gemm_phase(F.lds, g, S, E, F.tid);
            }
            END_PH();
            if (IN_PH() && SITE(6)) for (int rep_ = 0; rep_ < REPS(6); ++rep_) { PH_LOCALS; cmp_stage2(F, (const bf16_t*)(ws + WS_HIDP), (const bf16_t*)(ws + WS_W_CMP2) + (size_t)j * 2 * 64 * 256, 2048, 4096, (bf16_t*)(ws + WS_KCP)); }
            END_PH();
            if (IN_PH() && SITE(7)) for (int rep_ = 0; rep_ < REPS(7); ++rep_) { PH_LOCALS;
                for (int it = F.vcu; it < 1024; it += F.G) { const int k = it >> 8, a16 = (it >> 4) & 15, bg = it & 15;
                    const int qblk = k == 0 ? 63 - a16 : k == 1 ? 32 + a16 : k == 2 ? 31 - a16 : a16;
                    att::nsa_prompt_item(F.lds, bg >> 1, qblk, bg & 1, (const bf16_t*)(ws + WS_QB), (const bf16_t*)(ws + WS_KV6), (const bf16_t*)(ws + WS_KCP), (const float*)(ws + WS_G32), (bf16_t*)(ws + WS_OB), F.tid); }
            }
            END_PH();
            if (IN_PH() && SITE(22)) for (int rep_ = 0; rep_ < REPS(22); ++rep_) { PH_LOCALS;
                for (int q = F.vcu; q < 256; q += F.G)
                    att::nsa_sample_item(F.lds, q >> 1, q & 1, j, (const bf16_t*)(ws + WS_QB), (const bf16_t*)(ws + WS_KVS), (const bf16_t*)(ws + WS_KCS), (const float*)(ws + WS_G32),
                                         (const float*)in_ptr(2), (const float*)in_ptr(3), (const int*)in_ptr(7), (bf16_t*)(ws + WS_OB), F.tid);
            }
            END_PH();
            if (IN_PH() && SITE(8)) for (int rep_ = 0; rep_ < REPS(8); ++rep_) { PH_LOCALS;
                pg8::Gemm g{(const bf16_t*)(ws + WS_OB), (const bf16_t*)(ws + WS_W_NSA_OUT) + (size_t)j * D * D, D, D, D}; pg8::Sched S; S.init(MT / 256, 4, F.G, bx, D, D);
                pg8::EpiResid E{(const float*)(ws + WS_X32), (float*)(ws + WS_PRE)};
                pg8::gemm_phase(F.lds, g, S, E, F.tid);
            }
            END_PH();
        } else {
            if (IN_PH() && SITE(9)) for (int rep_ = 0; rep_ < REPS(9); ++rep_) { PH_LOCALS;
                pg8::Gemm g{(const bf16_t*)(ws + WS_XB), (const bf16_t*)(ws + WS_W_RG_IN) + (size_t)j * 2048 * D, D, D, D}; pg8::Sched S; S.init(MT / 256, 8, F.G, bx, D, D);
                pg8::EpiRgIn E{(bf16_t*)(ws + WS_GG), (bf16_t*)(ws + WS_RECB), F.out, j};
                pg8::gemm_phase(F.lds, g, S, E, F.tid);
            }
            END_PH();
            if (IN_PH() && SITE(10)) for (int rep_ = 0; rep_ < REPS(10); ++rep_) { PH_LOCALS; rg_conv_phase(F, (const bf16_t*)(ws + WS_RECB), (const float*)in_ptr(17) + (size_t)j * 4 * D, (const float*)in_ptr(18) + (size_t)j * D,
                                         (const float*)in_ptr(5) + (size_t)j * DECB * 3 * D, (bf16_t*)(ws + WS_REC)); }
            END_PH();
            if (IN_PH() && SITE(11)) for (int rep_ = 0; rep_ < REPS(11); ++rep_) { PH_LOCALS;
                pg8::Gemm g{(const bf16_t*)(ws + WS_REC), (const bf16_t*)(ws + WS_W_RG_G) + (size_t)j * 8 * 256 * 256, D, 256, 256}; pg8::Sched S; S.init(MT / 256, 8, F.G, bx, D, 256);
                S.a_pn_mul = pg8::Sched::rmul(2); S.a_pn_bytes = 256 * 2;
                pg8::EpiRgGate E{(const bf16_t*)(ws + WS_REC), (const float*)in_ptr(20) + (size_t)j * D, (const float*)in_ptr(22) + (size_t)j * D, (const float*)(ws + WS_SPT) + (size_t)j * D, (float*)(ws + WS_AA), (float*)(ws + WS_UU)};
                pg8::gemm_phase(F.lds, g, S, E, F.tid);
            }
            END_PH();
            if (IN_PH() && SITE(12)) for (int rep_ = 0; rep_ < REPS(12); ++rep_) { PH_LOCALS; scan1_phase(F, (const float*)(ws + WS_AA), (const float*)(ws + WS_UU), (float*)(ws + WS_CA), (float*)(ws + WS_CH)); }
            END_PH();
            if (IN_PH() && SITE(13)) for (int rep_ = 0; rep_ < REPS(13); ++rep_) { PH_LOCALS; scan2_phase(F, (const float*)(ws + WS_AA), (const float*)(ws + WS_UU), (const float*)(ws + WS_CA), (const float*)(ws + WS_CH), (const bf16_t*)(ws + WS_GG), (bf16_t*)(ws + WS_HG),
                                       (const float*)in_ptr(4) + (size_t)j * DECB * D, F.out, j); }
            END_PH();
            if (IN_PH() && SITE(14)) for (int rep_ = 0; rep_ < REPS(14); ++rep_) { PH_LOCALS;
                pg8::Gemm g{(const bf16_t*)(ws + WS_HG), (const bf16_t*)(ws + WS_W_RG_OUT) + (size_t)j * D * D, D, D, D}; pg8::Sched S; S.init(MT / 256, 4, F.G, bx, D, D);
                pg8::EpiResid E{(const float*)(ws + WS_X32), (float*)(ws + WS_PRE)};
                pg8::gemm_phase(F.lds, g, S, E, F.tid);
            }
            END_PH();
        }
        if (IN_PH() && SITE(15)) for (int rep_ = 0; rep_ < REPS(15); ++rep_) { PH_LOCALS; ln_phase(F, (const float*)(ws + WS_PRE), (const float*)in_ptr(29) + (size_t)layer * D, (const float*)in_ptr(30) + (size_t)layer * D, (float*)(ws + WS_H32), (bf16_t*)(ws + WS_HB)); }
        END_PH();
        if (IN_PH() && SITE(16)) for (int rep_ = 0; rep_ < REPS(16); ++rep_) { PH_LOCALS;
            pg8::Gemm g{(const bf16_t*)(ws + WS_HB), (const bf16_t*)(ws + WS_W_UP) + (size_t)layer * 6144 * D, D, D, D}; pg8::Sched S; S.init(MT / 256, 24, F.G, bx, D, D);
            pg8::EpiUp E{(bf16_t*)(ws + WS_U), F.out, layer};
            pg8::gemm_phase(F.lds, g, S, E, F.tid);
        }
        END_PH();
        if (IN_PH() && SITE(17)) for (int rep_ = 0; rep_ < REPS(17); ++rep_) { PH_LOCALS; ffn_conv_phase(F, (const bf16_t*)(ws + WS_U), (const float*)in_ptr(26) + (size_t)layer * 3 * 6144, (const float*)in_ptr(27) + (size_t)layer * 6144,
                                      (const float*)in_ptr(6) + (size_t)layer * DECB * 2 * 6144, (bf16_t*)(ws + WS_ACT)); }
        END_PH();
        if (IN_PH() && SITE(18)) for (int rep_ = 0; rep_ < REPS(18); ++rep_) { PH_LOCALS;
            pg8::Gemm g{(const bf16_t*)(ws + WS_ACT), (const bf16_t*)(ws + WS_W_DOWN) + (size_t)layer * D * DFF, DFF, DFF, DFF}; pg8::Sched S; S.init(MT / 256, 4, F.G, bx, DFF, DFF);
            pg8::EpiResid E{(const float*)(ws + WS_H32), (float*)(ws + WS_PRE)};
            pg8::gemm_phase(F.lds, g, S, E, F.tid);
        }
        END_PH();
        if (IN_PH() && SITE(19)) for (int rep_ = 0; rep_ < REPS(19); ++rep_) { PH_LOCALS; ln_phase(F, (const float*)(ws + WS_PRE), (const float*)in_ptr(31) + (size_t)layer * D, (const float*)in_ptr(32) + (size_t)layer * D, (float*)(ws + WS_H32), (bf16_t*)(ws + WS_HB)); }
        END_PH();
        if (IN_PH() && SITE(20)) for (int rep_ = 0; rep_ < REPS(20); ++rep_) { PH_LOCALS;
            pg8::Gemm g{(const bf16_t*)(ws + WS_HB), (const bf16_t*)(ws + WS_W_GATE) + (size_t)layer * D * D, D, D, D}; pg8::Sched S; S.init(MT / 256, 4, F.G, bx, D, D);
            pg8::EpiPle E{(const float*)(ws + WS_H32), (const bf16_t*)(ws + WS_PP) + (size_t)layer * MT * D, (float*)(ws + WS_X32), (bf16_t*)(ws + WS_XB), F.out, layer == DEPTH - 1 ? 1 : 0};
            pg8::gemm_phase(F.lds, g, S, E, F.tid);
        }
        END_PH();
    }
}

extern "C" void kernel_launch(void* const* d_in, const int* in_sizes, int n_in, void* d_out, int out_size, void* d_ws, size_t ws_size, hipStream_t stream) {
    static int grid = 0;
    if (grid == 0) {
        if (n_in != 35 || (size_t)out_size != O_END || ws_size < WS_END) { fprintf(stderr, "kernel_launch: unexpected problem (n_in %d, out %d, ws %zu need %zu)\n", n_in, out_size, ws_size, (size_t)WS_END); grid = -1; return; }
        int dev = 0, cus = 0, per_cu = 0;
        if (hipGetDevice(&dev) != hipSuccess || hipDeviceGetAttribute(&cus, hipDeviceAttributeMultiprocessorCount, dev) != hipSuccess) { grid = -1; return; }
        if (hipFuncSetAttribute((const void*)mega_fwd, hipFuncAttributeMaxDynamicSharedMemorySize, LDS_BYTES) != hipSuccess) { fprintf(stderr, "kernel_launch: hipFuncSetAttribute failed\n"); grid = -1; return; }
        if (hipOccupancyMaxActiveBlocksPerMultiprocessor(&per_cu, (const void*)mega_fwd, NWAVES * 64, LDS_BYTES) != hipSuccess || per_cu < 1)
            fprintf(stderr, "kernel_launch: occupancy query reports %d blocks per CU\n", per_cu);
        (void)hipGetLastError();
        grid = cus;
    }
    if (grid < 0) return;
    hipMemsetAsync((char*)d_ws + WS_CTL, 0, CTL_ZERO_BYTES, stream);
    Args a{};
    for (int i = 0; i < 35; ++i) a.in[i] = d_in[i];
    a.out = (float*)d_out; a.ws = (unsigned char*)d_ws;
#if MK_ONE_LAUNCH
    a.ph_lo = 0; a.ph_hi = N_PHASES;
    hipLaunchKernelGGL(mega_fwd, dim3(grid), dim3(NWAVES * 64), LDS_BYTES, stream, a);
#else
    for (int p = 0; p < N_PHASES; ++p) { a.ph_lo = p; a.ph_hi = p + 1; hipLaunchKernelGGL(mega_fwd, dim3(grid), dim3(NWAVES * 64), LDS_BYTES, stream, a); }
#endif
}
```

```cpp
#include <hip/hip_runtime.h>
#include <cstdio>
#include <cstdint>

#ifndef MK_ONE_LAUNCH
#define MK_ONE_LAUNCH 1
#endif
#ifndef PROBE_MASK
#define PROBE_MASK 0ull
#endif

#define LAS __attribute__((address_space(3)))
#define GAS __attribute__((address_space(1)))
typedef unsigned short bf16_t;
typedef short bf16x8 __attribute__((ext_vector_type(8)));
typedef short s16x4 __attribute__((ext_vector_type(4)));
typedef float f32x4 __attribute__((ext_vector_type(4)));
typedef float f32x2 __attribute__((ext_vector_type(2)));
typedef float f32x16 __attribute__((ext_vector_type(16)));
typedef unsigned u32x4 __attribute__((ext_vector_type(4)));
typedef unsigned u32x2 __attribute__((ext_vector_type(2)));

constexpr int D = 1024, BATCH = 8, SEQ = 2048, DEPTH = 4, DECB = 128, DECS = 4, PAST = 2048, PAGE = 128;
constexpr int MP = BATCH * SEQ, MS = DECB * DECS, MT = MP + MS;
constexpr int NPOOL = 2560, NPAGES = 16;
constexpr int DFF = 3072, DPLE = 256;
constexpr int NSA_N = 1840, NSA_NP = 2048;
constexpr float ALPHA = 1.6817928305074290f;
constexpr float LN_EPS = 1e-5f;
constexpr float QSCALE = 0.125f * 1.4426950408889634f;

constexpr size_t O_YP = 0;
constexpr size_t O_YS = O_YP + (size_t)MP * D;
constexpr size_t O_KVP = O_YS + (size_t)MS * D;
constexpr size_t O_KVS = O_KVP + (size_t)2 * MP * 512;
constexpr size_t O_WINP = O_KVS + (size_t)2 * MS * 512;
constexpr size_t O_WINS = O_WINP + (size_t)2 * BATCH * 512 * 256;
constexpr size_t O_HP = O_WINS + (size_t)2 * DECB * 512 * 256;
constexpr size_t O_HS = O_HP + (size_t)2 * BATCH * D;
constexpr size_t O_RCP = O_HS + (size_t)2 * DECB * D;
constexpr size_t O_RCS = O_RCP + (size_t)2 * BATCH * 3 * D;
constexpr size_t O_FCP = O_RCS + (size_t)2 * DECB * 3 * D;
constexpr size_t O_FCS = O_FCP + (size_t)4 * BATCH * 2 * 6144;
constexpr size_t O_END = O_FCS + (size_t)4 * DECB * 2 * 6144;
static_assert(O_END == 78053376, "output size");

constexpr size_t MiB = 1u << 20;
constexpr size_t WS_CTL = 0, CTL_ZERO_BYTES = 1 * MiB;
constexpr size_t WS_W_NSA_IN = 2 * MiB;
constexpr size_t WS_W_NSA_OUT = WS_W_NSA_IN + 8 * MiB;
constexpr size_t WS_W_CMP1 = WS_W_NSA_OUT + 4 * MiB;
constexpr size_t WS_W_CMP2 = WS_W_CMP1 + 4 * MiB;
constexpr size_t WS_W_RG_IN = WS_W_CMP2 + 1 * MiB;
constexpr size_t WS_W_RG_G = WS_W_RG_IN + 8 * MiB;
constexpr size_t WS_W_RG_OUT = WS_W_RG_G + 2 * MiB;
constexpr size_t WS_W_UP = WS_W_RG_OUT + 4 * MiB;
constexpr size_t WS_W_DOWN = WS_W_UP + 48 * MiB;
constexpr size_t WS_W_PROJ = WS_W_DOWN + 24 * MiB;
constexpr size_t WS_W_GATE = WS_W_PROJ + 2 * MiB;
constexpr size_t WS_B1PART = WS_W_GATE + 8 * MiB;
constexpr size_t WS_X32 = WS_B1PART + 1 * MiB;
constexpr size_t WS_XB = WS_X32 + 66 * MiB;
constexpr size_t WS_PB = WS_XB + 33 * MiB;
constexpr size_t WS_PBS = WS_PB + 32 * MiB;
constexpr size_t WS_PP = WS_PB + 33 * MiB;
constexpr size_t WS_PPS = WS_PP + 128 * MiB;
constexpr size_t WS_CS = WS_PP + 132 * MiB;
constexpr size_t WS_HIDS = WS_CS + 257 * MiB;
constexpr size_t WS_KCS = WS_HIDS + 64 * MiB;
constexpr size_t WS_QB = WS_KCS + 16 * MiB;
constexpr size_t WS_KV6 = WS_QB + 33 * MiB;
constexpr size_t WS_KVS = WS_KV6 + 25 * MiB;
constexpr size_t WS_G32 = WS_KVS + 1 * MiB;
constexpr size_t WS_HIDP = WS_G32 + 4 * MiB;
constexpr size_t WS_KCP = WS_HIDP + 2 * MiB;
constexpr size_t WS_OB = WS_KCP + 1 * MiB;
constexpr size_t WS_PRE = WS_OB + 33 * MiB;
constexpr size_t WS_H32 = WS_PRE + 66 * MiB;
constexpr size_t WS_HB = WS_H32 + 66 * MiB;
constexpr size_t WS_U = WS_HB + 33 * MiB;
constexpr size_t WS_ACT = WS_U + 198 * MiB;
constexpr size_t WS_GG = WS_ACT + 99 * MiB;
constexpr size_t WS_RECB = WS_GG + 33 * MiB;
constexpr size_t WS_REC = WS_RECB + 33 * MiB;
constexpr size_t WS_AA = WS_REC + 33 * MiB;
constexpr size_t WS_UU = WS_AA + 66 * MiB;
constexpr size_t WS_CA = WS_UU + 66 * MiB;
constexpr size_t WS_CH = WS_CA + 1 * MiB;
constexpr size_t WS_HG = WS_CH + 1 * MiB;
constexpr size_t WS_SPT = WS_HG + 33 * MiB;
constexpr size_t WS_END = WS_SPT + 1 * MiB;

constexpr int CW_BAR = 4096;

constexpr int RING_BYTES = 131072;
constexpr int LDSCTL_OFF = RING_BYTES, MISC_OFF = LDSCTL_OFF + 320;
constexpr int LDS_B1P_OFF = RING_BYTES + 1024;
constexpr int LDS_BYTES = 147456;
constexpr int NWAVES = 8;

__device__ __forceinline__ unsigned f2bf(float f) { unsigned u = __builtin_bit_cast(unsigned, f); return (u + 0x7fffu + ((u >> 16) & 1u)) >> 16; }
__device__ __forceinline__ unsigned pk2(float lo, float hi) { return f2bf(lo) | (f2bf(hi) << 16); }
__device__ __forceinline__ float bf2f(unsigned short h) { return __builtin_bit_cast(float, (unsigned)h << 16); }
__device__ __forceinline__ float bflo(unsigned w) { return __builtin_bit_cast(float, w << 16); }
__device__ __forceinline__ float bfhi(unsigned w) { return __builtin_bit_cast(float, w & 0xffff0000u); }
__device__ __forceinline__ float sigm(float x) { return 1.f / (1.f + __expf(-x)); }
__device__ __forceinline__ float gelu_t(float x) { const float u = 0.7978845608028654f * (x + 0.044715f * x * x * x); return x / (1.f + __expf(-2.f * u)); }
__device__ __forceinline__ float ex2(float x) { return __builtin_amdgcn_exp2f(x); }
__device__ __forceinline__ void unpack8(const u32x4& w, float (&f)[8]) { f[0] = bflo(w.x); f[1] = bfhi(w.x); f[2] = bflo(w.y); f[3] = bfhi(w.y); f[4] = bflo(w.z); f[5] = bfhi(w.z); f[6] = bflo(w.w); f[7] = bfhi(w.w); }
__device__ __forceinline__ int make_tid(int wave) { unsigned ones = ~0u; asm volatile("" : "+s"(ones)); asm volatile("" : "+s"(wave)); return wave * 64 + (int)__builtin_amdgcn_mbcnt_hi(ones, __builtin_amdgcn_mbcnt_lo(ones, 0u)); }
#define LDS_WAIT() asm volatile("s_waitcnt lgkmcnt(0)" ::: "memory")
#define VM_WAIT() asm volatile("s_waitcnt vmcnt(0)" ::: "memory")

namespace pg8 {
constexpr int BM = 256, BK = 64, HALF = 128, HTB = HALF * BK * 2, STAGE_BYTES = 8 * HTB, NXCD = 8, WGM = 8;
__host__ __device__ __forceinline__ int lds_byte(int r, int c) { const int st = (r >> 4) * 2 + (c >> 5), rr = r & 15, cc = c & 31, ob = rr * 64 + cc * 2; return st * 1024 + (ob ^ (((ob >> 9) & 1) << 5)); }
__host__ __device__ __forceinline__ void stage_rc(int b, int& R, int& C) { const int st = b / 1024, sb = b % 1024, swz = sb ^ (((sb >> 9) & 1) << 5); R = (st >> 1) * 16 + swz / 64; C = (st & 1) * 32 + (swz % 64) / 2; }
__host__ __device__ __forceinline__ int perm32(int rho) { const int n = rho >> 4, i = rho & 15; return 8 * (i >> 2) + 4 * n + (i & 3); }

struct Unit { int pm, pn; long aoff, boff; };
struct Gemm { const bf16_t* A; const bf16_t* Bt; int lda, ldb, K; };

struct Sched {
    int nM, nN, nwg, G, c;
    long a_tile, b_tile;
    int a_pn_mul; long a_pn_bytes;
    int b_pm_mul; long b_pm_bytes;
    __device__ void init(int nM_, int nN_, int G_, int c_, int lda, int ldb) {
        nM = nM_; nN = nN_; nwg = nM * nN; G = G_; c = c_; a_tile = (long)BM * lda * 2; b_tile = (long)BM * ldb * 2;
        a_pn_mul = 0; a_pn_bytes = 0; b_pm_mul = 0; b_pm_bytes = 0; }
    __device__ static constexpr int rmul(int div) { return (65536 + div - 1) / div; }
    __device__ bool next(int i, Unit& u) const {
        const long L = (long)i * G + c; if (L >= nwg) return false;
        int wgid = (int)L; { const int q = nwg / NXCD, r = nwg % NXCD, xcd = wgid % NXCD, off = wgid / NXCD; wgid = (xcd < r ? xcd * (q + 1) : r * (q + 1) + (xcd - r) * q) + off; }
        const int nig = WGM * nN, gid = wgid / nig, fm = gid * WGM, gsz = (nM - fm) < WGM ? (nM - fm) : WGM;
        u.pm = fm + ((wgid % nig) % gsz); u.pn = (wgid % nig) / gsz;
        u.aoff = (long)u.pm * a_tile + (long)((u.pn * a_pn_mul) >> 16) * a_pn_bytes; u.boff = (long)u.pn * b_tile + (long)((u.pm * b_pm_mul) >> 16) * b_pm_bytes;
        return true; }
};

template <class Epi>
__device__ __forceinline__ void gemm_phase(LAS unsigned char* lds, const Gemm g, const Sched& S, const Epi& E, int tid_in) {
    const int tid = tid_in, wid = __builtin_amdgcn_readfirstlane(tid >> 6), lane = tid & 63, wr = wid >> 2, wc = wid & 3, fr = lane & 15, fq = lane >> 4;
    int K_ = g.K; asm volatile("" : "+s"(K_));
    const int K = K_, nt = K / BK;
    unsigned voffA, voffB;
    { int R, C; stage_rc(tid * 16, R, C); const int Rb = (R & ~31) + perm32(R & 31); voffA = (unsigned)(R * g.lda + C) * 2u; voffB = (unsigned)(Rb * g.ldb + C) * 2u; }
    const size_t piecevoffA = (size_t)64 * g.lda * 2, piecevoffB = (size_t)64 * g.ldb * 2;
    const size_t kstep = (size_t)(BK * 2);
    const size_t hstepA = (size_t)HALF * g.lda * 2, hstepB = (size_t)HALF * g.ldb * 2;
    const unsigned ldsw = (unsigned)wid * 1024u;
    const int aoff = lds_byte(wr * 64 + fr, fq * 8), boff = lds_byte(wc * 32 + fr, fq * 8);
#define PG8_SA(b, h) (((b) * 2 + (h)) * HTB)
#define PG8_SB(b, h) ((4 + (b) * 2 + (h)) * HTB)
#define PG8_STAGE_(bufoff, gbase, voff, piece) do { \
        __builtin_amdgcn_global_load_lds((const unsigned*)((const char*)(gbase) + (voff)), (LAS unsigned*)(lds + (bufoff) + ldsw), 16, 0, 0); \
        __builtin_amdgcn_global_load_lds((const unsigned*)((const char*)(gbase) + (piece) + (voff)), (LAS unsigned*)(lds + (bufoff) + ldsw + 8192), 16, 0, 0); } while (0)
#define PG8_STAGE(bufoff, gbase, voff) PG8_STAGE_(bufoff, gbase, voff, piece##voff)
#define PG8_LDA(dst, b, h) do { _Pragma("unroll") for (int m = 0; m < 4; ++m) _Pragma("unroll") for (int k = 0; k < 2; ++k) dst[m][k] = *(const LAS bf16x8*)(lds + PG8_SA(b, h) + aoff + m * 2048 + k * 1024); } while (0)
#define PG8_LDB(dst, b, h) do { _Pragma("unroll") for (int n = 0; n < 2; ++n) _Pragma("unroll") for (int k = 0; k < 2; ++k) dst[n][k] = *(const LAS bf16x8*)(lds + PG8_SB(b, h) + boff + n * 2048 + k * 1024); } while (0)
#define PG8_MMA(ai, bj, At, Bt) do { __builtin_amdgcn_s_setprio(1); _Pragma("unroll") for (int m = 0; m < 4; ++m) _Pragma("unroll") for (int n = 0; n < 2; ++n) _Pragma("unroll") for (int k = 0; k < 2; ++k) \
        acc[ai][bj][m][n] = __builtin_amdgcn_mfma_f32_16x16x32_bf16(Bt[n][k], At[m][k], acc[ai][bj][m][n], 0, 0, 0); __builtin_amdgcn_s_setprio(0); } while (0)
#define PG8_WAIT_V(n) asm volatile("s_waitcnt vmcnt(" #n ")" ::: "memory")
#define PG8_WAIT_L(n) asm volatile("s_waitcnt lgkmcnt(" #n ")" ::: "memory")
#define PG8_BAR __builtin_amdgcn_s_barrier()
#define PG8_SCHED __builtin_amdgcn_sched_barrier(0)
    Unit cur, nxt; int ui = 0;
    if (!S.next(0, cur)) return;
    f32x4 acc[2][2][4][2];
#pragma unroll
    for (int a = 0; a < 2; ++a)
#pragma unroll
        for (int b = 0; b < 2; ++b)
#pragma unroll
            for (int m = 0; m < 4; ++m)
#pragma unroll
                for (int n = 0; n < 2; ++n) acc[a][b][m][n] = (f32x4){0.f, 0.f, 0.f, 0.f};
    bf16x8 At[4][2], B0[2][2], B1[2][2];
    const char* cA = (const char*)g.A + cur.aoff; const char* cB = (const char*)g.Bt + cur.boff;
    PG8_STAGE(PG8_SB(0, 0), cB, voffB); PG8_STAGE(PG8_SB(0, 1), cB + hstepB, voffB); PG8_STAGE(PG8_SA(0, 0), cA, voffA); PG8_STAGE(PG8_SA(0, 1), cA + hstepA, voffA);
    if (wr == 1) PG8_BAR;
    PG8_WAIT_V(2); PG8_BAR;
    PG8_STAGE(PG8_SB(1, 0), cB + kstep, voffB); PG8_STAGE(PG8_SA(1, 0), cA + kstep, voffA); PG8_STAGE(PG8_SB(1, 1), cB + hstepB + kstep, voffB);
    PG8_WAIT_V(6); PG8_BAR;
    for (;;) {
        const bool has_next = S.next(ui + 1, nxt);
        const char* nA = has_next ? (const char*)g.A + nxt.aoff : cA; const char* nB = has_next ? (const char*)g.Bt + nxt.boff : cB;
        for (int t = 0; t < nt; t += 2) {
            const bool last = (t == nt - 2);
            const char* a1 = cA + (size_t)(t + 1) * kstep;
            const char* a2 = last ? nA : cA + (size_t)(t + 2) * kstep; const char* b2 = last ? nB : cB + (size_t)(t + 2) * kstep;
            const char* a3 = a2 + kstep; const char* b3 = b2 + kstep;
            PG8_LDB(B0, 0, 0); PG8_LDB(B1, 0, 1); PG8_SCHED; PG8_LDA(At, 0, 0); PG8_STAGE(PG8_SA(1, 1), a1 + hstepA, voffA);
            PG8_WAIT_V(8); PG8_WAIT_L(0); PG8_BAR; PG8_MMA(0, 0, At, B0); PG8_MMA(0, 1, At, B1); PG8_BAR; PG8_SCHED;
            PG8_LDA(At, 0, 1); PG8_STAGE(PG8_SB(0, 0), b2, voffB); PG8_STAGE(PG8_SB(0, 1), b2 + hstepB, voffB); PG8_STAGE(PG8_SA(0, 0), a2, voffA);
            PG8_WAIT_V(8); PG8_WAIT_L(0); PG8_BAR; PG8_MMA(1, 0, At, B0); PG8_MMA(1, 1, At, B1); PG8_BAR; PG8_SCHED;
            PG8_LDB(B0, 1, 0); PG8_LDB(B1, 1, 1); PG8_SCHED; PG8_LDA(At, 1, 0); PG8_STAGE(PG8_SA(0, 1), a2 + hstepA, voffA);
            PG8_WAIT_V(8); PG8_WAIT_L(0); PG8_BAR; PG8_MMA(0, 0, At, B0); PG8_MMA(0, 1, At, B1); PG8_BAR; PG8_SCHED;
            PG8_LDA(At, 1, 1); PG8_STAGE(PG8_SB(1, 0), b3, voffB); PG8_STAGE(PG8_SB(1, 1), b3 + hstepB, voffB); PG8_STAGE(PG8_SA(1, 0), a3, voffA);
            PG8_WAIT_V(8); PG8_WAIT_L(0); PG8_BAR; PG8_MMA(1, 0, At, B0); PG8_MMA(1, 1, At, B1); PG8_BAR; PG8_SCHED;
        }
        if (wr == 0) PG8_BAR;
        E(acc, cur, wr, wc, fr, fq);
        if (!has_next) break;
#pragma unroll
        for (int a = 0; a < 2; ++a)
#pragma unroll
            for (int b = 0; b < 2; ++b)
#pragma unroll
                for (int m = 0; m < 4; ++m)
#pragma unroll
                    for (int n = 0; n < 2; ++n) acc[a][b][m][n] = (f32x4){0.f, 0.f, 0.f, 0.f};
        cur = nxt; cA = nA; cB = nB; ++ui;
        if (wr == 1) PG8_BAR;
    }
    PG8_WAIT_V(0);
    PG8_BAR;
#undef PG8_SA
#undef PG8_SB
#undef PG8_STAGE
#undef PG8_STAGE_
#undef PG8_LDA
#undef PG8_LDB
#undef PG8_MMA
#undef PG8_WAIT_V
#undef PG8_WAIT_L
#undef PG8_BAR
#undef PG8_SCHED
}

__device__ __forceinline__ u32x4 pack8(const f32x4& v0, const f32x4& v1) { u32x4 w; w.x = pk2(v0[0], v0[1]); w.y = pk2(v0[2], v0[3]); w.z = pk2(v1[0], v1[1]); w.w = pk2(v1[2], v1[3]); return w; }
#define EPI_PIECES(...) \
    _Pragma("unroll") for (int ai = 0; ai < 2; ++ai) _Pragma("unroll") for (int m = 0; m < 4; ++m) { const int rowU = u.pm * BM + ai * HALF + m * 16; (void)rowU; \
        _Pragma("unroll") for (int bj = 0; bj < 2; ++bj) { const f32x4 v0 = acc[ai][bj][m][0], v1 = acc[ai][bj][m][1]; (void)v0; (void)v1; __VA_ARGS__ } \
        asm volatile("" ::: "memory"); }
#define ST_F32X8(ptr, a, b) do { *(f32x4*)(ptr) = (a); *(f32x4*)((ptr) + 16) = (b); } while (0)

template <bool BA> struct EpiBf16G {
    bf16_t* O; int ldc; const LAS float* bias; int bias_pm_shift;
    __device__ __forceinline__ void operator()(const f32x4 (&acc)[2][2][4][2], const Unit& u, int wr, int wc, int fr, int fq) const {
        const LAS float* bp0 = BA ? bias + (u.pm >> bias_pm_shift) * 256 + wc * 32 + 8 * fq : nullptr;
        const unsigned lo = (unsigned)(((wr * 64 + fr) * ldc + wc * 32 + 8 * fq) * 2);
        EPI_PIECES(
            char* op = (char*)O + ((size_t)rowU * ldc + u.pn * BM + bj * HALF) * 2;
            f32x4 a = v0; f32x4 b = v1;
            if (BA) { const LAS float* bp = bp0 + bj * HALF;
                _Pragma("unroll") for (int e = 0; e < 4; ++e) { a[e] = gelu_t(a[e] + bp[e]); b[e] = gelu_t(b[e] + bp[4 + e]); } }
            *(u32x4*)(op + lo) = pack8(a, b); )
    }
};

struct EpiNsaIn {
    bf16_t* QB; bf16_t* KV6; bf16_t* KVS; float* G32; float* out; int j;
    __device__ __forceinline__ void operator()(const f32x4 (&acc)[2][2][4][2], const Unit& u, int wr, int wc, int fr, int fq) const {
        const bool samp = u.pm >= MP / BM; const int rowL = wr * 64 + fr, colL = wc * 32 + 8 * fq;
        if (u.pn < 4) {
            const unsigned lo = (unsigned)((rowL * 1024 + colL) * 2);
            EPI_PIECES( char* op = (char*)QB + ((size_t)rowU * 1024 + u.pn * BM + bj * HALF) * 2; *(u32x4*)(op + lo) = pack8(v0 * QSCALE, v1 * QSCALE); )
        } else if (u.pn < 7) {
            const int gg = wc >> 1, d = (wc & 1) * 32 + 8 * fq;
            if (!samp) {
                const int b = u.pm >> 3; const bool wintail = (u.pm & 7) >= 6;
                const unsigned lo_kv = (unsigned)(((gg * 2048 + rowL) * 64 + d) * 2), lo_o = (unsigned)((rowL * 512 + colL) * 4), lo_w = (unsigned)((rowL * 256 + colL) * 4);
                EPI_PIECES(
                    const int kc0 = u.pn * BM + bj * HALF - 1024, comp = kc0 >> 7, tU = rowU & 2047;
                    char* kp = (char*)KV6 + ((size_t)((comp * 8 + b) * 2 * 2048 + tU) * 64) * 2; *(u32x4*)(kp + lo_kv) = pack8(v0, v1);
                    if (comp < 4) { char* op = (char*)(out + O_KVP) + ((size_t)((j * BATCH + b) * SEQ + tU) * 512 + kc0) * 4; ST_F32X8(op + lo_o, v0, v1); }
                    else if (wintail) { char* op = (char*)(out + O_WINP) + ((size_t)((j * BATCH + b) * 512 + (tU - (SEQ - 512))) * 256 + (kc0 - 512)) * 4; ST_F32X8(op + lo_w, v0, v1); } )
            } else {
                const unsigned lo_s = (unsigned)((rowL * 768 + colL) * 2), lo_o = (unsigned)((rowL * 512 + colL) * 4), lo_w = (unsigned)((((rowL >> 2) * 512 + (rowL & 3)) * 256 + colL) * 4);
                EPI_PIECES(
                    const int kc0 = u.pn * BM + bj * HALF - 1024, comp = kc0 >> 7, srU = rowU - MP;
                    char* sp = (char*)KVS + ((size_t)srU * 768 + kc0) * 2; *(u32x4*)(sp + lo_s) = pack8(v0, v1);
                    if (comp < 4) { char* op = (char*)(out + O_KVS) + ((size_t)(j * MS + srU) * 512 + kc0) * 4; ST_F32X8(op + lo_o, v0, v1); }
                    else { char* op = (char*)(out + O_WINS) + ((size_t)((j * DECB + (srU >> 2)) * 512 + 508) * 256 + (kc0 - 512)) * 4; ST_F32X8(op + lo_w, v0, v1); } )
            }
        } else {
            const unsigned lo = (unsigned)((rowL * 48 + colL) * 4);
            if (colL < 48) {
#pragma unroll
                for (int ai = 0; ai < 2; ++ai)
#pragma unroll
                    for (int m = 0; m < 4; ++m) { const int rowU = u.pm * BM + ai * HALF + m * 16; char* op = (char*)G32 + (size_t)rowU * 48 * 4;
                        f32x4 a = acc[ai][0][m][0], b = acc[ai][0][m][1];
#pragma unroll
                        for (int e = 0; e < 4; ++e) { a[e] = sigm(a[e]); b[e] = sigm(b[e]); }
                        ST_F32X8(op + lo, a, b); }
            }
        }
    }
};

struct EpiResid {
    const float* base; float* pre;
    __device__ __forceinline__ void operator()(const f32x4 (&acc)[2][2][4][2], const Unit& u, int wr, int wc, int fr, int fq) const {
        const unsigned lo = (unsigned)(((wr * 64 + fr) * D + wc * 32 + 8 * fq) * 4);
        EPI_PIECES(
            const size_t uo = ((size_t)rowU * D + u.pn * BM + bj * HALF) * 4; const char* bp = (const char*)base + uo; char* op = (char*)pre + uo;
            const f32x4 b0 = *(const f32x4*)(bp + lo), b1 = *(const f32x4*)(bp + lo + 16);
            ST_F32X8(op + lo, b0 * ALPHA + v0, b1 * ALPHA + v1); )
    }
};

struct EpiUp {
    bf16_t* U; float* out; int layer;
    __device__ __forceinline__ void operator()(const f32x4 (&acc)[2][2][4][2], const Unit& u, int wr, int wc, int fr, int fq) const {
        const bool samp = u.pm >= MP / BM; const int rowL = wr * 64 + fr, colL = wc * 32 + 8 * fq;
        const unsigned lo = (unsigned)((rowL * 6144 + colL) * 2);
        EPI_PIECES(
            const int ncU = bj * DFF + u.pn * 128;
            char* op = (char*)U + ((size_t)rowU * 6144 + ncU) * 2; *(u32x4*)(op + lo) = pack8(v0, v1);
            if (!samp) { if ((u.pm & 7) == 7 && ai == 1 && m == 3 && rowL >= 64 + 14) { const int b = u.pm >> 3, tt = rowL - (64 + 14);
                    float* o = out + O_FCP + ((size_t)(layer * BATCH + b) * 2 + tt) * 6144 + ncU + colL; ST_F32X8((char*)o, v0, v1); } }
            else { const int sr = rowU - MP + rowL, b = sr >> 2, s = sr & 3;
                if (s >= 2) { float* o = out + O_FCS + ((size_t)(layer * DECB + b) * 2 + (s - 2)) * 6144 + ncU + colL; ST_F32X8((char*)o, v0, v1); } } )
    }
};

struct EpiPle {
    const float* h2; const bf16_t* pp; float* x32; bf16_t* xb; float* out; int last;
    __device__ __forceinline__ void operator()(const f32x4 (&acc)[2][2][4][2], const Unit& u, int wr, int wc, int fr, int fq) const {
        const unsigned le = (unsigned)((wr * 64 + fr) * D + wc * 32 + 8 * fq);
        EPI_PIECES(
            const size_t ue = (size_t)rowU * D + u.pn * BM + bj * HALF;
            const char* hp = (const char*)h2 + ue * 4; const char* ppp = (const char*)pp + ue * 2;
            const f32x4 h0 = *(const f32x4*)(hp + le * 4), h1 = *(const f32x4*)(hp + le * 4 + 16); const u32x4 pw = *(const u32x4*)(ppp + le * 2);
            f32x4 r0; f32x4 r1;
            r0[0] = h0[0] + sigm(v0[0]) * bflo(pw.x); r0[1] = h0[1] + sigm(v0[1]) * bfhi(pw.x); r0[2] = h0[2] + sigm(v0[2]) * bflo(pw.y); r0[3] = h0[3] + sigm(v0[3]) * bfhi(pw.y);
            r1[0] = h1[0] + sigm(v1[0]) * bflo(pw.z); r1[1] = h1[1] + sigm(v1[1]) * bfhi(pw.z); r1[2] = h1[2] + sigm(v1[2]) * bflo(pw.w); r1[3] = h1[3] + sigm(v1[3]) * bfhi(pw.w);
            if (last) { char* op = (char*)(out + O_YP) + ue * 4; ST_F32X8(op + le * 4, r0, r1); }
            else { char* xp = (char*)x32 + ue * 4; ST_F32X8(xp + le * 4, r0, r1); char* bp = (char*)xb + ue * 2; *(u32x4*)(bp + le * 2) = pack8(r0, r1); } )
    }
};

struct EpiRgIn {
    bf16_t* GG; bf16_t* RECB; float* out; int j;
    __device__ __forceinline__ void operator()(const f32x4 (&acc)[2][2][4][2], const Unit& u, int wr, int wc, int fr, int fq) const {
        const bool samp = u.pm >= MP / BM; const int rowL = wr * 64 + fr, colL = wc * 32 + 8 * fq;
        const unsigned lo = (unsigned)((rowL * D + colL) * 2);
        if (u.pn < 4) {
            EPI_PIECES( char* op = (char*)GG + ((size_t)rowU * D + u.pn * BM + bj * HALF) * 2; f32x4 a = v0; f32x4 b = v1;
                _Pragma("unroll") for (int e = 0; e < 4; ++e) { a[e] = gelu_t(a[e]); b[e] = gelu_t(b[e]); }
                *(u32x4*)(op + lo) = pack8(a, b); )
        } else {
            EPI_PIECES(
                const int cU = (u.pn - 4) * BM + bj * HALF;
                char* op = (char*)RECB + ((size_t)rowU * D + cU) * 2; *(u32x4*)(op + lo) = pack8(v0, v1);
                if (!samp) { if ((u.pm & 7) == 7 && ai == 1 && m == 3 && rowL >= 64 + 13) { const int b = u.pm >> 3, tt = rowL - (64 + 13);
                        float* o = out + O_RCP + ((size_t)(j * BATCH + b) * 3 + tt) * D + cU + colL; ST_F32X8((char*)o, v0, v1); } }
                else { const int sr = rowU - MP + rowL, b = sr >> 2, s = sr & 3;
                    if (s >= 1) { float* o = out + O_RCS + ((size_t)(j * DECB + b) * 3 + (s - 1)) * D + cU + colL; ST_F32X8((char*)o, v0, v1); } } )
        }
    }
};

struct EpiRgGate {
    const bf16_t* REC; const float* ga_b; const float* gx_b; const float* spt; float* AA; float* UU;
    __device__ __forceinline__ void operator()(const f32x4 (&acc)[2][2][4][2], const Unit& u, int wr, int wc, int fr, int fq) const {
        const int cU = (u.pn >> 1) * 256 + (u.pn & 1) * 128, cL = wc * 32 + 8 * fq;
        const unsigned lo4 = (unsigned)(((wr * 64 + fr) * D + cL) * 4), lo2 = lo4 >> 1;
        float gab[8], gxb[8], sp[8];
#pragma unroll
        for (int e = 0; e < 8; ++e) { gab[e] = ga_b[cU + cL + e]; gxb[e] = gx_b[cU + cL + e]; sp[e] = spt[cU + cL + e]; }
        constexpr float L2E = 1.4426950408889634f;
#pragma unroll
        for (int ai = 0; ai < 2; ++ai)
#pragma unroll
            for (int m = 0; m < 4; ++m) { const size_t ue = (size_t)(u.pm * BM + ai * HALF + m * 16) * D + cU;
                float rec[8]; unpack8(*(const u32x4*)((const char*)REC + ue * 2 + lo2), rec);
                f32x4 av[2], uv[2];
#pragma unroll
                for (int e = 0; e < 8; ++e) { const float pa = acc[ai][0][m][e >> 2][e & 3] + gab[e], px = acc[ai][1][m][e >> 2][e & 3] + gxb[e];
                    const float r = __builtin_amdgcn_rcpf(1.f + ex2(-L2E * pa)), ig = __builtin_amdgcn_rcpf(1.f + ex2(-L2E * px));
                    const float t = sp[e] * r, a = ex2(t), a2 = ex2(2.f * t);
                    av[e >> 2][e & 3] = a; uv[e >> 2][e & 3] = __builtin_amdgcn_sqrtf(fmaxf(1.f - a2, 0.f)) * ig * rec[e]; }
                char* ap = (char*)AA + ue * 4; char* up = (char*)UU + ue * 4;
                ST_F32X8(ap + lo4, av[0], av[1]); ST_F32X8(up + lo4, uv[0], uv[1]);
                asm volatile("" ::: "memory"); }
    }
};
}


template <class EF>
__device__ __forceinline__ void sgemm(LAS unsigned char* lds, int tid_in, int vcu, int G, const bf16_t* A, int lda, int nrt, const bf16_t* Bt, int ldb, int K, int nct, EF ef) {
    int tid_ = tid_in; asm volatile("" : "+v"(tid_));
    const int tid = tid_, lane = tid & 63, w = __builtin_amdgcn_readfirstlane(tid >> 6), r32 = lane & 31, hi = lane >> 5;
    LAS float* part = (LAS float*)lds;
    const int kw = K >> 3, nsteps = kw >> 4;
    for (int task = vcu; task < nrt * nct; task += G) { const int rt = task % nrt, ct = task / nrt;
        const bf16_t* ap = A + (size_t)(32 * rt + r32) * lda + w * kw + 8 * hi;
        const bf16_t* bp = Bt + (size_t)(64 * ct + r32) * ldb + w * kw + 8 * hi;
        f32x16 acc0 = {0}, acc1 = {0};
        for (int s0 = 0; s0 < nsteps; s0 += 8) { bf16x8 af[8], b0[8], b1[8];
#pragma unroll
            for (int i = 0; i < 8; ++i) if (s0 + i < nsteps) { af[i] = *(const bf16x8*)(ap + 16 * (s0 + i)); b0[i] = *(const bf16x8*)(bp + 16 * (s0 + i)); b1[i] = *(const bf16x8*)(bp + (size_t)32 * ldb + 16 * (s0 + i)); }
#pragma unroll
            for (int i = 0; i < 8; ++i) if (s0 + i < nsteps) { acc0 = __builtin_amdgcn_mfma_f32_32x32x16_bf16(b0[i], af[i], acc0, 0, 0, 0); acc1 = __builtin_amdgcn_mfma_f32_32x32x16_bf16(b1[i], af[i], acc1, 0, 0, 0); } }
        LAS float* pr = part + (w * 32 + r32) * 64;
#pragma unroll
        for (int k4 = 0; k4 < 4; ++k4) {
            *(LAS f32x4*)(pr + (((2 * k4 + hi) ^ (r32 & 15)) << 2)) = (f32x4){acc0[4 * k4], acc0[4 * k4 + 1], acc0[4 * k4 + 2], acc0[4 * k4 + 3]};
            *(LAS f32x4*)(pr + (((8 + 2 * k4 + hi) ^ (r32 & 15)) << 2)) = (f32x4){acc1[4 * k4], acc1[4 * k4 + 1], acc1[4 * k4 + 2], acc1[4 * k4 + 3]}; }
        __syncthreads();
        { const int row = tid >> 4, c16 = tid & 15; f32x4 v = {0.f, 0.f, 0.f, 0.f};
#pragma unroll
          for (int ww = 0; ww < 8; ++ww) v += *(const LAS f32x4*)(part + (ww * 32 + row) * 64 + ((c16 ^ (row & 15)) << 2));
          ef(32 * rt + row, 64 * ct + 4 * c16, v); }
        __syncthreads();
    }
}
__device__ __forceinline__ u32x2 pack4(const f32x4& v) { u32x2 w; w.x = pk2(v[0], v[1]); w.y = pk2(v[2], v[3]); return w; }

#define XB_TMO      128
#define XB_XCNT(j)  (256  + 64 * (j))
#define XB_XSUB(j)  (1280 + 64 * (j))
#define XB_XGEN(j)  (2304 + 64 * (j))
#define XB_TOP      3328
#define XB_TOPGEN   3392
#define XCD_BAR_WORDS 3456
#define XB_SPIN_CAP (1u << 18)
__device__ __forceinline__ unsigned xb_ld(unsigned* p)              { return __hip_atomic_load(p, __ATOMIC_RELAXED, __HIP_MEMORY_SCOPE_AGENT); }
__device__ __forceinline__ unsigned xb_add(unsigned* p, unsigned v) { return __hip_atomic_fetch_add(p, v, __ATOMIC_RELAXED, __HIP_MEMORY_SCOPE_AGENT); }
__device__ __forceinline__ unsigned xb_xcc_id() { return (unsigned)__builtin_amdgcn_s_getreg((3 << 11) | 20) & 0xFu; }
#define XB_SPIN(cond, bar) do { unsigned _sp = 0; while (cond) { __builtin_amdgcn_s_sleep(1); \
    if ((++_sp & 255u) == 0u) { if (xb_ld(&(bar)[XB_TMO])) break; if (_sp > XB_SPIN_CAP) { atomicAdd(&(bar)[XB_TMO], 1u); break; } } } } while (0)
struct XcdBarrier { unsigned* bar; unsigned x; volatile LAS unsigned* st; };
__device__ __forceinline__ XcdBarrier xcd_barrier_post(unsigned* bar, volatile LAS unsigned* st, int tid) {
    XcdBarrier b; b.bar = bar; b.x = xb_xcc_id(); b.st = st;
    if (tid == 0) (void)xb_add(&bar[XB_XCNT(b.x)], 1u);
    return b;
}
__device__ __forceinline__ void xcd_barrier_complete(unsigned* bar, unsigned x, unsigned& nloc, unsigned& nx) {
    const unsigned G = gridDim.x * gridDim.y * gridDim.z;
    unsigned sum, cnt, mine, sp = 0u;
    for (;;) {
        sum = 0u; cnt = 0u; mine = 0u;
#pragma unroll
        for (unsigned j = 0; j < 16; ++j) { const unsigned c = xb_ld(&bar[XB_XCNT(j)]); sum += c; cnt += (c > 0u) ? 1u : 0u; mine = (j == x) ? c : mine; }
        if (sum == G) break;
        __builtin_amdgcn_s_sleep(1);
        if ((++sp & 255u) == 0u) { if (xb_ld(&bar[XB_TMO])) break; if (sp > XB_SPIN_CAP) { atomicAdd(&bar[XB_TMO], 1u); break; } }
    }
    nloc = mine > 0u ? mine : 1u; nx = cnt > 0u ? cnt : 1u;
}
__device__ __forceinline__ void xcd_barrier(const XcdBarrier& b, int tid) {
    asm volatile("s_waitcnt vmcnt(0)" ::: "memory");
    __syncthreads();
    if (tid == 0) {
        unsigned* bar = b.bar;
        __builtin_amdgcn_s_waitcnt(0);
        unsigned nloc = b.st[0], nx = b.st[1];
        if (nloc == 0u) { xcd_barrier_complete(bar, b.x, nloc, nx); b.st[0] = nloc; b.st[1] = nx; }
        const unsigned old = xb_add(&bar[XB_XSUB(b.x)], 1u);
        const unsigned gen = old / nloc;
        if (old + 1u == (gen + 1u) * nloc) {
            __builtin_amdgcn_fence(__ATOMIC_RELEASE, "agent");
            asm volatile("s_waitcnt vmcnt(0)" ::: "memory");
            const unsigned og = xb_add(&bar[XB_TOP], 1u);
            const unsigned tg = og / nx;
            if (og + 1u == (tg + 1u) * nx) xb_add(&bar[XB_TOPGEN], 1u);
            else XB_SPIN(xb_ld(&bar[XB_TOPGEN]) == tg, bar);
            __builtin_amdgcn_fence(__ATOMIC_ACQUIRE, "agent");
            xb_add(&bar[XB_XGEN(b.x)], 1u);
            asm volatile("s_waitcnt vmcnt(0)" ::: "memory");
        } else {
            XB_SPIN(xb_ld(&bar[XB_XGEN(b.x)]) == gen, bar);
            __builtin_amdgcn_fence(__ATOMIC_ACQUIRE, "agent");
            asm volatile("s_waitcnt vmcnt(0)" ::: "memory");
        }
    }
    __syncthreads();
}

struct Args { const void* in[35]; float* out; unsigned char* ws; int ph_lo, ph_hi; };
struct Frame {
    LAS unsigned char* lds; int tid, lane, wave, vcu, G;
    unsigned char* ws; float* out;
};
__device__ __forceinline__ float wave_sum(float v) {
#pragma unroll
    for (int o = 1; o < 64; o <<= 1) v += __shfl_xor(v, o);
    return v;
}

__device__ __forceinline__ const void* in_ptr(int k) {
    const void* const __attribute__((address_space(4)))* p = (const void* const __attribute__((address_space(4)))*)__builtin_amdgcn_kernarg_segment_ptr();
    asm volatile("" : "+s"(k));
    return p[k];
}
__device__ __forceinline__ void tr_item(const float* W, int ldw, int k0, int n_src0, int n_valid, bf16_t* WT, int ldt, int dst_row0, LAS float* scr, int lane) {
#pragma unroll 8
    for (int i = 0; i < 32; ++i) { const int kk = 2 * i + (lane >> 5), nn = lane & 31; scr[kk * 33 + nn] = (nn < n_valid) ? W[(size_t)(k0 + kk) * ldw + n_src0 + nn] : 0.f; }
    LDS_WAIT(); asm volatile("" ::: "memory");
    const int c = lane & 7;
#pragma unroll
    for (int jj = 0; jj < 4; ++jj) { const int n = (lane >> 3) + 8 * jj; const LAS float* s = scr + (8 * c) * 33 + n;
        u32x4 o; o.x = pk2(s[0 * 33], s[1 * 33]); o.y = pk2(s[2 * 33], s[3 * 33]); o.z = pk2(s[4 * 33], s[5 * 33]); o.w = pk2(s[6 * 33], s[7 * 33]);
        *(u32x4*)(WT + (size_t)(dst_row0 + n) * ldt + k0 + 8 * c) = o; }
    LDS_WAIT(); asm volatile("" ::: "memory");
}

__device__ __forceinline__ void p0_prologue(Frame& F) {
    unsigned char* ws = F.ws;
    LAS float* scr = (LAS float*)(F.lds + F.wave * 16384);
    const int gw = F.vcu * NWAVES + F.wave, NGW = F.G * NWAVES, lane = F.lane;
    constexpr int I_NSA_IN = 16 * 64, I_SQ = 16 * 32, I_CMP1 = 32 * 8, I_CMP2 = 4 * 2, I_RG_IN = 16 * 64, I_RG_G = 4 * 8, I_UP = 16 * 192, I_DOWN = 48 * 32, I_PROJ = 4 * 32;
    constexpr int NITEMS = 2 * I_NSA_IN + 2 * I_SQ + 4 * I_CMP1 + 4 * I_CMP2 + 2 * I_RG_IN + 16 * I_RG_G + 2 * I_SQ + 4 * I_UP + 4 * I_DOWN + 4 * I_PROJ + 4 * I_SQ;
    for (int it = gw; it < NITEMS; it += NGW) {
        int r = it;
        if (r < 2 * I_NSA_IN) { const int j = r / I_NSA_IN, q = r % I_NSA_IN, kb = q / 64, nb = q % 64; const int nv = NSA_N - 32 * nb;
            tr_item((const float*)in_ptr(10) + (size_t)j * 1024 * NSA_N, NSA_N, 64 * kb, 32 * nb, nv < 0 ? 0 : (nv > 32 ? 32 : nv), (bf16_t*)(ws + WS_W_NSA_IN) + (size_t)j * NSA_NP * 1024, 1024, 32 * nb, scr, lane); continue; } r -= 2 * I_NSA_IN;
        if (r < 2 * I_SQ) { const int j = r / I_SQ, q = r % I_SQ, kb = q / 32, nb = q % 32;
            tr_item((const float*)in_ptr(11) + (size_t)j * 1024 * 1024, 1024, 64 * kb, 32 * nb, 32, (bf16_t*)(ws + WS_W_NSA_OUT) + (size_t)j * 1024 * 1024, 1024, 32 * nb, scr, lane); continue; } r -= 2 * I_SQ;
        if (r < 4 * I_CMP1) { const int mt = r / I_CMP1, q = r % I_CMP1, kb = q / 8, nb = q % 8;
            tr_item((const float*)in_ptr(13) + (size_t)mt * 2048 * 256, 256, 64 * kb, 32 * nb, 32, (bf16_t*)(ws + WS_W_CMP1) + (size_t)mt * 256 * 2048, 2048, 32 * nb, scr, lane); continue; } r -= 4 * I_CMP1;
        if (r < 4 * I_CMP2) { const int mt = r / I_CMP2, q = r % I_CMP2, kb = q / 2, nb = q % 2;
            tr_item((const float*)in_ptr(15) + (size_t)mt * 256 * 64, 64, 64 * kb, 32 * nb, 32, (bf16_t*)(ws + WS_W_CMP2) + (size_t)mt * 64 * 256, 256, 32 * nb, scr, lane); continue; } r -= 4 * I_CMP2;
        if (r < 2 * I_RG_IN) { const int j = r / I_RG_IN, q = r % I_RG_IN, kb = q / 64, nb = q % 64;
            tr_item((const float*)in_ptr(16) + (size_t)j * 1024 * 2048, 2048, 64 * kb, 32 * nb, 32, (bf16_t*)(ws + WS_W_RG_IN) + (size_t)j * 2048 * 1024, 1024, 32 * nb, scr, lane); continue; } r -= 2 * I_RG_IN;
        if (r < 16 * I_RG_G) { const int mt = r / I_RG_G, q = r % I_RG_G, kb = q / 8, nt = q % 8; const int j = mt >> 3, src = (mt >> 2) & 1, nb = mt & 3;
            const float* W = (const float*)in_ptr(src ? 21 : 19) + (size_t)(j * 4 + nb) * 256 * 256;
            tr_item(W, 256, 64 * kb, 32 * nt, 32, (bf16_t*)(ws + WS_W_RG_G) + (size_t)j * 8 * 256 * 256, 256, (nb * 2 + nt / 4) * 256 + src * 128 + (nt % 4) * 32, scr, lane); continue; } r -= 16 * I_RG_G;
        if (r < 2 * I_SQ) { const int j = r / I_SQ, q = r % I_SQ, kb = q / 32, nb = q % 32;
            tr_item((const float*)in_ptr(24) + (size_t)j * 1024 * 1024, 1024, 64 * kb, 32 * nb, 32, (bf16_t*)(ws + WS_W_RG_OUT) + (size_t)j * 1024 * 1024, 1024, 32 * nb, scr, lane); continue; } r -= 2 * I_SQ;
        if (r < 4 * I_UP) { const int i = r / I_UP, q = r % I_UP, kb = q / 192, nt = q % 192; const int n0 = 32 * nt, half = n0 / DFF, within = n0 % DFF;
            tr_item((const float*)in_ptr(25) + (size_t)i * 1024 * 6144, 6144, 64 * kb, n0, 32, (bf16_t*)(ws + WS_W_UP) + (size_t)i * 6144 * 1024, 1024, (within / 128) * 256 + half * 128 + (within % 128), scr, lane); continue; } r -= 4 * I_UP;
        if (r < 4 * I_DOWN) { const int i = r / I_DOWN, q = r % I_DOWN, kb = q / 32, nb = q % 32;
            tr_item((const float*)in_ptr(28) + (size_t)i * 3072 * 1024, 1024, 64 * kb, 32 * nb, 32, (bf16_t*)(ws + WS_W_DOWN) + (size_t)i * 1024 * 3072, 3072, 32 * nb, scr, lane); continue; } r -= 4 * I_DOWN;
        if (r < 4 * I_PROJ) { const int i = r / I_PROJ, q = r % I_PROJ, kb = q / 32, nb = q % 32;
            tr_item((const float*)in_ptr(33) + (size_t)i * 256 * 1024, 1024, 64 * kb, 32 * nb, 32, (bf16_t*)(ws + WS_W_PROJ) + (size_t)i * 1024 * 256, 256, 32 * nb, scr, lane); continue; } r -= 4 * I_PROJ;
        { const int i = r / I_SQ, q = r % I_SQ, kb = q / 32, nb = q % 32;
            tr_item((const float*)in_ptr(34) + (size_t)i * 1024 * 1024, 1024, 64 * kb, 32 * nb, 32, (bf16_t*)(ws + WS_W_GATE) + (size_t)i * 1024 * 1024, 1024, 32 * nb, scr, lane); }
    }
    for (int m0 = 2 * gw; m0 < MT; m0 += 2 * NGW) {
        f32x4 v[2][4];
#pragma unroll
        for (int r = 0; r < 2; ++r) { const int m = m0 + r; const float* src = (m < MP) ? (const float*)in_ptr(0) + (size_t)m * D : (const float*)in_ptr(1) + (size_t)(m - MP) * D;
#pragma unroll
            for (int jj = 0; jj < 4; ++jj) v[r][jj] = *((const f32x4*)src + lane + 64 * jj); }
#pragma unroll
        for (int r = 0; r < 2; ++r) { const int m = m0 + r; float* x32 = (float*)(ws + WS_X32) + (size_t)m * D; bf16_t* xb = (bf16_t*)(ws + WS_XB) + (size_t)m * D;
#pragma unroll
            for (int jj = 0; jj < 4; ++jj) { *((f32x4*)x32 + lane + 64 * jj) = v[r][jj]; u32x2 w; w.x = pk2(v[r][jj][0], v[r][jj][1]); w.y = pk2(v[r][jj][2], v[r][jj][3]); *((u32x2*)xb + lane + 64 * jj) = w; } }
    }
    for (int r0 = 8 * gw; r0 < 4 * MT; r0 += 8 * NGW) {
        f32x4 v[8];
#pragma unroll
        for (int r = 0; r < 8; ++r) { const int rr = r0 + r, i = rr / MT, m = rr % MT;
            const float* src = (m < MP) ? (const float*)in_ptr(8) + ((size_t)i * MP + m) * DPLE : (const float*)in_ptr(9) + ((size_t)i * MS + (m - MP)) * DPLE;
            v[r] = *((const f32x4*)src + lane); }
#pragma unroll
        for (int r = 0; r < 8; ++r) { u32x2 w; w.x = pk2(v[r][0], v[r][1]); w.y = pk2(v[r][2], v[r][3]); const int rr = r0 + r, i = rr / MT, m = rr % MT; bf16_t* dst = (m < MP) ? (bf16_t*)(ws + WS_PB) + ((size_t)i * MP + m) * DPLE : (bf16_t*)(ws + WS_PBS) + ((size_t)i * MS + (m - MP)) * DPLE; *((u32x2*)dst + lane) = w; }
    }
    { const int* pt = (const int*)in_ptr(7); const float* ckv = (const float*)in_ptr(2); bf16_t* cs = (bf16_t*)(ws + WS_CS);
      const int kv = lane >> 5, gg = (lane >> 4) & 1, c4 = lane & 15;
      for (int it = gw; it < 2 * DECB * NPAGES * 4; it += NGW) { const int qr = it & 3, ps = (it >> 2) & 15, b = (it >> 6) & 127, layer = it >> 13;
          const int page = pt[b * NPAGES + ps]; const float* srow = ckv + ((size_t)(layer * NPOOL + page) * PAGE + qr * 32) * 512;
          bf16_t* drow = cs + ((size_t)(((layer * 2 + kv) * DECB + b) * 2 + gg) * PAST + ps * 128 + qr * 32) * 64 + c4 * 4;
#pragma unroll
          for (int r0 = 0; r0 < 32; r0 += 8) { f32x4 v[8];
#pragma unroll
              for (int r = 0; r < 8; ++r) v[r] = *((const f32x4*)(srow + (size_t)(r0 + r) * 512) + lane);
#pragma unroll
              for (int r = 0; r < 8; ++r) { u32x2 w; w.x = pk2(v[r][0], v[r][1]); w.y = pk2(v[r][2], v[r][3]); *(u32x2*)(drow + (size_t)(r0 + r) * 64) = w; } } } }
    for (int o = F.vcu * 512 + F.tid; o < 2 * D; o += F.G * 512) ((float*)(ws + WS_SPT))[o] = -8.f * 1.4426950408889634f * log1pf(__expf(-((const float*)in_ptr(23))[o]));
    for (int it = gw; it < 4 * 4 * 32; it += NGW) { const int mt = it >> 7, hc = (it >> 5) & 3, sl = it & 31; const int h = hc * 64 + lane;
        const float* pe = (const float*)in_ptr(12) + (size_t)mt * 2048; const float* w1 = (const float*)in_ptr(13) + (size_t)mt * 2048 * 256;
        float s = 0.f;
#pragma unroll 8
        for (int k = 0; k < 64; ++k) { const int kk = sl * 64 + k; s += pe[kk] * w1[(size_t)kk * 256 + h]; }
        ((float*)(ws + WS_B1PART))[(mt * 32 + sl) * 256 + h] = s; }
    for (int jb = F.vcu; jb < 2 * DECB; jb += F.G) { const f32x4* src = (const f32x4*)in_ptr(3) + (size_t)jb * (512 * 64) + 4 * 64; f32x4* dst = (f32x4*)(F.out + O_WINS) + (size_t)jb * (512 * 64);
        for (int k0 = 0; k0 < 64; k0 += 8) { f32x4 v[8];
#pragma unroll
            for (int k = 0; k < 8; ++k) { const int idx = F.tid + 512 * (k0 + k); if (idx < 508 * 64) v[k] = src[idx]; }
#pragma unroll
            for (int k = 0; k < 8; ++k) { const int idx = F.tid + 512 * (k0 + k); if (idx < 508 * 64) dst[idx] = v[k]; } } }
}

__device__ __forceinline__ void load_b1p(Frame& F) {
    LAS float* tb = (LAS float*)(F.lds + LDS_B1P_OFF); const float* part = (const float*)(F.ws + WS_B1PART);
    for (int o = F.tid; o < 1024; o += 512) { const int mt = o >> 8, h = o & 255; float s = ((const float*)in_ptr(14))[o];
        for (int sl = 0; sl < 32; ++sl) s += part[(mt * 32 + sl) * 256 + h];
        tb[o] = s; }
    __syncthreads();
}

__device__ __forceinline__ void cmp_stage2(Frame& F, const bf16_t* hid, const bf16_t* w2t_base, int rows_per_mat, int nrows, bf16_t* outp) {
    const int gw = F.vcu * NWAVES + F.wave, NGW = F.G * NWAVES, lane = F.lane, r32 = lane & 31, hi = lane >> 5;
    for (int task = gw; task < nrows / 32; task += NGW) { const int R0 = task * 32; const bf16_t* w2t = w2t_base + (size_t)(R0 / rows_per_mat) * 64 * 256;
        f32x16 o0 = {0}, o1 = {0};
#pragma unroll 4
        for (int ks = 0; ks < 16; ++ks) {
            const bf16x8 hf = *(const bf16x8*)(hid + (size_t)(R0 + r32) * 256 + 16 * ks + 8 * hi);
            const bf16x8 w0 = *(const bf16x8*)(w2t + (size_t)r32 * 256 + 16 * ks + 8 * hi), w1 = *(const bf16x8*)(w2t + (size_t)(32 + r32) * 256 + 16 * ks + 8 * hi);
            o0 = __builtin_amdgcn_mfma_f32_32x32x16_bf16(w0, hf, o0, 0, 0, 0); o1 = __builtin_amdgcn_mfma_f32_32x32x16_bf16(w1, hf, o1, 0, 0, 0); }
        bf16_t* op = outp + (size_t)(R0 + r32) * 64;
#pragma unroll
        for (int k4 = 0; k4 < 4; ++k4) { u32x2 w; w.x = pk2(o0[4 * k4], o0[4 * k4 + 1]); w.y = pk2(o0[4 * k4 + 2], o0[4 * k4 + 3]); *(u32x2*)(op + 8 * k4 + 4 * hi) = w;
            u32x2 w2; w2.x = pk2(o1[4 * k4], o1[4 * k4 + 1]); w2.y = pk2(o1[4 * k4 + 2], o1[4 * k4 + 3]); *(u32x2*)(op + 32 + 8 * k4 + 4 * hi) = w2; } }
}

__device__ __forceinline__ void ln_phase(Frame& F, const float* pre, const float* g, const float* bta, float* h32, bf16_t* hb) {
    const int gw = F.vcu * NWAVES + F.wave, NGW = F.G * NWAVES, lane = F.lane;
    f32x4 gv[4], bv[4];
#pragma unroll
    for (int jj = 0; jj < 4; ++jj) { gv[jj] = *((const f32x4*)g + lane + 64 * jj); bv[jj] = *((const f32x4*)bta + lane + 64 * jj); }
    for (int m = gw; m < MT; m += NGW) {
        const f32x4* xr = (const f32x4*)(pre + (size_t)m * D) + lane; f32x4 v[4]; float s = 0.f;
#pragma unroll
        for (int jj = 0; jj < 4; ++jj) { v[jj] = xr[64 * jj]; s += (v[jj][0] + v[jj][1]) + (v[jj][2] + v[jj][3]); }
        const float mean = wave_sum(s) * (1.f / D); float s2 = 0.f;
#pragma unroll
        for (int jj = 0; jj < 4; ++jj) { v[jj] = v[jj] - mean; s2 += (v[jj][0] * v[jj][0] + v[jj][1] * v[jj][1]) + (v[jj][2] * v[jj][2] + v[jj][3] * v[jj][3]); }
        const float rstd = 1.f / sqrtf(wave_sum(s2) * (1.f / D) + LN_EPS);
#pragma unroll
        for (int jj = 0; jj < 4; ++jj) { const f32x4 y = v[jj] * rstd * gv[jj] + bv[jj]; *((f32x4*)(h32 + (size_t)m * D) + lane + 64 * jj) = y;
            u32x2 w; w.x = pk2(y[0], y[1]); w.y = pk2(y[2], y[3]); *((u32x2*)(hb + (size_t)m * D) + lane + 64 * jj) = w; }
    }
}


template <int NR> __device__ __forceinline__ void ffn_conv_rows(const bf16_t* U, bf16_t* ACT, int row0, int c, const float (&w)[2][3][8], const float (&bb)[2][8], float (&p2)[2][8], float (&p1)[2][8]) {
    u32x4 ua[NR], ub[NR];
#pragma unroll
    for (int r = 0; r < NR; ++r) { ua[r] = *(const u32x4*)(U + (size_t)(row0 + r) * 6144 + c); ub[r] = *(const u32x4*)(U + (size_t)(row0 + r) * 6144 + DFF + c); }
#pragma unroll
    for (int r = 0; r < NR; ++r) { float cur[2][8], res[8]; unpack8(ua[r], cur[0]); unpack8(ub[r], cur[1]);
#pragma unroll
        for (int e = 0; e < 8; ++e) {
            const float xa = bb[0][e] + p2[0][e] * w[0][0][e] + p1[0][e] * w[0][1][e] + cur[0][e] * w[0][2][e];
            const float xb = bb[1][e] + p2[1][e] * w[1][0][e] + p1[1][e] * w[1][1][e] + cur[1][e] * w[1][2][e];
            res[e] = gelu_t(xa) * xb; p2[0][e] = p1[0][e]; p1[0][e] = cur[0][e]; p2[1][e] = p1[1][e]; p1[1][e] = cur[1][e]; }
        u32x4 o; o.x = pk2(res[0], res[1]); o.y = pk2(res[2], res[3]); o.z = pk2(res[4], res[5]); o.w = pk2(res[6], res[7]);
        *(u32x4*)(ACT + (size_t)(row0 + r) * DFF + c) = o; }
}
__device__ __forceinline__ void ffn_conv_phase(Frame& F, const bf16_t* U, const float* cw, const float* cb, const float* state  , bf16_t* ACT) {
    const int gt = F.vcu * 512 + F.tid, NT = F.G * 512;
    constexpr int CG = DFF / 8;
    constexpr int NPI = (MP / 16) * CG;
    constexpr int NSI = DECB * CG;
    for (int it = gt; it < NPI + NSI; it += NT) {
        const bool samp = it >= NPI; const int q = samp ? it - NPI : it; const int cg = q % CG, rc = q / CG, c = cg * 8;
        float w[2][3][8], bb[2][8];
#pragma unroll
        for (int h = 0; h < 2; ++h) {
#pragma unroll
            for (int k = 0; k < 3; ++k) { const f32x4 a = *(const f32x4*)(cw + (size_t)k * 6144 + h * DFF + c), b = *(const f32x4*)(cw + (size_t)k * 6144 + h * DFF + c + 4);
#pragma unroll
                for (int e = 0; e < 4; ++e) { w[h][k][e] = a[e]; w[h][k][4 + e] = b[e]; } }
            const f32x4 a = *(const f32x4*)(cb + h * DFF + c), b = *(const f32x4*)(cb + h * DFF + c + 4);
#pragma unroll
            for (int e = 0; e < 4; ++e) { bb[h][e] = a[e]; bb[h][4 + e] = b[e]; } }
        float p2[2][8], p1[2][8];
        if (!samp) { const int row0 = rc * 16, t0 = row0 & 2047;
#pragma unroll
            for (int h = 0; h < 2; ++h) {
                if (t0 == 0) {
#pragma unroll
                    for (int e = 0; e < 8; ++e) { p2[h][e] = 0.f; p1[h][e] = 0.f; } }
                else { unpack8(*(const u32x4*)(U + (size_t)(row0 - 2) * 6144 + h * DFF + c), p2[h]); unpack8(*(const u32x4*)(U + (size_t)(row0 - 1) * 6144 + h * DFF + c), p1[h]); } }
            ffn_conv_rows<8>(U, ACT, row0, c, w, bb, p2, p1); ffn_conv_rows<8>(U, ACT, row0 + 8, c, w, bb, p2, p1); }
        else { const int row0 = MP + rc * 4;
#pragma unroll
            for (int h = 0; h < 2; ++h) { const float* s0 = state + ((size_t)rc * 2 + 0) * 6144 + h * DFF + c; const float* s1 = state + ((size_t)rc * 2 + 1) * 6144 + h * DFF + c;
#pragma unroll
                for (int e = 0; e < 8; ++e) { p2[h][e] = s0[e]; p1[h][e] = s1[e]; } }
            ffn_conv_rows<4>(U, ACT, row0, c, w, bb, p2, p1); }
    }
}

__device__ __forceinline__ void rg_conv_phase(Frame& F, const bf16_t* RECB, const float* cw  , const float* cb, const float* state  , bf16_t* REC) {
    const int gt = F.vcu * 512 + F.tid, NT = F.G * 512;
    constexpr int CG = D / 8; constexpr int NPI = (MP / 16) * CG, NSI = DECB * CG;
    for (int it = gt; it < NPI + NSI; it += NT) {
        const bool samp = it >= NPI; const int q = samp ? it - NPI : it; const int cg = q % CG, rc = q / CG, c = cg * 8;
        float w[4][8], bb[8];
#pragma unroll
        for (int k = 0; k < 4; ++k) {
#pragma unroll
            for (int e = 0; e < 8; ++e) w[k][e] = cw[k * D + c + e]; }
#pragma unroll
        for (int e = 0; e < 8; ++e) bb[e] = cb[c + e];
        float p3[8], p2[8], p1[8]; int row0, nrows;
        if (!samp) { row0 = rc * 16; nrows = 16; const int t0 = row0 & 2047;
            if (t0 == 0) {
#pragma unroll
                for (int e = 0; e < 8; ++e) { p3[e] = 0.f; p2[e] = 0.f; p1[e] = 0.f; } }
            else { unpack8(*(const u32x4*)(RECB + (size_t)(row0 - 3) * D + c), p3); unpack8(*(const u32x4*)(RECB + (size_t)(row0 - 2) * D + c), p2); unpack8(*(const u32x4*)(RECB + (size_t)(row0 - 1) * D + c), p1); } }
        else { row0 = MP + rc * 4; nrows = 4;
#pragma unroll
            for (int e = 0; e < 8; ++e) { p3[e] = state[((size_t)rc * 3 + 0) * D + c + e]; p2[e] = state[((size_t)rc * 3 + 1) * D + c + e]; p1[e] = state[((size_t)rc * 3 + 2) * D + c + e]; } }
        for (int r = 0; r < nrows; ++r) {
            float cur[8], res[8]; unpack8(*(const u32x4*)(RECB + (size_t)(row0 + r) * D + c), cur);
#pragma unroll
            for (int e = 0; e < 8; ++e) { res[e] = bb[e] + p3[e] * w[0][e] + p2[e] * w[1][e] + p1[e] * w[2][e] + cur[e] * w[3][e]; p3[e] = p2[e]; p2[e] = p1[e]; p1[e] = cur[e]; }
            u32x4 o; o.x = pk2(res[0], res[1]); o.y = pk2(res[2], res[3]); o.z = pk2(res[4], res[5]); o.w = pk2(res[6], res[7]);
            *(u32x4*)(REC + (size_t)(row0 + r) * D + c) = o; }
    }
}

__device__ __forceinline__ void scan1_phase(Frame& F, const float* AA, const float* UU, float* CA, float* CH) {
    for (int it = F.vcu; it < BATCH * 32 * 2; it += F.G) { const int bc = it >> 1, c = (it & 1) * 512 + F.tid; const int b = bc >> 5, ch = bc & 31;
        const size_t r0 = (size_t)b * SEQ + ch * 64; float a = 1.f, h = 0.f;
#pragma unroll
        for (int t0 = 0; t0 < 64; t0 += 16) { float at[16], ut[16];
#pragma unroll
            for (int t = 0; t < 16; ++t) { at[t] = AA[(r0 + t0 + t) * D + c]; ut[t] = UU[(r0 + t0 + t) * D + c]; }
#pragma unroll
            for (int t = 0; t < 16; ++t) { h = at[t] * h + ut[t]; a *= at[t]; } }
        CA[(size_t)bc * D + c] = a; CH[(size_t)bc * D + c] = h; }
}
__device__ __forceinline__ void scan2_phase(Frame& F, const float* AA, const float* UU, const float* CA, const float* CH, const bf16_t* GG, bf16_t* HG, const float* h0s  ,
                                            const bf16_t* REC, const float* ga_b, const float* gx_b, const float* spt, float* out, int j) {
    constexpr int NPI = BATCH * 32 * 2, NSI = DECB * 2;
    for (int it = F.vcu; it < NPI + NSI; it += F.G) {
        if (it < NPI) { const int bc = it >> 1, c = (it & 1) * 512 + F.tid; const int b = bc >> 5, ch = bc & 31;
            float h = 0.f;
#pragma unroll
            for (int k0 = 0; k0 < 32; k0 += 16) { float ca[16], chh[16];
#pragma unroll
                for (int k = 0; k < 16; ++k) { const bool on = (k0 + k) < ch; ca[k] = on ? CA[(size_t)(b * 32 + k0 + k) * D + c] : 1.f; chh[k] = on ? CH[(size_t)(b * 32 + k0 + k) * D + c] : 0.f; }
#pragma unroll
                for (int k = 0; k < 16; ++k) h = ca[k] * h + chh[k]; }
            const size_t r0 = (size_t)b * SEQ + ch * 64;
#pragma unroll
            for (int t0 = 0; t0 < 64; t0 += 16) { float at[16], ut[16]; bf16_t gv[16];
#pragma unroll
                for (int t = 0; t < 16; ++t) { at[t] = AA[(r0 + t0 + t) * D + c]; ut[t] = UU[(r0 + t0 + t) * D + c]; gv[t] = GG[(r0 + t0 + t) * D + c]; }
#pragma unroll
                for (int t = 0; t < 16; ++t) { h = at[t] * h + ut[t]; HG[(r0 + t0 + t) * D + c] = (bf16_t)f2bf(h * bf2f(gv[t])); } }
            if (ch == 31) out[O_HP + (size_t)(j * BATCH + b) * D + c] = h; }
        else { const int q = it - NPI, b = q >> 1, c = (q & 1) * 512 + F.tid; float h = h0s[(size_t)b * D + c];
            const float gab = ga_b[c], gxb = gx_b[c], sp = spt[c]; constexpr float L2E = 1.4426950408889634f;
#pragma unroll
            for (int s = 0; s < 4; ++s) { const size_t r = (size_t)MP + b * 4 + s;
                const float rg = __builtin_amdgcn_rcpf(1.f + ex2(-L2E * (AA[r * D + c] + gab))), ig = __builtin_amdgcn_rcpf(1.f + ex2(-L2E * (UU[r * D + c] + gxb)));
                const float t = sp * rg, a = ex2(t), a2 = ex2(2.f * t), u = __builtin_amdgcn_sqrtf(fmaxf(1.f - a2, 0.f)) * ig * bf2f(REC[r * D + c]);
                h = a * h + u; HG[r * D + c] = (bf16_t)f2bf(h * bf2f(GG[r * D + c])); }
            out[O_HS + (size_t)(j * DECB + b) * D + c] = h; }
    }
}

namespace att {
__device__ __forceinline__ int crow(int r, int hi) { return (r & 3) + 8 * (r >> 2) + 4 * hi; }
__device__ __forceinline__ int koff(int key, int c16) { return key * 128 + ((c16 ^ ((key >> 1) & 7)) << 4); }
__device__ __forceinline__ int voff8(int key, int c8) { return key * 128 + ((c8 ^ (((key >> 1) & 1) << 3)) << 3); }
__device__ __forceinline__ float pmax(float v) { auto rr = __builtin_amdgcn_permlane32_swap(__float_as_uint(v), __float_as_uint(v), false, false); return fmaxf(__uint_as_float(rr[0]), __uint_as_float(rr[1])); }
__device__ __forceinline__ float psum(float v) { auto rr = __builtin_amdgcn_permlane32_swap(__float_as_uint(v), __float_as_uint(v), false, false); return __uint_as_float(rr[0]) + __uint_as_float(rr[1]); }
__device__ __forceinline__ float pother(float v, int hi) { auto rr = __builtin_amdgcn_permlane32_swap(__float_as_uint(v), __float_as_uint(v), false, false); return hi ? __uint_as_float(rr[0]) : __uint_as_float(rr[1]); }
typedef short v4i16_t __attribute__((ext_vector_type(4)));
__device__ __forceinline__ s16x4 vtr(const LAS unsigned char* p) { return __builtin_bit_cast(s16x4, __builtin_amdgcn_ds_read_tr16_b64_v4i16((LAS v4i16_t*)p)); }

__device__ __forceinline__ f32x16 s_tile(const LAS unsigned char* Kt, int key0, const bf16x8 (&qf)[4], int lane) {
    const int kq = lane & 31, hi = lane >> 5; f32x16 s = {0};
#pragma unroll
    for (int ks = 0; ks < 4; ++ks) { const bf16x8 kf = *(const LAS bf16x8*)(Kt + koff(key0 + kq, 2 * ks + hi)); s = __builtin_amdgcn_mfma_f32_32x32x16_bf16(kf, qf[ks], s, 0, 0, 0); }
    return s;
}
__device__ __forceinline__ void pv_tile(const LAS unsigned char* Vt, int key0, const f32x16& p, f32x16 (&o)[2], int lane) {
    const int hi = lane >> 5, gI = (lane >> 4) & 1, l15 = lane & 15, qp = l15 >> 2, pp = l15 & 3;
    unsigned pk[8];
#pragma unroll
    for (int i = 0; i < 8; ++i) pk[i] = pk2(p[2 * i], p[2 * i + 1]);
#pragma unroll
    for (int st = 0; st < 2; ++st) { const u32x4 pw = {pk[4 * st], pk[4 * st + 1], pk[4 * st + 2], pk[4 * st + 3]}; const bf16x8 pb = __builtin_bit_cast(bf16x8, pw);
#pragma unroll
        for (int dt = 0; dt < 2; ++dt) { const int c8 = 8 * dt + 4 * gI + pp, k1 = key0 + 16 * st + 4 * hi + qp;
            const s16x4 lo = vtr(Vt + voff8(k1, c8)), h4 = vtr(Vt + voff8(k1 + 8, c8));
            const bf16x8 vf = {lo[0], lo[1], lo[2], lo[3], h4[0], h4[1], h4[2], h4[3]};
            o[dt] = __builtin_amdgcn_mfma_f32_32x32x16_bf16(vf, pb, o[dt], 0, 0, 0); } }
}
template <class VF>
__device__ __forceinline__ void flash32(const LAS unsigned char* Kt, const LAS unsigned char* Vt, int key0, const bf16x8 (&qf)[4], float& m, float& l, f32x16 (&o)[2], int lane, VF valid) {
    f32x16 s = s_tile(Kt, key0, qf, lane); const int hi = lane >> 5;
    float tm = -1e30f;
#pragma unroll
    for (int r = 0; r < 16; ++r) { const bool v = valid(crow(r, hi)); s[r] = v ? s[r] : -1e30f; tm = fmaxf(tm, s[r]); }
    tm = pmax(tm);
    const float mn = fmaxf(m, tm), f = ex2(m - mn); m = mn;
    float ps = 0.f;
#pragma unroll
    for (int r = 0; r < 16; ++r) { const float p = s[r] > -1e29f ? ex2(s[r] - mn) : 0.f; s[r] = p; ps += p; }
    l = l * f + ps;
#pragma unroll
    for (int r = 0; r < 16; ++r) { o[0][r] *= f; o[1][r] *= f; }
    pv_tile(Vt, key0, s, o, lane);
}

constexpr int P_KT0 = 0, P_VT0 = 8192, P_KT1 = 16384, P_VT1 = 24576, P_KC = 32768, P_VC = 49152, P_IMP = 65536, P_IMPS = 98304, P_SELM = 102400;

__device__ __forceinline__ void stage_kv64(LAS unsigned char* Kt, LAS unsigned char* Vt, const u32x4& rk, const u32x4& rv, int tid) {
    const int key = tid >> 3, c16 = tid & 7;
    *(LAS u32x4*)(Kt + koff(key, c16)) = rk; *(LAS u32x4*)(Vt + key * 128 + ((c16 ^ (((key >> 1) & 1) << 2)) << 4)) = rv;
}

__device__ __forceinline__ void nsa_prompt_item(LAS unsigned char* lds, int b, int qblk, int g, const bf16_t* QB, const bf16_t* KV6, const bf16_t* KCP, const float* G32, bf16_t* OB, int tid_in) {
    int tid_ = tid_in; asm volatile("" : "+v"(tid_));
    const int tid = tid_, lane = tid & 63, w = __builtin_amdgcn_readfirstlane(tid >> 6), q = lane & 31, hi = lane >> 5;
    const int t0 = 32 * qblk, t = t0 + q, cur = qblk >> 1, head = 8 * g + w; const size_t m = (size_t)b * SEQ + t;
#pragma unroll
    for (int i = 0; i < 2; ++i) { const int idx = tid + 512 * i, key = idx >> 3, c16 = idx & 7;
        const u32x4 kk = *(const u32x4*)(KCP + ((size_t)((0 * 16 + b * 2 + g) * 128 + key)) * 64 + c16 * 8), vv = *(const u32x4*)(KCP + ((size_t)((1 * 16 + b * 2 + g) * 128 + key)) * 64 + c16 * 8);
        *(LAS u32x4*)(lds + P_KC + koff(key, c16)) = kk; *(LAS u32x4*)(lds + P_VC + key * 128 + ((c16 ^ (((key >> 1) & 1) << 2)) << 4)) = vv; }
    bf16x8 qf[4];
#pragma unroll
    for (int ks = 0; ks < 4; ++ks) qf[ks] = *(const bf16x8*)(QB + m * 1024 + head * 64 + 16 * ks + 8 * hi);
    const float g0 = G32[m * 48 + g * 24 + w * 3 + 0], g1 = G32[m * 48 + g * 24 + w * 3 + 1], g2 = G32[m * 48 + g * 24 + w * 3 + 2];
    __syncthreads();
    f32x16 otot[2];
    {
        f32x16 s[4]; float mx = -1e30f;
#pragma unroll
        for (int tl = 0; tl < 4; ++tl) { s[tl] = s_tile(lds + P_KC, 32 * tl, qf, lane);
#pragma unroll
            for (int r = 0; r < 16; ++r) { const int c = 32 * tl + crow(r, hi); const bool v = (16 * c + 31 <= t); s[tl][r] = v ? s[tl][r] : -1e30f; mx = fmaxf(mx, s[tl][r]); } }
        mx = pmax(mx); float sum = 0.f;
#pragma unroll
        for (int tl = 0; tl < 4; ++tl)
#pragma unroll
            for (int r = 0; r < 16; ++r) { const float e = s[tl][r] > -1e29f ? ex2(s[tl][r] - mx) : 0.f; s[tl][r] = e; sum += e; }
        sum = psum(sum); const float inv = 1.f / fmaxf(sum, 1e-30f);
        float G[16], lastv[16];
#pragma unroll
        for (int tl = 0; tl < 4; ++tl)
#pragma unroll
            for (int k = 0; k < 4; ++k) { float a = 0.f;
#pragma unroll
                for (int i = 0; i < 4; ++i) { s[tl][4 * k + i] *= inv; a += s[tl][4 * k + i]; }
                G[4 * tl + k] = a; lastv[4 * tl + k] = s[tl][4 * k + 3]; }
        float oth[16];
#pragma unroll
        for (int i = 0; i < 16; ++i) oth[i] = pother(lastv[i], hi);
        LAS float* imp = (LAS float*)(lds + P_IMP) + (w * 32 + q) * 32;
#pragma unroll
        for (int i = 0; i < 16; ++i) { const int tl = i >> 2, k = i & 3; const int n = 2 * k + hi + 8 * tl;
            const float prev = hi ? oth[i] : (i ? oth[i - 1] : 0.f); imp[n] = G[i] + prev; }
        f32x16 oc[2] = {{0}, {0}};
#pragma unroll
        for (int tl = 0; tl < 4; ++tl) pv_tile(lds + P_VC, 32 * tl, s[tl], oc, lane);
        otot[0] = oc[0] * g0; otot[1] = oc[1] * g0;
    }
    __syncthreads();
    {
        const int qq = lane >> 4, n2 = lane & 15, qs = 4 * w + qq;
        LAS float* imps = (LAS float*)(lds + P_IMPS) + qs * 32; float val[2];
#pragma unroll
        for (int e = 0; e < 2; ++e) { const int n = n2 + 16 * e; float v = 0.f;
#pragma unroll
            for (int ww = 0; ww < 8; ++ww) v += ((LAS float*)(lds + P_IMP))[(ww * 32 + qs) * 32 + n];
            if (n == 0 || n == cur || n == cur - 1) v = 1e6f;
            if (n > cur) v = -1.f;
            val[e] = v; imps[n] = v; }
        LDS_WAIT(); asm volatile("" ::: "memory");
        int rank0 = 0, rank1 = 0;
        for (int np = 0; np < 32; ++np) { const float vp = imps[np];
            rank0 += (vp > val[0] || (vp == val[0] && np < n2)) ? 1 : 0; rank1 += (vp > val[1] || (vp == val[1] && np < n2 + 16)) ? 1 : 0; }
        const unsigned long long b0 = __ballot(rank0 < 16), b1 = __ballot(rank1 < 16);
        const unsigned mask = (unsigned)((b0 >> (16 * qq)) & 0xffffull) | ((unsigned)((b1 >> (16 * qq)) & 0xffffull) << 16);
        if (n2 == 0) ((LAS unsigned*)(lds + P_SELM))[qs] = mask;
    }
    __syncthreads();
    const unsigned mymask = ((LAS unsigned*)(lds + P_SELM))[q];
    unsigned um = mymask;
#pragma unroll
    for (int o = 1; o < 32; o <<= 1) um |= (unsigned)__shfl_xor((int)um, o);
    um = (unsigned)__builtin_amdgcn_readfirstlane((int)um);
    const bf16_t* Ksel = KV6 + ((size_t)((2 * 8 + b) * 2 + g) * 2048) * 64; const bf16_t* Vsel = KV6 + ((size_t)((3 * 8 + b) * 2 + g) * 2048) * 64;
    const bf16_t* Kwin = KV6 + ((size_t)((4 * 8 + b) * 2 + g) * 2048) * 64; const bf16_t* Vwin = KV6 + ((size_t)((5 * 8 + b) * 2 + g) * 2048) * 64;
    const int ldoff = (tid >> 3) * 64 + (tid & 7) * 8;
    {
        unsigned rem = um & (cur == 31 ? 0xffffffffu : ((1u << (cur + 1)) - 1u));
        float mm = -1e30f, ll = 0.f; f32x16 o[2] = {{0}, {0}};
        int n = __builtin_ctz(rem); rem &= rem - 1;
        u32x4 rk = *(const u32x4*)(Ksel + (size_t)n * 4096 + ldoff), rv = *(const u32x4*)(Vsel + (size_t)n * 4096 + ldoff);
        int buf = 0;
        for (;;) {
            LAS unsigned char* Kt = lds + (buf ? P_KT1 : P_KT0); LAS unsigned char* Vt = lds + (buf ? P_VT1 : P_VT0);
            stage_kv64(Kt, Vt, rk, rv, tid);
            __syncthreads();
            const int nn = rem ? __builtin_ctz(rem) : -1;
            if (nn >= 0) { rem &= rem - 1; rk = *(const u32x4*)(Ksel + (size_t)nn * 4096 + ldoff); rv = *(const u32x4*)(Vsel + (size_t)nn * 4096 + ldoff); }
            const bool selq = (mymask >> n) & 1u;
#pragma unroll
            for (int hf = 0; hf < 2; ++hf) { const int kb = 64 * n + 32 * hf;
                flash32(Kt, Vt, 32 * hf, qf, mm, ll, o, lane, [&](int kk) { return selq && (kb + kk <= t); }); }
            if (nn < 0) break;
            n = nn; buf ^= 1;
        }
        ll = psum(ll); const float sc = g1 / fmaxf(ll, 1e-30f);
        otot[0] += o[0] * sc; otot[1] += o[1] * sc;
    }
    __syncthreads();
    {
        const int nlo = cur - 8 < 0 ? 0 : cur - 8;
        float mm = -1e30f, ll = 0.f; f32x16 o[2] = {{0}, {0}};
        u32x4 rk = *(const u32x4*)(Kwin + (size_t)nlo * 4096 + ldoff), rv = *(const u32x4*)(Vwin + (size_t)nlo * 4096 + ldoff);
        int buf = 0;
        for (int n = nlo; n <= cur; ++n) {
            LAS unsigned char* Kt = lds + (buf ? P_KT1 : P_KT0); LAS unsigned char* Vt = lds + (buf ? P_VT1 : P_VT0);
            stage_kv64(Kt, Vt, rk, rv, tid);
            __syncthreads();
            if (n < cur) { rk = *(const u32x4*)(Kwin + (size_t)(n + 1) * 4096 + ldoff); rv = *(const u32x4*)(Vwin + (size_t)(n + 1) * 4096 + ldoff); }
#pragma unroll
            for (int hf = 0; hf < 2; ++hf) { const int kb = 64 * n + 32 * hf;
                flash32(Kt, Vt, 32 * hf, qf, mm, ll, o, lane, [&](int kk) { const int key = kb + kk; return key <= t && key >= t - 512; }); }
            buf ^= 1;
        }
        ll = psum(ll); const float sc = g2 / fmaxf(ll, 1e-30f);
        otot[0] += o[0] * sc; otot[1] += o[1] * sc;
    }
    bf16_t* op = OB + m * 1024 + head * 64;
#pragma unroll
    for (int dt = 0; dt < 2; ++dt)
#pragma unroll
        for (int k4 = 0; k4 < 4; ++k4) { u32x2 wv; wv.x = pk2(otot[dt][4 * k4], otot[dt][4 * k4 + 1]); wv.y = pk2(otot[dt][4 * k4 + 2], otot[dt][4 * k4 + 3]);
            *(u32x2*)(op + 32 * dt + 8 * k4 + 4 * hi) = wv; }
    __syncthreads();
}

constexpr int S_TILE = 0  , S_OBUF = 0  , S_KC = 65536, S_VC = 81920, S_PBUF = 98304  ,
              S_MST = 114688  , S_LST = 115712, S_IMPS = 116736  , S_SELF = 117376  ;

__device__ __forceinline__ void s_write_partial(LAS unsigned char* lds, int w, int lane, float mm, float ll, const f32x16 (&o)[2]) {
    const int j = lane & 31, hi = lane >> 5;
    if (hi == 0) { ((LAS float*)(lds + S_MST))[w * 32 + j] = mm; ((LAS float*)(lds + S_LST))[w * 32 + j] = ll; }
    LAS float* ob = (LAS float*)(lds + S_OBUF) + w * 2048;
#pragma unroll
    for (int dt = 0; dt < 2; ++dt)
#pragma unroll
        for (int r = 0; r < 16; ++r) ob[(32 * dt + crow(r, hi)) * 32 + j] = o[dt][r];
}
__device__ __forceinline__ void s_merge(LAS unsigned char* lds, int nw, int tid, float gate, float (&acc)[4]) {
    const int j = tid & 31; const LAS float* ms = (const LAS float*)(lds + S_MST); const LAS float* ls = (const LAS float*)(lds + S_LST);
    float M = -1e30f;
    for (int w = 0; w < nw; ++w) M = fmaxf(M, ms[w * 32 + j]);
    float L = 0.f, wt[8];
    for (int w = 0; w < 8; ++w) { wt[w] = (w < nw) ? ex2(ms[w * 32 + j] - M) : 0.f; if (w < nw) L += ls[w * 32 + j] * wt[w]; }
    const float sc = gate / fmaxf(L, 1e-30f);
#pragma unroll
    for (int i = 0; i < 4; ++i) { const int d = (tid >> 5) + 16 * i; float v = 0.f;
        for (int w = 0; w < nw; ++w) v += ((const LAS float*)(lds + S_OBUF))[w * 2048 + d * 32 + j] * wt[w];
        acc[i] += v * sc; }
}
__device__ __forceinline__ void s_load_half_f32(LAS unsigned char* Kt, LAS unsigned char* Vt, const float* ksrc, const float* vsrc, size_t rstride, int nvalid, int lane) {
    const int kr = lane >> 4, c = lane & 15;
#pragma unroll
    for (int i = 0; i < 8; ++i) { const int key = 4 * i + kr; f32x4 kv = {0.f, 0.f, 0.f, 0.f}, vv = {0.f, 0.f, 0.f, 0.f};
        if (key < nvalid) { kv = *(const f32x4*)(ksrc + (size_t)key * rstride + 4 * c); vv = *(const f32x4*)(vsrc + (size_t)key * rstride + 4 * c); }
        u32x2 kw; kw.x = pk2(kv[0], kv[1]); kw.y = pk2(kv[2], kv[3]); u32x2 vw; vw.x = pk2(vv[0], vv[1]); vw.y = pk2(vv[2], vv[3]);
        *(LAS u32x2*)(Kt + koff(key, c >> 1) + 8 * (c & 1)) = kw; *(LAS u32x2*)(Vt + voff8(key, c)) = vw; }
}
__device__ __forceinline__ void s_load_rows_bf16(LAS unsigned char* Kt, LAS unsigned char* Vt, int key0, const bf16_t* ksrc, const bf16_t* vsrc, size_t rstride, int nvalid, int lane) {
    const int kr = lane >> 4, c = lane & 15;
    for (int i = 0; i < 8; ++i) { const int kk = 4 * i + kr; if (kk >= nvalid) break;
        const u32x2 kw = *(const u32x2*)(ksrc + (size_t)kk * rstride + 4 * c), vw = *(const u32x2*)(vsrc + (size_t)kk * rstride + 4 * c);
        *(LAS u32x2*)(Kt + koff(key0 + kk, c >> 1) + 8 * (c & 1)) = kw; *(LAS u32x2*)(Vt + voff8(key0 + kk, c)) = vw; }
}

__device__ __forceinline__ void nsa_sample_item(LAS unsigned char* lds, int b, int g, int layer, const bf16_t* QB, const bf16_t* KVS, const bf16_t* KCS, const float* G32,
                                                const float* ckv, const float* cwin, const int* pt, bf16_t* OB, int tid_in) {
    int tid_ = tid_in; asm volatile("" : "+v"(tid_));
    const int tid = tid_, lane = tid & 63, w = __builtin_amdgcn_readfirstlane(tid >> 6), j = lane & 31, hi = lane >> 5, qy = j >> 3, hh = j & 7;
    const size_t ms = (size_t)MP + 4 * b + qy; const int head = 8 * g + hh;
#pragma unroll
    for (int i = 0; i < 2; ++i) { const int idx = tid + 512 * i, key = idx >> 3, c16 = idx & 7;
        const u32x4 kk = *(const u32x4*)(KCS + ((size_t)((((layer * 2 + 0) * DECB + b) * 2 + g) * 128 + key)) * 64 + c16 * 8), vv = *(const u32x4*)(KCS + ((size_t)((((layer * 2 + 1) * DECB + b) * 2 + g) * 128 + key)) * 64 + c16 * 8);
        *(LAS u32x4*)(lds + S_KC + koff(key, c16)) = kk; *(LAS u32x4*)(lds + S_VC + key * 128 + ((c16 ^ (((key >> 1) & 1) << 2)) << 4)) = vv; }
    bf16x8 qf[4];
#pragma unroll
    for (int ks = 0; ks < 4; ++ks) qf[ks] = *(const bf16x8*)(QB + ms * 1024 + head * 64 + 16 * ks + 8 * hi);
    const float g0 = G32[ms * 48 + g * 24 + hh * 3 + 0], g1 = G32[ms * 48 + g * 24 + hh * 3 + 1], g2 = G32[ms * 48 + g * 24 + hh * 3 + 2];
    float acc[4] = {0.f, 0.f, 0.f, 0.f};
    if (tid < 8) ((LAS unsigned*)(lds + S_SELF))[tid] = 0u;
    __syncthreads();
    if (w < 4) {
        f32x16 s = s_tile(lds + S_KC, 32 * w, qf, lane); float mx = -1e30f;
#pragma unroll
        for (int r = 0; r < 16; ++r) { const int c = 32 * w + crow(r, hi); s[r] = (c < 127) ? s[r] : -1e30f; mx = fmaxf(mx, s[r]); }
        mx = pmax(mx); float sum = 0.f;
#pragma unroll
        for (int r = 0; r < 16; ++r) { const float e = s[r] > -1e29f ? ex2(s[r] - mx) : 0.f; s[r] = e; sum += e; ((LAS float*)(lds + S_PBUF))[(32 * w + crow(r, hi)) * 32 + j] = e; }
        sum = psum(sum);
        f32x16 o[2] = {{0}, {0}}; pv_tile(lds + S_VC, 32 * w, s, o, lane);
        s_write_partial(lds, w, lane, mx, sum, o);
    }
    __syncthreads();
    s_merge(lds, 4, tid, g0, acc);
    if (tid < 132) { const int q4 = tid / 33, n = tid % 33; float v = 0.f;
        const LAS float* msb = (const LAS float*)(lds + S_MST); const LAS float* lsb = (const LAS float*)(lds + S_LST);
        for (int h8 = 0; h8 < 8; ++h8) { const int jj = 8 * q4 + h8; float M = -1e30f;
            for (int ww = 0; ww < 4; ++ww) M = fmaxf(M, msb[ww * 32 + jj]);
            float L = 0.f; for (int ww = 0; ww < 4; ++ww) L += lsb[ww * 32 + jj] * ex2(msb[ww * 32 + jj] - M);
            float a = 0.f;
            for (int c = 4 * n - 1; c <= 4 * n + 3; ++c) if (c >= 0 && c < 127) a += ((const LAS float*)(lds + S_PBUF))[c * 32 + jj] * ex2(msb[(c >> 5) * 32 + jj] - M);
            v += a / fmaxf(L, 1e-30f); }
        if (n == 0 || n == 32 || n == 31) v = 1e6f;
        ((LAS float*)(lds + S_IMPS))[q4 * 33 + n] = v; }
    __syncthreads();
    if (tid < 132) { const int q4 = tid / 33, n = tid % 33; const float v = ((const LAS float*)(lds + S_IMPS))[q4 * 33 + n]; int rank = 0;
        for (int np = 0; np < 33; ++np) { const float vp = ((const LAS float*)(lds + S_IMPS))[q4 * 33 + np]; rank += (vp > v || (vp == v && np < n)) ? 1 : 0; }
        if (rank < 16) __hip_atomic_fetch_or((LAS unsigned*)(lds + S_SELF) + q4 * 2 + (n >> 5), 1u << (n & 31), __ATOMIC_RELAXED, __HIP_MEMORY_SCOPE_WORKGROUP); }
    __syncthreads();
    unsigned long long mymask, um;
    { const LAS unsigned* sf = (const LAS unsigned*)(lds + S_SELF);
      mymask = (unsigned long long)sf[qy * 2] | ((unsigned long long)sf[qy * 2 + 1] << 32);
      um = (unsigned long long)(sf[0] | sf[2] | sf[4] | sf[6]) | ((unsigned long long)(sf[1] | sf[3] | sf[5] | sf[7]) << 32); }
    LAS unsigned char* Kt = lds + S_TILE + w * 8192; LAS unsigned char* Vt = Kt + 4096;
    {
        float mm = -1e30f, ll = 0.f; f32x16 o[2] = {{0}, {0}}; int idx = 0;
        for (int n = 0; n < 33; ++n) { if (!((um >> n) & 1ull)) continue;
            for (int hf = 0; hf < 2; ++hf) { if (n == 32 && hf == 1) break;
                if ((idx++ & 7) != w) continue;
                if (n < 32) { const int page = pt[b * NPAGES + (n >> 1)]; const float* base = ckv + ((size_t)(layer * NPOOL + page) * PAGE + (n & 1) * 64 + 32 * hf) * 512 + g * 64;
                    s_load_half_f32(Kt, Vt, base + 2 * 128, base + 3 * 128, 512, 32, lane); }
                else { s_load_half_f32(Kt, Vt, nullptr, nullptr, 0, 0, lane); LDS_WAIT();
                    s_load_rows_bf16(Kt, Vt, 0, KVS + (size_t)(4 * b) * 768 + 2 * 128 + g * 64, KVS + (size_t)(4 * b) * 768 + 3 * 128 + g * 64, 768, 4, lane); }
                LDS_WAIT(); asm volatile("" ::: "memory");
                const bool selq = (mymask >> n) & 1ull; const int pos0 = 64 * n + 32 * hf;
                flash32(Kt, Vt, 0, qf, mm, ll, o, lane, [&](int kk) { return selq && (pos0 + kk <= PAST + qy); });
                LDS_WAIT(); asm volatile("" ::: "memory"); } }
        ll = psum(ll);
        __syncthreads();
        s_write_partial(lds, w, lane, mm, ll, o);
        __syncthreads();
        s_merge(lds, 8, tid, g1, acc);
        __syncthreads();
    }
    {
        float mm = -1e30f, ll = 0.f; f32x16 o[2] = {{0}, {0}};
        for (int ht = w; ht < 17; ht += 8) {
            if (ht < 16) { const float* base = cwin + ((size_t)(layer * DECB + b) * 512 + 32 * ht) * 256 + g * 64; s_load_half_f32(Kt, Vt, base, base + 128, 256, 32, lane); }
            else { s_load_half_f32(Kt, Vt, nullptr, nullptr, 0, 0, lane); LDS_WAIT();
                s_load_rows_bf16(Kt, Vt, 0, KVS + (size_t)(4 * b) * 768 + 4 * 128 + g * 64, KVS + (size_t)(4 * b) * 768 + 5 * 128 + g * 64, 768, 4, lane); }
            LDS_WAIT(); asm volatile("" ::: "memory");
            const int i0 = 32 * ht;
            flash32(Kt, Vt, 0, qf, mm, ll, o, lane, [&](int kk) { const int ix = i0 + kk; return ix >= qy && ix <= 512 + qy; });
            LDS_WAIT(); asm volatile("" ::: "memory"); }
        ll = psum(ll);
        __syncthreads();
        s_write_partial(lds, w, lane, mm, ll, o);
        __syncthreads();
        s_merge(lds, 8, tid, g2, acc);
    }
    { const int jj = tid & 31; const size_t mr = (size_t)MP + 4 * b + (jj >> 3); const int hd = 8 * g + (jj & 7);
#pragma unroll
      for (int i = 0; i < 4; ++i) { const int d = (tid >> 5) + 16 * i; OB[mr * 1024 + hd * 64 + d] = (bf16_t)f2bf(acc[i]); } }
    __syncthreads();
}
}

constexpr int N_PHASES = 4 + 4 * 12;
__global__ void __launch_bounds__(NWAVES * 64, 2) mega_fwd(Args args) {
    extern __shared__ __attribute__((aligned(16))) unsigned char lds_raw[];
    Frame F;
    const int wave0 = __builtin_amdgcn_readfirstlane((int)threadIdx.x >> 6);
    F.lds = (LAS unsigned char*)lds_raw; F.tid = make_tid(wave0); F.lane = F.tid & 63; F.wave = wave0;
    F.G = gridDim.x; { const int bx0 = blockIdx.x; F.vcu = (F.G % 8 == 0) ? (bx0 % 8) * (F.G / 8) + bx0 / 8 : bx0; }
    F.ws = args.ws; F.out = args.out;
    unsigned char* ws0 = args.ws; float* out0 = args.out; int layer0 = 0;
#define PH_LOCALS unsigned char* ws = ws0; asm volatile("" : "+s"(ws)); float* outl = out0; asm volatile("" : "+s"(outl)); int layer = layer0; asm volatile("" : "+s"(layer)); const int j = layer >> 1; (void)j; int bx = (int)blockIdx.x; asm volatile("" : "+s"(bx)); (void)bx; F.ws = ws; F.out = outl; { const int G_ = F.G; F.vcu = (G_ % 8 == 0) ? (bx % 8) * (G_ / 8) + bx / 8 : bx; } { const int t_ = make_tid(wave0); F.tid = t_; F.lane = t_ & 63; F.wave = __builtin_amdgcn_readfirstlane(t_ >> 6); }
    for (int u = F.tid; u < (LDS_BYTES - LDSCTL_OFF) / 4; u += NWAVES * 64) ((LAS unsigned*)(F.lds + LDSCTL_OFF))[u] = 0u;
    __syncthreads();
    const int lo = args.ph_lo, hi = args.ph_hi;
    XcdBarrier bar = xcd_barrier_post((unsigned*)(ws0 + WS_CTL) + CW_BAR, (volatile LAS unsigned*)(F.lds + MISC_OFF) + 8, F.tid);
    int ph = 0;
#define IN_PH() (lo <= ph && ph < hi)
#ifndef ONLY_SITE
#define SITE(k) true
#else
#define SITE(k) ((k) == ONLY_SITE)
#endif
#define REPS(k) ((((unsigned long long)(PROBE_MASK)) >> (k)) & 1ull ? 2 : 1)
#define END_PH() do { if (lo <= ph && ph + 1 < hi) xcd_barrier(bar, make_tid(wave0)); ++ph; } while (0)

#ifndef SKIP_P0
    if (IN_PH() && SITE(1)) for (int rep_ = 0; rep_ < REPS(1); ++rep_) { PH_LOCALS; p0_prologue(F); }
#endif
    END_PH();
    if (IN_PH() && SITE(2)) for (int rep_ = 0; rep_ < REPS(2); ++rep_) { PH_LOCALS;
        { pg8::Gemm g{(const bf16_t*)(ws + WS_PB), (const bf16_t*)(ws + WS_W_PROJ), DPLE, DPLE, DPLE}; pg8::Sched S; S.init(4 * MP / 256, 4, F.G, bx, DPLE, DPLE);
          S.b_pm_mul = pg8::Sched::rmul(MP / 256); S.b_pm_bytes = (long)1024 * DPLE * 2;
          pg8::EpiBf16G<false> E{(bf16_t*)(ws + WS_PP), D, nullptr, 0};
          pg8::gemm_phase(F.lds, g, S, E, F.tid); }
        for (int i = 0; i < DEPTH; ++i) { bf16_t* pps = (bf16_t*)(ws + WS_PPS) + (size_t)i * MS * D;
            sgemm(F.lds, F.tid, F.vcu, F.G, (const bf16_t*)(ws + WS_PBS) + (size_t)i * MS * DPLE, DPLE, MS / 32, (const bf16_t*)(ws + WS_W_PROJ) + (size_t)i * D * DPLE, DPLE, DPLE, D / 64,
                  [&](int sr, int col, f32x4 v) { *(u32x2*)(pps + (size_t)sr * D + col) = pack4(v); }); }
    }
    END_PH();
    if (IN_PH() && SITE(21)) for (int rep_ = 0; rep_ < REPS(21); ++rep_) { PH_LOCALS;
        load_b1p(F);
        { pg8::Gemm g{(const bf16_t*)(ws + WS_CS), (const bf16_t*)(ws + WS_W_CMP1), 1024, 2048, 2048}; pg8::Sched S; S.init(512, 1, F.G, bx, 1024, 2048);
          S.b_pm_mul = pg8::Sched::rmul(128); S.b_pm_bytes = (long)256 * 2048 * 2;
          pg8::EpiBf16G<true> E{(bf16_t*)(ws + WS_HIDS), 256, (const LAS float*)(F.lds + LDS_B1P_OFF), 7};
          pg8::gemm_phase(F.lds, g, S, E, F.tid); }
    }
    END_PH();
    if (IN_PH() && SITE(3)) for (int rep_ = 0; rep_ < REPS(3); ++rep_) { PH_LOCALS; cmp_stage2(F, (const bf16_t*)(ws + WS_HIDS), (const bf16_t*)(ws + WS_W_CMP2), 32768, 131072, (bf16_t*)(ws + WS_KCS)); }
    END_PH();

    for (layer0 = 0; layer0 < DEPTH; ++layer0) {
        if ((layer0 & 1) == 0) {
            if (IN_PH() && SITE(4)) for (int rep_ = 0; rep_ < REPS(4); ++rep_) { PH_LOCALS;
                { pg8::Gemm g{(const bf16_t*)(ws + WS_XB), (const bf16_t*)(ws + WS_W_NSA_IN) + (size_t)j * NSA_NP * 1024, D, D, D}; pg8::Sched S; S.init(MP / 256, NSA_NP / 256, F.G, bx, D, D);
                  pg8::EpiNsaIn E{(bf16_t*)(ws + WS_QB), (bf16_t*)(ws + WS_KV6), (bf16_t*)(ws + WS_KVS), (float*)(ws + WS_G32), F.out, j};
                  pg8::gemm_phase(F.lds, g, S, E, F.tid); }
                { bf16_t* QB = (bf16_t*)(ws + WS_QB); bf16_t* KVS = (bf16_t*)(ws + WS_KVS); float* G32 = (float*)(ws + WS_G32); float* out = F.out;
                  sgemm(F.lds, F.tid, F.vcu, F.G, (const bf16_t*)(ws + WS_XB) + (size_t)MP * D, D, MS / 32, (const bf16_t*)(ws + WS_W_NSA_IN) + (size_t)j * NSA_NP * 1024, D, D, 29,
                    [&](int sr, int col, f32x4 v) {
                        if (col < 1024) { *(u32x2*)(QB + (size_t)(MP + sr) * 1024 + col) = pack4(v * QSCALE); }
                        else if (col < 1792) { const int kc = col - 1024; *(u32x2*)(KVS + (size_t)sr * 768 + kc) = pack4(v);
                            if (kc < 512) *(f32x4*)(out + O_KVS + (size_t)(j * MS + sr) * 512 + kc) = v;
                            else *(f32x4*)(out + O_WINS + ((size_t)(j * DECB + (sr >> 2)) * 512 + 508 + (sr & 3)) * 256 + (kc - 512)) = v; }
                        else if (col < 1840) { f32x4 s4; for (int e = 0; e < 4; ++e) s4[e] = sigm(v[e]); *(f32x4*)(G32 + (size_t)(MP + sr) * 48 + (col - 1792)) = s4; } }); }
            }
            END_PH();
            if (IN_PH() && SITE(5)) for (int rep_ = 0; rep_ < REPS(5); ++rep_) { PH_LOCALS;
                load_b1p(F);
                for (int kv = 0; kv < 2; ++kv) { const LAS float* bt = (const LAS float*)(F.lds + LDS_B1P_OFF) + (j * 2 + kv) * 256; bf16_t* hid = (bf16_t*)(ws + WS_HIDP) + (size_t)kv * 2048 * 256;
                    sgemm(F.lds, F.tid, F.vcu, F.G, (const bf16_t*)(ws + WS_KV6) + (size_t)kv * 16 * 2048 * 64, 1024, 64, (const bf16_t*)(ws + WS_W_CMP1) + (size_t)(j * 2 + kv) * 256 * 2048, 2048, 2048, 4,
                        [&](int r, int col, f32x4 v) { f32x4 o; for (int e = 0; e < 4; ++e) o[e] = gelu_t(v[e] + bt[col + e]); *(u32x2*)(hid + (size_t)r * 256 + col) = pack4(o); }); }
            }
            END_PH();
            if (IN_PH() && SITE(6)) for (int rep_ = 0; rep_ < REPS(6); ++rep_) { PH_LOCALS; cmp_stage2(F, (const bf16_t*)(ws + WS_HIDP), (const bf16_t*)(ws + WS_W_CMP2) + (size_t)j * 2 * 64 * 256, 2048, 4096, (bf16_t*)(ws + WS_KCP)); }
            END_PH();
            if (IN_PH() && SITE(7)) for (int rep_ = 0; rep_ < REPS(7); ++rep_) { PH_LOCALS;
                for (int it = F.vcu; it < 1024; it += F.G) { const int k = it >> 8, a16 = (it >> 4) & 15, bg = it & 15;
                    const int qblk = k == 0 ? 63 - a16 : k == 1 ? 32 + a16 : k == 2 ? 31 - a16 : a16;
                    att::nsa_prompt_item(F.lds, bg >> 1, qblk, bg & 1, (const bf16_t*)(ws + WS_QB), (const bf16_t*)(ws + WS_KV6), (const bf16_t*)(ws + WS_KCP), (const float*)(ws + WS_G32), (bf16_t*)(ws + WS_OB), F.tid); }
            }
            END_PH();
            if (IN_PH() && SITE(22)) for (int rep_ = 0; rep_ < REPS(22); ++rep_) { PH_LOCALS;
                for (int q = F.vcu; q < 256; q += F.G)
                    att::nsa_sample_item(F.lds, q >> 1, q & 1, j, (const bf16_t*)(ws + WS_QB), (const bf16_t*)(ws + WS_KVS), (const bf16_t*)(ws + WS_KCS), (const float*)(ws + WS_G32),
                                         (const float*)in_ptr(2), (const float*)in_ptr(3), (const int*)in_ptr(7), (bf16_t*)(ws + WS_OB), F.tid);
            }
            END_PH();
            if (IN_PH() && SITE(8)) for (int rep_ = 0; rep_ < REPS(8); ++rep_) { PH_LOCALS;
                { pg8::Gemm g{(const bf16_t*)(ws + WS_OB), (const bf16_t*)(ws + WS_W_NSA_OUT) + (size_t)j * D * D, D, D, D}; pg8::Sched S; S.init(MP / 256, 4, F.G, bx, D, D);
                  pg8::EpiResid E{(const float*)(ws + WS_X32), (float*)(ws + WS_PRE)};
                  pg8::gemm_phase(F.lds, g, S, E, F.tid); }
                { const float* xs = (const float*)(ws + WS_X32) + (size_t)MP * D; float* pre = (float*)(ws + WS_PRE) + (size_t)MP * D;
                  sgemm(F.lds, F.tid, F.vcu, F.G, (const bf16_t*)(ws + WS_OB) + (size_t)MP * D, D, MS / 32, (const bf16_t*)(ws + WS_W_NSA_OUT) + (size_t)j * D * D, D, D, D / 64,
                    [&](int sr, int col, f32x4 v) { const size_t o = (size_t)sr * D + col; *(f32x4*)(pre + o) = *(const f32x4*)(xs + o) * ALPHA + v; }); }
            }
            END_PH();
        } else {
            if (IN_PH() && SITE(9)) for (int rep_ = 0; rep_ < REPS(9); ++rep_) { PH_LOCALS;
                { pg8::Gemm g{(const bf16_t*)(ws + WS_XB), (const bf16_t*)(ws + WS_W_RG_IN) + (size_t)j * 2048 * D, D, D, D}; pg8::Sched S; S.init(MP / 256, 8, F.G, bx, D, D);
                  pg8::EpiRgIn E{(bf16_t*)(ws + WS_GG), (bf16_t*)(ws + WS_RECB), F.out, j};
                  pg8::gemm_phase(F.lds, g, S, E, F.tid); }
                { bf16_t* GG = (bf16_t*)(ws + WS_GG) + (size_t)MP * D; bf16_t* RECB = (bf16_t*)(ws + WS_RECB) + (size_t)MP * D; float* out = F.out;
                  sgemm(F.lds, F.tid, F.vcu, F.G, (const bf16_t*)(ws + WS_XB) + (size_t)MP * D, D, MS / 32, (const bf16_t*)(ws + WS_W_RG_IN) + (size_t)j * 2048 * D, D, D, 32,
                    [&](int sr, int col, f32x4 v) {
                        if (col < 1024) { f32x4 o; for (int e = 0; e < 4; ++e) o[e] = gelu_t(v[e]); *(u32x2*)(GG + (size_t)sr * D + col) = pack4(o); }
                        else { const int c = col - 1024; *(u32x2*)(RECB + (size_t)sr * D + c) = pack4(v);
                            if ((sr & 3) >= 1) *(f32x4*)(out + O_RCS + ((size_t)(j * DECB + (sr >> 2)) * 3 + ((sr & 3) - 1)) * D + c) = v; } }); }
            }
            END_PH();
            if (IN_PH() && SITE(10)) for (int rep_ = 0; rep_ < REPS(10); ++rep_) { PH_LOCALS; rg_conv_phase(F, (const bf16_t*)(ws + WS_RECB), (const float*)in_ptr(17) + (size_t)j * 4 * D, (const float*)in_ptr(18) + (size_t)j * D,
                                         (const float*)in_ptr(5) + (size_t)j * DECB * 3 * D, (bf16_t*)(ws + WS_REC)); }
            END_PH();
            if (IN_PH() && SITE(11)) for (int rep_ = 0; rep_ < REPS(11); ++rep_) { PH_LOCALS;
                { pg8::Gemm g{(const bf16_t*)(ws + WS_REC), (const bf16_t*)(ws + WS_W_RG_G) + (size_t)j * 8 * 256 * 256, D, 256, 256}; pg8::Sched S; S.init(MP / 256, 8, F.G, bx, D, 256);
                  S.a_pn_mul = pg8::Sched::rmul(2); S.a_pn_bytes = 256 * 2;
                  pg8::EpiRgGate E{(const bf16_t*)(ws + WS_REC), (const float*)in_ptr(20) + (size_t)j * D, (const float*)in_ptr(22) + (size_t)j * D, (const float*)(ws + WS_SPT) + (size_t)j * D, (float*)(ws + WS_AA), (float*)(ws + WS_UU)};
                  pg8::gemm_phase(F.lds, g, S, E, F.tid); }
                for (int nb = 0; nb < 4; ++nb) { float* AAs = (float*)(ws + WS_AA) + (size_t)MP * D + nb * 256; float* UUs = (float*)(ws + WS_UU) + (size_t)MP * D + nb * 256;
                    sgemm(F.lds, F.tid, F.vcu, F.G, (const bf16_t*)(ws + WS_REC) + (size_t)MP * D + nb * 256, D, MS / 32, (const bf16_t*)(ws + WS_W_RG_G) + ((size_t)j * 8 + nb * 2) * 256 * 256, 256, 256, 8,
                        [&](int sr, int col, f32x4 v) { const int ch = (col >> 8) * 128 + (col & 127); *(f32x4*)(((col >> 7) & 1 ? UUs : AAs) + (size_t)sr * D + ch) = v; }); }
            }
            END_PH();
            if (IN_PH() && SITE(12)) for (int rep_ = 0; rep_ < REPS(12); ++rep_) { PH_LOCALS; scan1_phase(F, (const float*)(ws + WS_AA), (const float*)(ws + WS_UU), (float*)(ws + WS_CA), (float*)(ws + WS_CH)); }
            END_PH();
            if (IN_PH() && SITE(13)) for (int rep_ = 0; rep_ < REPS(13); ++rep_) { PH_LOCALS; scan2_phase(F, (const float*)(ws + WS_AA), (const float*)(ws + WS_UU), (const float*)(ws + WS_CA), (const float*)(ws + WS_CH), (const bf16_t*)(ws + WS_GG), (bf16_t*)(ws + WS_HG),
                                       (const float*)in_ptr(4) + (size_t)j * DECB * D, (const bf16_t*)(ws + WS_REC), (const float*)in_ptr(20) + (size_t)j * D, (const float*)in_ptr(22) + (size_t)j * D, (const float*)(ws + WS_SPT) + (size_t)j * D, F.out, j); }
            END_PH();
            if (IN_PH() && SITE(14)) for (int rep_ = 0; rep_ < REPS(14); ++rep_) { PH_LOCALS;
                { pg8::Gemm g{(const bf16_t*)(ws + WS_HG), (const bf16_t*)(ws + WS_W_RG_OUT) + (size_t)j * D * D, D, D, D}; pg8::Sched S; S.init(MP / 256, 4, F.G, bx, D, D);
                  pg8::EpiResid E{(const float*)(ws + WS_X32), (float*)(ws + WS_PRE)};
                  pg8::gemm_phase(F.lds, g, S, E, F.tid); }
                { const float* xs = (const float*)(ws + WS_X32) + (size_t)MP * D; float* pre = (float*)(ws + WS_PRE) + (size_t)MP * D;
                  sgemm(F.lds, F.tid, F.vcu, F.G, (const bf16_t*)(ws + WS_HG) + (size_t)MP * D, D, MS / 32, (const bf16_t*)(ws + WS_W_RG_OUT) + (size_t)j * D * D, D, D, D / 64,
                    [&](int sr, int col, f32x4 v) { const size_t o = (size_t)sr * D + col; *(f32x4*)(pre + o) = *(const f32x4*)(xs + o) * ALPHA + v; }); }
            }
            END_PH();
        }
        if (IN_PH() && SITE(15)) for (int rep_ = 0; rep_ < REPS(15); ++rep_) { PH_LOCALS; ln_phase(F, (const float*)(ws + WS_PRE), (const float*)in_ptr(29) + (size_t)layer * D, (const float*)in_ptr(30) + (size_t)layer * D, (float*)(ws + WS_H32), (bf16_t*)(ws + WS_HB)); }
        END_PH();
        if (IN_PH() && SITE(16)) for (int rep_ = 0; rep_ < REPS(16); ++rep_) { PH_LOCALS;
            { pg8::Gemm g{(const bf16_t*)(ws + WS_HB), (const bf16_t*)(ws + WS_W_UP) + (size_t)layer * 6144 * D, D, D, D}; pg8::Sched S; S.init(MP / 256, 24, F.G, bx, D, D);
              pg8::EpiUp E{(bf16_t*)(ws + WS_U), F.out, layer};
              pg8::gemm_phase(F.lds, g, S, E, F.tid); }
            { bf16_t* U = (bf16_t*)(ws + WS_U) + (size_t)MP * 6144; float* out = F.out;
              sgemm(F.lds, F.tid, F.vcu, F.G, (const bf16_t*)(ws + WS_HB) + (size_t)MP * D, D, MS / 32, (const bf16_t*)(ws + WS_W_UP) + (size_t)layer * 6144 * D, D, D, 96,
                [&](int sr, int col, f32x4 v) { const int nat = ((col >> 7) & 1) * DFF + (col >> 8) * 128 + (col & 127); *(u32x2*)(U + (size_t)sr * 6144 + nat) = pack4(v);
                    if ((sr & 3) >= 2) *(f32x4*)(out + O_FCS + ((size_t)(layer * DECB + (sr >> 2)) * 2 + ((sr & 3) - 2)) * 6144 + nat) = v; }); }
        }
        END_PH();
        if (IN_PH() && SITE(17)) for (int rep_ = 0; rep_ < REPS(17); ++rep_) { PH_LOCALS; ffn_conv_phase(F, (const bf16_t*)(ws + WS_U), (const float*)in_ptr(26) + (size_t)layer * 3 * 6144, (const float*)in_ptr(27) + (size_t)layer * 6144,
                                      (const float*)in_ptr(6) + (size_t)layer * DECB * 2 * 6144, (bf16_t*)(ws + WS_ACT)); }
        END_PH();
        if (IN_PH() && SITE(18)) for (int rep_ = 0; rep_ < REPS(18); ++rep_) { PH_LOCALS;
            { pg8::Gemm g{(const bf16_t*)(ws + WS_ACT), (const bf16_t*)(ws + WS_W_DOWN) + (size_t)layer * D * DFF, DFF, DFF, DFF}; pg8::Sched S; S.init(MP / 256, 4, F.G, bx, DFF, DFF);
              pg8::EpiResid E{(const float*)(ws + WS_H32), (float*)(ws + WS_PRE)};
              pg8::gemm_phase(F.lds, g, S, E, F.tid); }
            { const float* hs = (const float*)(ws + WS_H32) + (size_t)MP * D; float* pre = (float*)(ws + WS_PRE) + (size_t)MP * D;
              sgemm(F.lds, F.tid, F.vcu, F.G, (const bf16_t*)(ws + WS_ACT) + (size_t)MP * DFF, DFF, MS / 32, (const bf16_t*)(ws + WS_W_DOWN) + (size_t)layer * D * DFF, DFF, DFF, D / 64,
                [&](int sr, int col, f32x4 v) { const size_t o = (size_t)sr * D + col; *(f32x4*)(pre + o) = *(const f32x4*)(hs + o) * ALPHA + v; }); }
        }
        END_PH();
        if (IN_PH() && SITE(19)) for (int rep_ = 0; rep_ < REPS(19); ++rep_) { PH_LOCALS; ln_phase(F, (const float*)(ws + WS_PRE), (const float*)in_ptr(31) + (size_t)layer * D, (const float*)in_ptr(32) + (size_t)layer * D, (float*)(ws + WS_H32), (bf16_t*)(ws + WS_HB)); }
        END_PH();
        if (IN_PH() && SITE(20)) for (int rep_ = 0; rep_ < REPS(20); ++rep_) { PH_LOCALS;
            { pg8::Gemm g{(const bf16_t*)(ws + WS_HB), (const bf16_t*)(ws + WS_W_GATE) + (size_t)layer * D * D, D, D, D}; pg8::Sched S; S.init(MP / 256, 4, F.G, bx, D, D);
              pg8::EpiPle E{(const float*)(ws + WS_H32), (const bf16_t*)(ws + WS_PP) + (size_t)layer * MP * D, (float*)(ws + WS_X32), (bf16_t*)(ws + WS_XB), F.out, layer == DEPTH - 1 ? 1 : 0};
              pg8::gemm_phase(F.lds, g, S, E, F.tid); }
            { const float* hs = (const float*)(ws + WS_H32) + (size_t)MP * D; const bf16_t* pps = (const bf16_t*)(ws + WS_PPS) + (size_t)layer * MS * D;
              float* xs = (float*)(ws + WS_X32) + (size_t)MP * D; bf16_t* xbs = (bf16_t*)(ws + WS_XB) + (size_t)MP * D; float* out = F.out; const bool last = layer == DEPTH - 1;
              sgemm(F.lds, F.tid, F.vcu, F.G, (const bf16_t*)(ws + WS_HB) + (size_t)MP * D, D, MS / 32, (const bf16_t*)(ws + WS_W_GATE) + (size_t)layer * D * D, D, D, D / 64,
                [&](int sr, int col, f32x4 v) { const size_t o = (size_t)sr * D + col; const f32x4 h = *(const f32x4*)(hs + o); const u32x2 pw = *(const u32x2*)(pps + o);
                    f32x4 r; r[0] = h[0] + sigm(v[0]) * bflo(pw.x); r[1] = h[1] + sigm(v[1]) * bfhi(pw.x); r[2] = h[2] + sigm(v[2]) * bflo(pw.y); r[3] = h[3] + sigm(v[3]) * bfhi(pw.y);
                    if (last) *(f32x4*)(out + O_YS + o) = r; else { *(f32x4*)(xs + o) = r; *(u32x2*)(xbs + o) = pack4(r); } }); }
        }
        END_PH();
    }
}

extern "C" void kernel_launch(void* const* d_in, const int* in_sizes, int n_in, void* d_out, int out_size, void* d_ws, size_t ws_size, hipStream_t stream) {
    static int grid = 0;
    if (grid == 0) {
        if (n_in != 35 || (size_t)out_size != O_END || ws_size < WS_END) { fprintf(stderr, "kernel_launch: unexpected problem (n_in %d, out %d, ws %zu need %zu)\n", n_in, out_size, ws_size, (size_t)WS_END); grid = -1; return; }
        int dev = 0, cus = 0, per_cu = 0;
        if (hipGetDevice(&dev) != hipSuccess || hipDeviceGetAttribute(&cus, hipDeviceAttributeMultiprocessorCount, dev) != hipSuccess) { grid = -1; return; }
        if (hipFuncSetAttribute((const void*)mega_fwd, hipFuncAttributeMaxDynamicSharedMemorySize, LDS_BYTES) != hipSuccess) { fprintf(stderr, "kernel_launch: hipFuncSetAttribute failed\n"); grid = -1; return; }
        if (hipOccupancyMaxActiveBlocksPerMultiprocessor(&per_cu, (const void*)mega_fwd, NWAVES * 64, LDS_BYTES) != hipSuccess || per_cu < 1)
            fprintf(stderr, "kernel_launch: occupancy query reports %d blocks per CU\n", per_cu);
        (void)hipGetLastError();
        grid = cus;
    }
    if (grid < 0) return;
    hipMemsetAsync((char*)d_ws + WS_CTL, 0, CTL_ZERO_BYTES, stream);
    Args a{};
    for (int i = 0; i < 35; ++i) a.in[i] = d_in[i];
    a.out = (float*)d_out; a.ws = (unsigned char*)d_ws;
#if MK_ONE_LAUNCH
    a.ph_lo = 0; a.ph_hi = N_PHASES;
    hipLaunchKernelGGL(mega_fwd, dim3(grid), dim3(NWAVES * 64), LDS_BYTES, stream, a);
#else
    for (int p = 0; p < N_PHASES; ++p) { a.ph_lo = p; a.ph_hi = p + 1; hipLaunchKernelGGL(mega_fwd, dim3(grid), dim3(NWAVES * 64), LDS_BYTES, stream, a); }
#endif
}
```
